# Optimizing an MI355X kernel written in HIP

```python
import jax, jax.numpy as jnp
from jax import lax
import numpy as np

D_MODEL = 1024
BATCH = 2
SEQ = 8192
DEPTH = 2

N_HEADS = 8
HEAD_DIM = 64
ATTN_WIDTH = 512
ROPE_DIM = 16
ROPE_THETA = 500000.0
IDX_HEADS = 8
IDX_DIM = 32
IDX_ROPE_DIM = 8
TOPK_MAX = 256
Q_BLOCK = 128
POOL_GROUPS = 4
POOL_GROUP_DIM = 128
POOL_WIDTH = 512
POOL_WINDOWS = (2, 4, 8, 16)
D_FF = 2816
N_EXPERTS = 8
TOP_K_EXPERTS = 2
D_FF_EXPERT = 3584
N_DENSE = (DEPTH + 1) // 2
N_MOE = DEPTH // 2
EPS = 1e-6
IN_SPLIT_SIZES = (ATTN_WIDTH, ATTN_WIDTH, ATTN_WIDTH, IDX_HEADS * IDX_DIM, IDX_DIM, IDX_HEADS, POOL_WIDTH, D_MODEL, D_MODEL)
IN_WIDTH = 4392

kernel_name = 'hybrid_dsa_pool_moe_block'


def rmsnorm(x, g):
    xf = x.astype(jnp.float32)
    y = xf * lax.rsqrt(jnp.mean(xf * xf, axis=-1, keepdims=True) + EPS)
    return (y * g.astype(jnp.float32)).astype(x.dtype)


def rope_partial(x, pos, rot_dim):
    inv = jnp.power(ROPE_THETA, -jnp.arange(0, rot_dim, 2, dtype=jnp.float32) / rot_dim)
    ang = pos[:, None] * inv[None, :]
    cos = jnp.cos(ang)[None, :, None, :]
    sin = jnp.sin(ang)[None, :, None, :]
    xr = x[..., :rot_dim].astype(jnp.float32)
    x1, x2 = xr[..., : rot_dim // 2], xr[..., rot_dim // 2:]
    rot = jnp.concatenate([x1 * cos - x2 * sin, x2 * cos + x1 * sin], axis=-1)
    return jnp.concatenate([rot.astype(x.dtype), x[..., rot_dim:]], axis=-1)


def dsa_attention(q, k, v, qi, ki, wi):
    B, S, H, hd = q.shape
    topk = min(TOPK_MAX, S // 4)
    nb = S // Q_BLOCK
    kpos = jnp.arange(S, dtype=jnp.int32)
    ki32 = ki.astype(jnp.float32)

    def to_blocks(a):
        return a.reshape((B, nb, Q_BLOCK) + a.shape[2:]).swapaxes(0, 1)

    def block(args):
        qb, qib, wib, qpos = args
        dots = jnp.einsum('bqhd,bsd->bqhs', qib.astype(jnp.float32), ki32) * (IDX_DIM ** -0.5)
        score = jnp.einsum('bqh,bqhs->bqs', wib.astype(jnp.float32) * (IDX_HEADS ** -0.5), jax.nn.relu(dots))
        causal = kpos[None, :] <= qpos[:, None]
        score = jnp.where(causal[None], score, -jnp.inf)
        _, sel = lax.top_k(score, topk)
        valid = sel <= qpos[None, :, None]
        k_sel = jax.vmap(lambda kk, ii: kk[ii])(k, sel)
        v_sel = jax.vmap(lambda vv, ii: vv[ii])(v, sel)
        logits = jnp.einsum('bqhd,bqkhd->bqhk', qb.astype(jnp.float32), k_sel.astype(jnp.float32)) * (HEAD_DIM ** -0.5)
        logits = jnp.where(valid[:, :, None, :], logits, -jnp.inf)
        p = jax.nn.softmax(logits, axis=-1)
        return jnp.einsum('bqhk,bqkhd->bqhd', p.astype(v.dtype), v_sel)

    pos_b = kpos.reshape(nb, Q_BLOCK)
    out = lax.map(block, (to_blocks(q), to_blocks(qi), to_blocks(wi), pos_b))
    return out.swapaxes(0, 1).reshape(B, S, H * hd)


def pool_mixer(u, w_pool, pool_scale):
    B, S, C = u.shape
    cs = jnp.pad(jnp.cumsum(u.astype(jnp.float32), axis=1), ((0, 0), (1, 0), (0, 0)))
    t1 = jnp.arange(1, S + 1, dtype=jnp.float32)
    means = []
    for g, w in enumerate(POOL_WINDOWS):
        c = cs[:, :, g * POOL_GROUP_DIM:(g + 1) * POOL_GROUP_DIM]
        lagged = jnp.pad(c[:, :S + 1 - w], ((0, 0), (w - 1, 0), (0, 0)))
        means.append((c[:, 1:] - lagged) / jnp.minimum(t1, w)[None, :, None])
    pooled = jnp.stack(means, axis=2)
    diff = pooled - u.reshape(B, S, POOL_GROUPS, POOL_GROUP_DIM).astype(jnp.float32)
    mixed = jnp.einsum('bsgc,gcd->bsgd', diff.astype(u.dtype), w_pool)
    return mixed.reshape(B, S, C) * pool_scale


def swiglu(h, w1, w3, w2):
    return (jax.nn.silu(h @ w1) * (h @ w3)) @ w2


def moe_swiglu(h, w_router, w1, w3, w2):
    logits = jnp.einsum('bsd,de->bse', h.astype(jnp.float32), w_router.astype(jnp.float32))
    top_v, top_i = lax.top_k(logits, TOP_K_EXPERTS)
    top_w = jax.nn.softmax(top_v, axis=-1)
    gate = jnp.sum(jax.nn.one_hot(top_i, N_EXPERTS, dtype=jnp.float32) * top_w[..., None], axis=-2)
    gate = gate.astype(h.dtype)
    y = jnp.zeros_like(h)
    for e in range(N_EXPERTS):
        y = y + gate[..., e:e + 1] * swiglu(h, w1[e], w3[e], w2[e])
    return y


def setup_inputs(seed: int = 0) -> dict:
    key = jax.random.key(seed)
    ks = jax.random.split(key, 20)

    def nrm(k, shape, scale):
        return jax.random.normal(k, shape, jnp.float32) * scale

    return {
        'x': nrm(ks[0], (BATCH, SEQ, D_MODEL), 1.0),
        'mix_norm': 1.0 + nrm(ks[1], (DEPTH, D_MODEL), 0.02),
        'w_in': nrm(ks[2], (DEPTH, D_MODEL, IN_WIDTH), D_MODEL ** -0.5),
        'q_norm': 1.0 + nrm(ks[3], (DEPTH, HEAD_DIM), 0.02),
        'k_norm': 1.0 + nrm(ks[4], (DEPTH, HEAD_DIM), 0.02),
        'w_pool': nrm(ks[5], (DEPTH, POOL_GROUPS, POOL_GROUP_DIM, POOL_GROUP_DIM), POOL_GROUP_DIM ** -0.5),
        'pool_scale': 1.0 + nrm(ks[6], (DEPTH, POOL_WIDTH), 0.1),
        'w_attn_proj': nrm(ks[7], (DEPTH, ATTN_WIDTH, D_MODEL), ATTN_WIDTH ** -0.5),
        'w_pool_proj': nrm(ks[8], (DEPTH, POOL_WIDTH, D_MODEL), POOL_WIDTH ** -0.5),
        'w_out': nrm(ks[9], (DEPTH, D_MODEL, D_MODEL), D_MODEL ** -0.5),
        'ffn_norm': 1.0 + nrm(ks[10], (DEPTH, D_MODEL), 0.02),
        'dense_w1': nrm(ks[11], (N_DENSE, D_MODEL, D_FF), D_MODEL ** -0.5),
        'dense_w3': nrm(ks[12], (N_DENSE, D_MODEL, D_FF), D_MODEL ** -0.5),
        'dense_w2': nrm(ks[13], (N_DENSE, D_FF, D_MODEL), D_FF ** -0.5),
        'moe_router': nrm(ks[14], (N_MOE, D_MODEL, N_EXPERTS), D_MODEL ** -0.5),
        'moe_w1': nrm(ks[15], (N_MOE, N_EXPERTS, D_MODEL, D_FF_EXPERT), D_MODEL ** -0.5),
        'moe_w3': nrm(ks[16], (N_MOE, N_EXPERTS, D_MODEL, D_FF_EXPERT), D_MODEL ** -0.5),
        'moe_w2': nrm(ks[17], (N_MOE, N_EXPERTS, D_FF_EXPERT, D_MODEL), D_FF_EXPERT ** -0.5),
    }


def reference(x, mix_norm, w_in, q_norm, k_norm, w_pool, pool_scale, w_attn_proj, w_pool_proj, w_out, ffn_norm, dense_w1, dense_w3, dense_w2, moe_router, moe_w1, moe_w3, moe_w2):
    B, S, _ = x.shape
    pos = jnp.arange(S, dtype=jnp.float32)
    offsets = [int(o) for o in np.cumsum(IN_SPLIT_SIZES)[:-1]]
    for layer in range(DEPTH):
        h = rmsnorm(x, mix_norm[layer])
        z = h @ w_in[layer]
        q, k, v, qi, ki, wi, u, ga, gp = jnp.split(z, offsets, axis=-1)
        q = rope_partial(rmsnorm(q.reshape(B, S, N_HEADS, HEAD_DIM), q_norm[layer]), pos, ROPE_DIM)
        k = rope_partial(rmsnorm(k.reshape(B, S, N_HEADS, HEAD_DIM), k_norm[layer]), pos, ROPE_DIM)
        v = v.reshape(B, S, N_HEADS, HEAD_DIM)
        qi = rope_partial(qi.reshape(B, S, IDX_HEADS, IDX_DIM), pos, IDX_ROPE_DIM)
        ki = rope_partial(ki[:, :, None, :], pos, IDX_ROPE_DIM)[:, :, 0, :]
        a = dsa_attention(q, k, v, qi, ki, wi)
        p = pool_mixer(u, w_pool[layer], pool_scale[layer])
        merged = jax.nn.sigmoid(ga) * (a @ w_attn_proj[layer]) + jax.nn.sigmoid(gp) * (p @ w_pool_proj[layer])
        x = x + merged @ w_out[layer]
        h2 = rmsnorm(x, ffn_norm[layer])
        if layer % 2 == 0:
            i = layer // 2
            x = x + swiglu(h2, dense_w1[i], dense_w3[i], dense_w2[i])
        else:
            i = layer // 2
            x = x + moe_swiglu(h2, moe_router[i], moe_w1[i], moe_w3[i], moe_w2[i])
    return x
```

```cpp
#define MK_PER_PHASE 1
#include <hip/hip_runtime.h>
#include <cstdio>
#include <cstdint>
namespace pg8 {
#define PG8_LAS __attribute__((address_space(3)))
typedef unsigned short bf16_t;
typedef short bf16x8 __attribute__((ext_vector_type(8)));
typedef float f32x4 __attribute__((ext_vector_type(4)));
typedef unsigned u32x4 __attribute__((ext_vector_type(4)));
constexpr int BM = 256, BK = 64, HALF = 128, HTB = HALF * BK * 2  , STAGE_BYTES = 8 * HTB, NXCD = 8, WGM = 8;

__host__ __device__ __forceinline__ int lds_byte(int r, int c) { const int st = (r >> 4) * 2 + (c >> 5), rr = r & 15, cc = c & 31, ob = rr * 64 + cc * 2; return st * 1024 + (ob ^ (((ob >> 9) & 1) << 5)); }
__host__ __device__ __forceinline__ void stage_rc(int b, int& R, int& C) { const int st = b / 1024, sb = b % 1024, swz = sb ^ (((sb >> 9) & 1) << 5); R = (st >> 1) * 16 + swz / 64; C = (st & 1) * 32 + (swz % 64) / 2; }
__host__ __device__ __forceinline__ int perm32(int rho) { const int n = rho >> 4, i = rho & 15; return 8 * (i >> 2) + 4 * n + (i & 3); }

struct Unit { int pm, pn; };
struct Gemm { const bf16_t* A; const bf16_t* Bt; int M, N, K; };

struct StaticOrder {
    int nM, nN, nwg, G, c;
    __host__ __device__ void init(int M, int N, int G_, int c_) { nM = M / BM; nN = N / BM; nwg = nM * nN; G = G_; c = c_; }
    __host__ __device__ bool next(int i, Unit& u) const {
        const long L = (long)i * G + c; if (L >= nwg) return false;
        int wgid = (int)L; { const int q = nwg / NXCD, r = nwg % NXCD, xcd = wgid % NXCD, off = wgid / NXCD; wgid = (xcd < r ? xcd * (q + 1) : r * (q + 1) + (xcd - r) * q) + off; }
        const int nig = WGM * nN, gid = wgid / nig, fm = gid * WGM, gsz = (nM - fm) < WGM ? (nM - fm) : WGM;
        u.pm = fm + ((wgid % nig) % gsz); u.pn = (wgid % nig) / gsz; return true;
    }
    __device__ __forceinline__ void a_ready(const Unit&) const {}
    __device__ __forceinline__ void done(const Unit&) const {}
};

__device__ __forceinline__ unsigned cvt_pk_bf16(float lo, float hi) { unsigned r; asm volatile("v_cvt_pk_bf16_f32 %0, %1, %2" : "=v"(r) : "v"(lo), "v"(hi)); return r; }
typedef float f32x2 __attribute__((ext_vector_type(2)));
__device__ __forceinline__ float bf_lo(unsigned w) { return __uint_as_float(w << 16); }
__device__ __forceinline__ float bf_hi(unsigned w) { return __uint_as_float(w & 0xffff0000u); }
__device__ __forceinline__ float fsigmoid(float x) { return __builtin_amdgcn_rcpf(1.f + __builtin_amdgcn_exp2f(-1.4426950408889634f * x)); }
__device__ __forceinline__ u32x4 pack8(const f32x4 v0, const f32x4 v1) { u32x4 w; w.x = cvt_pk_bf16(v0[0], v0[1]); w.y = cvt_pk_bf16(v0[2], v0[3]); w.z = cvt_pk_bf16(v1[0], v1[1]); w.w = cvt_pk_bf16(v1[2], v1[3]); return w; }
__device__ __forceinline__ void unpack8(const u32x4 w, f32x4& v0, f32x4& v1) { v0 = (f32x4){bf_lo(w.x), bf_hi(w.x), bf_lo(w.y), bf_hi(w.y)}; v1 = (f32x4){bf_lo(w.z), bf_hi(w.z), bf_lo(w.w), bf_hi(w.w)}; }
__device__ __forceinline__ float rstd_from_parts(const float* ssqp, int row) {
    const f32x4* p = (const f32x4*)(ssqp + (size_t)row * 16);
    const f32x4 a = p[0], b = p[1], c = p[2], d = p[3];
    const float s = (((a[0] + a[1]) + (a[2] + a[3])) + ((b[0] + b[1]) + (b[2] + b[3]))) + (((c[0] + c[1]) + (c[2] + c[3])) + ((d[0] + d[1]) + (d[2] + d[3])));
    return __builtin_amdgcn_rsqf(s * (1.0f / 1024.0f) + 1e-6f);
}
struct EpiRowScale {
    static constexpr bool PERM = true, AFTER_DRAIN = false;
    bf16_t* O; int ldc; const float* ssqp;
    __device__ __forceinline__ void operator()(const f32x4 (&acc)[2][2][4][2], const Unit& u, int wr, int wc, int fr, int fq) const {
        const int row0 = u.pm * BM + wr * 64 + fr, col0 = u.pn * BM + wc * 32 + 8 * fq;
#pragma unroll
        for (int ai = 0; ai < 2; ++ai)
#pragma unroll
            for (int m = 0; m < 4; ++m) { const int row = row0 + ai * HALF + m * 16; const float rs = rstd_from_parts(ssqp, row); bf16_t* rowp = O + (size_t)row * ldc + col0;
#pragma unroll
                for (int bj = 0; bj < 2; ++bj) *(u32x4*)(rowp + bj * HALF) = pack8(acc[ai][bj][m][0] * rs, acc[ai][bj][m][1] * rs); }
    }
};
template <bool ADD> struct EpiGate {
    static constexpr bool PERM = true, AFTER_DRAIN = false;
    const bf16_t* G; int ldg; const bf16_t* T; bf16_t* O;
    __device__ __forceinline__ void operator()(const f32x4 (&acc)[2][2][4][2], const Unit& u, int wr, int wc, int fr, int fq) const {
        const int row0 = u.pm * BM + wr * 64 + fr, col0 = u.pn * BM + wc * 32 + 8 * fq;
#pragma unroll
        for (int ai = 0; ai < 2; ++ai)
#pragma unroll
            for (int m = 0; m < 4; ++m) { const int row = row0 + ai * HALF + m * 16;
#pragma unroll
                for (int bj = 0; bj < 2; ++bj) { const int col = col0 + bj * HALF;
                    f32x4 g0, g1; unpack8(*(const u32x4*)(G + (size_t)row * ldg + col), g0, g1);
                    f32x4 v0 = acc[ai][bj][m][0], v1 = acc[ai][bj][m][1];
#pragma unroll
                    for (int i = 0; i < 4; ++i) { v0[i] *= fsigmoid(g0[i]); v1[i] *= fsigmoid(g1[i]); }
                    if (ADD) { f32x4 t0, t1; unpack8(*(const u32x4*)(T + (size_t)row * 1024 + col), t0, t1); v0 += t0; v1 += t1; }
                    *(u32x4*)(O + (size_t)row * 1024 + col) = pack8(v0, v1); } }
    }
};
struct EpiResid {
    static constexpr bool PERM = true, AFTER_DRAIN = false;
    const float* res; float* out; bf16_t* ob; float* ssqp;
    __device__ __forceinline__ void operator()(const f32x4 (&acc)[2][2][4][2], const Unit& u, int wr, int wc, int fr, int fq) const {
        const int row0 = u.pm * BM + wr * 64 + fr, col0 = u.pn * BM + wc * 32 + 8 * fq;
#pragma unroll
        for (int ai = 0; ai < 2; ++ai)
#pragma unroll
            for (int m = 0; m < 4; ++m) { const int row = row0 + ai * HALF + m * 16; float ss = 0.f;
#pragma unroll
                for (int bj = 0; bj < 2; ++bj) { const size_t off = (size_t)row * 1024 + col0 + bj * HALF;
                    const f32x4 v0 = acc[ai][bj][m][0] + *(const f32x4*)(res + off), v1 = acc[ai][bj][m][1] + *(const f32x4*)(res + off + 4);
                    *(f32x4*)(out + off) = v0; *(f32x4*)(out + off + 4) = v1; *(u32x4*)(ob + off) = pack8(v0, v1);
                    ss += ((v0[0] * v0[0] + v0[1] * v0[1]) + (v0[2] * v0[2] + v0[3] * v0[3])) + ((v1[0] * v1[0] + v1[1] * v1[1]) + (v1[2] * v1[2] + v1[3] * v1[3])); }
                ss += __shfl_xor(ss, 16); ss += __shfl_xor(ss, 32);
                if (fq == 0) ssqp[(size_t)row * 16 + u.pn * 4 + wc] = ss; }
    }
};
template <bool GROUPED> struct EpiSwiGLU {
    static constexpr bool PERM = true, AFTER_DRAIN = false;
    bf16_t* O; int ldo; int nct; const float* ssqp; const float* meta;
    __device__ __forceinline__ void operator()(const f32x4 (&acc)[2][2][4][2], const Unit& u, int wr, int wc, int fr, int fq) const {
        const int row0 = u.pm * BM + wr * 64 + fr, col0 = (u.pn % nct) * HALF + wc * 32 + 8 * fq;
#pragma unroll
        for (int ai = 0; ai < 2; ++ai)
#pragma unroll
            for (int m = 0; m < 4; ++m) { const int row = row0 + ai * HALF + m * 16; float rs, gt;
                if (GROUPED) { const f32x2 mt = *(const f32x2*)(meta + (size_t)row * 4); rs = mt.x; gt = mt.y; } else { rs = rstd_from_parts(ssqp, row); gt = 1.f; }
                f32x4 o[2];
#pragma unroll
                for (int n = 0; n < 2; ++n)
#pragma unroll
                    for (int i = 0; i < 4; ++i) { const float a1 = acc[ai][0][m][n][i] * rs, a3 = acc[ai][1][m][n][i] * rs; o[n][i] = a1 * fsigmoid(a1) * a3 * gt; }
                *(u32x4*)(O + (size_t)row * ldo + col0) = pack8(o[0], o[1]); }
    }
};
struct EpiPlain {
    static constexpr bool PERM = true, AFTER_DRAIN = false;
    bf16_t* O; int ldo; int nct;
    __device__ __forceinline__ void operator()(const f32x4 (&acc)[2][2][4][2], const Unit& u, int wr, int wc, int fr, int fq) const {
        const int row0 = u.pm * BM + wr * 64 + fr, col0 = (u.pn % nct) * BM + wc * 32 + 8 * fq;
#pragma unroll
        for (int ai = 0; ai < 2; ++ai)
#pragma unroll
            for (int m = 0; m < 4; ++m) { bf16_t* rowp = O + (size_t)(row0 + ai * HALF + m * 16) * ldo + col0;
#pragma unroll
                for (int bj = 0; bj < 2; ++bj) *(u32x4*)(rowp + bj * HALF) = pack8(acc[ai][bj][m][0], acc[ai][bj][m][1]); }
    }
};
struct GroupedOrder {
    int nct, G, c, nrt, t1, t2, t3, t4, t5, t6, t7;
    __device__ __forceinline__ bool next(int i, Unit& u) const {
        const long L = (long)i * G + c; if (L >= (long)nrt * nct) return false;
        const int rt = (int)(L / nct), ct = (int)(L % nct);
        const int e = (rt >= t1) + (rt >= t2) + (rt >= t3) + (rt >= t4) + (rt >= t5) + (rt >= t6) + (rt >= t7);
        u.pm = rt; u.pn = e * nct + ct; return true;
    }
    __device__ __forceinline__ void a_ready(const Unit&) const {}
    __device__ __forceinline__ void done(const Unit&) const {}
};
template <class Epi, class Sched, bool ALIGN_EPI = false, bool SP2 = false>
__device__ __forceinline__ void gemm_phase(PG8_LAS unsigned char* lds, const Gemm g, const Sched& S, const Epi& E) {
    int tid_ = threadIdx.x; asm volatile("" : "+v"(tid_));
    const int tid = tid_, wid = __builtin_amdgcn_readfirstlane(tid >> 6), lane = tid & 63, wr = wid >> 2, wc = wid & 3, fr = lane & 15, fq = lane >> 4;
    const int K = g.K, nt = K / BK;
    unsigned voffA[2], voffB[2];
#pragma unroll
    for (int i = 0; i < 2; ++i) { int R, C; stage_rc(tid * 16 + i * 8192, R, C); const int Rb = Epi::PERM ? ((R & ~31) + perm32(R & 31)) : R;
        voffA[i] = (unsigned)(R * K + C) * 2u; voffB[i] = (unsigned)(Rb * K + C) * 2u; }
    const size_t kstep = (size_t)(BK * 2);
    const size_t hstep = (size_t)HALF * K * 2;
    const size_t tstep = 2 * hstep;
    const unsigned ldsw = (unsigned)wid * 1024u;
    const int aoff = lds_byte(wr * 64 + fr, fq * 8), boff = lds_byte(wc * 32 + fr, fq * 8);
#define PG8_SA(b, h) (((b) * 2 + (h)) * HTB)
#define PG8_SB(b, h) ((4 + (b) * 2 + (h)) * HTB)
#define PG8_STAGE(bufoff, gbase, voff) do { _Pragma("unroll") for (int _i = 0; _i < 2; ++_i) \
        __builtin_amdgcn_global_load_lds((const unsigned*)((const char*)(gbase) + (voff)[_i]), (PG8_LAS unsigned*)(lds + (bufoff) + ldsw + _i * 8192), 16, 0, 0); } while (0)
#define PG8_LDA(dst, b, h) do { _Pragma("unroll") for (int m = 0; m < 4; ++m) _Pragma("unroll") for (int k = 0; k < 2; ++k) dst[m][k] = *(const PG8_LAS bf16x8*)(lds + PG8_SA(b, h) + aoff + m * 2048 + k * 1024); } while (0)
#define PG8_LDB(dst, b, h) do { _Pragma("unroll") for (int n = 0; n < 2; ++n) _Pragma("unroll") for (int k = 0; k < 2; ++k) dst[n][k] = *(const PG8_LAS bf16x8*)(lds + PG8_SB(b, h) + boff + n * 2048 + k * 1024); } while (0)
#define PG8_MMA(ai, bj, At, Bt) do { __builtin_amdgcn_s_setprio(1); _Pragma("unroll") for (int m = 0; m < 4; ++m) _Pragma("unroll") for (int n = 0; n < 2; ++n) _Pragma("unroll") for (int k = 0; k < 2; ++k) \
        acc[ai][bj][m][n] = __builtin_amdgcn_mfma_f32_16x16x32_bf16(Bt[n][k], At[m][k], acc[ai][bj][m][n], 0, 0, 0); __builtin_amdgcn_s_setprio(0); } while (0)
#define PG8_WAIT_V(n) asm volatile("s_waitcnt vmcnt(" #n ")" ::: "memory")
#define PG8_WAIT_L(n) asm volatile("s_waitcnt lgkmcnt(" #n ")" ::: "memory")
#define PG8_BAR __builtin_amdgcn_s_barrier()
#define PG8_SCHED __builtin_amdgcn_sched_barrier(0)
    Unit cur, nxt; int ui = 0;
    if (!S.next(0, cur)) return;
    f32x4 acc[2][2][4][2];
#pragma unroll
    for (int a = 0; a < 2; ++a)
#pragma unroll
        for (int b = 0; b < 2; ++b)
#pragma unroll
            for (int m = 0; m < 4; ++m)
#pragma unroll
                for (int n = 0; n < 2; ++n) acc[a][b][m][n] = (f32x4){0.f, 0.f, 0.f, 0.f};
    bf16x8 At[4][2], B0[2][2], B1[2][2];
    const char* cA = (const char*)g.A + (size_t)cur.pm * tstep; const char* cB = (const char*)g.Bt + (size_t)cur.pn * tstep;
    S.a_ready(cur);
    if constexpr (SP2) {
        PG8_STAGE(PG8_SB(0, 0), cB, voffB); PG8_STAGE(PG8_SB(0, 1), cB + hstep, voffB); PG8_STAGE(PG8_SA(0, 0), cA, voffA); PG8_STAGE(PG8_SA(0, 1), cA + hstep, voffA);
        if (wr == 1) PG8_BAR;
        PG8_WAIT_V(2); PG8_BAR;
        PG8_STAGE(PG8_SB(1, 0), cB + kstep, voffB); PG8_STAGE(PG8_SA(1, 0), cA + kstep, voffA); PG8_STAGE(PG8_SB(1, 1), cB + hstep + kstep, voffB);
        PG8_WAIT_V(6); PG8_BAR;
    } else {
        PG8_STAGE(PG8_SB(0, 0), cB, voffB); PG8_STAGE(PG8_SA(0, 0), cA, voffA); PG8_STAGE(PG8_SB(0, 1), cB + hstep, voffB); PG8_STAGE(PG8_SA(0, 1), cA + hstep, voffA);
        if (wr == 1) PG8_BAR;
        PG8_WAIT_V(4); PG8_BAR;
        PG8_STAGE(PG8_SB(1, 0), cB + kstep, voffB); PG8_STAGE(PG8_SA(1, 0), cA + kstep, voffA); PG8_STAGE(PG8_SB(1, 1), cB + hstep + kstep, voffB);
        PG8_WAIT_V(6); PG8_BAR;
    }
    for (;;) {
        const bool has_next = S.next(ui + 1, nxt);
        const char* nA = has_next ? (const char*)g.A + (size_t)nxt.pm * tstep : cA; const char* nB = has_next ? (const char*)g.Bt + (size_t)nxt.pn * tstep : cB;
        for (int t = 0; t < nt; t += 2) {
            const bool last = (t == nt - 2);
            const char* a1 = cA + (size_t)(t + 1) * kstep;
            const char* a2 = last ? nA : cA + (size_t)(t + 2) * kstep; const char* b2 = last ? nB : cB + (size_t)(t + 2) * kstep;
            const char* a3 = a2 + kstep; const char* b3 = b2 + kstep;
            if (last && has_next) S.a_ready(nxt);
            if constexpr (SP2) {
            PG8_LDB(B0, 0, 0); PG8_LDB(B1, 0, 1); PG8_SCHED; PG8_LDA(At, 0, 0); PG8_STAGE(PG8_SA(1, 1), a1 + hstep, voffA);
            PG8_WAIT_V(8); PG8_WAIT_L(0); PG8_BAR; PG8_MMA(0, 0, At, B0); PG8_MMA(0, 1, At, B1); PG8_BAR; PG8_SCHED;
            PG8_LDA(At, 0, 1); PG8_STAGE(PG8_SB(0, 0), b2, voffB); PG8_STAGE(PG8_SB(0, 1), b2 + hstep, voffB); PG8_STAGE(PG8_SA(0, 0), a2, voffA);
            PG8_WAIT_V(8); PG8_WAIT_L(0); PG8_BAR; PG8_MMA(1, 0, At, B0); PG8_MMA(1, 1, At, B1); PG8_BAR; PG8_SCHED;
            PG8_LDB(B0, 1, 0); PG8_LDB(B1, 1, 1); PG8_SCHED; PG8_LDA(At, 1, 0); PG8_STAGE(PG8_SA(0, 1), a2 + hstep, voffA);
            PG8_WAIT_V(8); PG8_WAIT_L(0); PG8_BAR; PG8_MMA(0, 0, At, B0); PG8_MMA(0, 1, At, B1); PG8_BAR; PG8_SCHED;
            PG8_LDA(At, 1, 1); PG8_STAGE(PG8_SB(1, 0), b3, voffB); PG8_STAGE(PG8_SB(1, 1), b3 + hstep, voffB); PG8_STAGE(PG8_SA(1, 0), a3, voffA);
            PG8_WAIT_V(8); PG8_WAIT_L(0); PG8_BAR; PG8_MMA(1, 0, At, B0); PG8_MMA(1, 1, At, B1); PG8_BAR; PG8_SCHED;
            } else {
            PG8_LDB(B0, 0, 0); PG8_SCHED; PG8_LDA(At, 0, 0); PG8_STAGE(PG8_SA(1, 1), a1 + hstep, voffA);
            PG8_WAIT_L(8); PG8_BAR; PG8_WAIT_L(0); PG8_MMA(0, 0, At, B0); PG8_BAR; PG8_SCHED;
            PG8_LDB(B1, 0, 1); PG8_STAGE(PG8_SB(0, 0), b2, voffB);
            PG8_BAR; PG8_WAIT_L(0); PG8_MMA(0, 1, At, B1); PG8_BAR;
            PG8_LDA(At, 0, 1); PG8_STAGE(PG8_SA(0, 0), a2, voffA);
            PG8_BAR; PG8_WAIT_L(0); PG8_MMA(1, 0, At, B0); PG8_BAR; PG8_SCHED;
            PG8_STAGE(PG8_SB(0, 1), b2 + hstep, voffB);
            PG8_WAIT_V(6); PG8_BAR; PG8_MMA(1, 1, At, B1); PG8_BAR;
            PG8_LDB(B0, 1, 0); PG8_SCHED; PG8_LDA(At, 1, 0); PG8_STAGE(PG8_SA(0, 1), a2 + hstep, voffA);
            PG8_WAIT_L(8); PG8_BAR; PG8_WAIT_L(0); PG8_MMA(0, 0, At, B0); PG8_BAR; PG8_SCHED;
            PG8_LDB(B1, 1, 1); PG8_STAGE(PG8_SB(1, 0), b3, voffB);
            PG8_BAR; PG8_WAIT_L(0); PG8_MMA(0, 1, At, B1); PG8_BAR;
            PG8_LDA(At, 1, 1); PG8_STAGE(PG8_SA(1, 0), a3, voffA);
            PG8_BAR; PG8_WAIT_L(0); PG8_MMA(1, 0, At, B0); PG8_BAR; PG8_SCHED;
            PG8_STAGE(PG8_SB(1, 1), b3 + hstep, voffB);
            PG8_WAIT_V(6); PG8_BAR; PG8_MMA(1, 1, At, B1); PG8_BAR;
            }
        }
        if constexpr (ALIGN_EPI) { if (wr == 0) PG8_BAR; }
        if constexpr (!Epi::AFTER_DRAIN) { E(acc, cur, wr, wc, fr, fq); S.done(cur); }
        if (!has_next) break;
#pragma unroll
        for (int a = 0; a < 2; ++a)
#pragma unroll
            for (int b = 0; b < 2; ++b)
#pragma unroll
                for (int m = 0; m < 4; ++m)
#pragma unroll
                    for (int n = 0; n < 2; ++n) acc[a][b][m][n] = (f32x4){0.f, 0.f, 0.f, 0.f};
        cur = nxt; cA = nA; cB = nB; ++ui;
        if constexpr (ALIGN_EPI) { if (wr == 1) PG8_BAR; }
    }
    PG8_WAIT_V(0);
    if constexpr (!ALIGN_EPI) { if (wr == 0) PG8_BAR; }
    PG8_BAR;
    if constexpr (Epi::AFTER_DRAIN) { E.fused(acc, cur, wr, wc, fr, fq, lds, wid, lane); S.done(cur); }
#undef PG8_SA
#undef PG8_SB
#undef PG8_STAGE
#undef PG8_LDA
#undef PG8_LDB
#undef PG8_MMA
#undef PG8_WAIT_V
#undef PG8_WAIT_L
#undef PG8_BAR
#undef PG8_SCHED
}
}
#include <hip/hip_bf16.h>
#include <cmath>
namespace attn_body {
using bf16=__hip_bfloat16;
using bf16x8=__attribute__((ext_vector_type(8)))short;
using s16x4=__attribute__((ext_vector_type(4)))short;
using f32x16=__attribute__((ext_vector_type(16)))float;
using u32x4=__attribute__((ext_vector_type(4)))unsigned;
constexpr int BATCH=2,NHEAD=8,SEQ=8192,D=64,DM=NHEAD*D;
constexpr int NW=8,QBLK=32,QB=QBLK*NW,KVBLK=64,NQB=SEQ/QB;
constexpr int ATTN_PITCH=DM, ATTN_UNIT_ROWS=QB;
__device__ __forceinline__ int crow(int r,int hi){return (r&3)+8*(r>>2)+4*hi;}
#define SBAR() __builtin_amdgcn_sched_barrier(0)
typedef const __attribute__((address_space(4))) unsigned long long* cmask_ptr;
__device__ __forceinline__ float msel(unsigned long long m,float if_set,float if_clear){float r;asm("v_cndmask_b32_e64 %0, %1, %2, %3":"=v"(r):"v"(if_clear),"v"(if_set),"s"(m));return r;}
__device__ __forceinline__ void mkc(f32x16&c,cmask_ptr mp,float negmh,float ninf){
  #pragma unroll
  for(int r=0;r<16;++r)c[r]=msel(mp[r],negmh,ninf);
}

constexpr int NSLOT=3, SLOTB=8192;
constexpr int LDS_K=0, LDS_V=NSLOT*SLOTB, LDS_WS=2*NSLOT*SLOTB, LDS_OST=LDS_WS+NW*64*4, LDS_BYTES=LDS_OST+NW*4096;
constexpr float C2=0.125f*1.4426950408889634f;
__device__ __forceinline__ void glds16(const void*gsrc,unsigned lds_dst){unsigned keep;
  asm volatile("s_mov_b32 %0, m0\n\ts_mov_b32 m0, %2\n\ts_nop 0\n\tglobal_load_lds_dwordx4 %1, off\n\ts_mov_b32 m0, %0":"=&s"(keep):"v"(gsrc),"s"(lds_dst):"memory");}
__device__ __forceinline__ float max3f(float a,float b,float c){float r;asm("v_max3_f32 %0, %1, %2, %3":"=v"(r):"v"(a),"v"(b),"v"(c));return r;}
__device__ __forceinline__ float max2f(float a,float b){float r;asm("v_max_f32_e32 %0, %1, %2":"=v"(r):"v"(a),"v"(b));return r;}
__device__ __forceinline__ float fadd_s(float a,float b){float r;asm("v_add_f32_e32 %0, %1, %2":"=v"(r):"v"(a),"v"(b));return r;}
__device__ __forceinline__ float fsub_s(float a,float b){float r;asm("v_sub_f32_e32 %0, %1, %2":"=v"(r):"v"(a),"v"(b));return r;}
typedef float f32x2_t __attribute__((ext_vector_type(2))); typedef __bf16 bf16x2_t __attribute__((ext_vector_type(2)));
__device__ __forceinline__ unsigned cvtpk_s(float lo,float hi){f32x2_t v={lo,hi};bf16x2_t b=__builtin_convertvector(v,bf16x2_t);return __builtin_bit_cast(unsigned,b);}
#define WAIT_BAR(N) asm volatile("s_waitcnt vmcnt(" #N ") lgkmcnt(0)\n\ts_barrier":::"memory")

__device__ __forceinline__ void qkt(f32x16&p0,f32x16&p1,const char*Kslot,const bf16x8*qr,int r32,int hi){
  const char*kb=Kslot+hi*1024+r32*16;
  #pragma unroll
  for(int d0=0;d0<4;++d0){
    const bf16x8 b0=*reinterpret_cast<const bf16x8*>(kb+d0*2048);
    const bf16x8 b1=*reinterpret_cast<const bf16x8*>(kb+d0*2048+512);
    p0=__builtin_amdgcn_mfma_f32_32x32x16_bf16(b0,qr[d0],p0,0,0,0);p1=__builtin_amdgcn_mfma_f32_32x32x16_bf16(b1,qr[d0],p1,0,0,0);}
}
typedef __attribute__((address_space(3))) const char* lds_cptr;
typedef short v4i16_t __attribute__((ext_vector_type(4)));
__device__ __forceinline__ void kload8(bf16x8*kf,lds_cptr kp){
  kf[0]=*(const __attribute__((address_space(3))) bf16x8*)(kp);      kf[1]=*(const __attribute__((address_space(3))) bf16x8*)(kp+512);
  kf[2]=*(const __attribute__((address_space(3))) bf16x8*)(kp+2048); kf[3]=*(const __attribute__((address_space(3))) bf16x8*)(kp+2560);
  kf[4]=*(const __attribute__((address_space(3))) bf16x8*)(kp+4096); kf[5]=*(const __attribute__((address_space(3))) bf16x8*)(kp+4608);
  kf[6]=*(const __attribute__((address_space(3))) bf16x8*)(kp+6144); kf[7]=*(const __attribute__((address_space(3))) bf16x8*)(kp+6656);
}
__device__ __forceinline__ void kload2(bf16x8*kf,lds_cptr kp,int j){ kf[2*j]=*(const __attribute__((address_space(3))) bf16x8*)(kp+j*2048); kf[2*j+1]=*(const __attribute__((address_space(3))) bf16x8*)(kp+j*2048+512); }
__device__ __forceinline__ s16x4 vtr(lds_cptr p){ return __builtin_bit_cast(s16x4,__builtin_amdgcn_ds_read_tr16_b64_v4i16((__attribute__((address_space(3))) v4i16_t*)p)); }
__device__ __forceinline__ float rowmax(const f32x16&p0,const f32x16&p1){
  float a=max3f(p0[0],p0[1],p1[0]),b=max3f(p0[2],p0[3],p1[1]);a=max3f(a,p1[2],p1[3]);
  #pragma unroll
  for(int r=4;r<16;r+=4){a=max3f(a,p0[r],p0[r+1]);b=max3f(b,p0[r+2],p0[r+3]);a=max3f(a,p1[r],p1[r+1]);b=max3f(b,p1[r+2],p1[r+3]);}
  const float m=max2f(a,b);
  auto rr=__builtin_amdgcn_permlane32_swap(__float_as_uint(m),__float_as_uint(m),false,false);
  return max2f(__uint_as_float(rr[0]),__uint_as_float(rr[1]));
}
__device__ __forceinline__ void pv(f32x16*o,int vb,bf16x8 pa0,bf16x8 pa1,bf16x8 pa2,bf16x8 pa3){
  #pragma unroll
  for(int d0=0;d0<2;++d0){s16x4 lo[4],hi[4];
    #pragma unroll
    for(int ks=0;ks<4;++ks){
      asm volatile("ds_read_b64_tr_b16 %0,%1 offset:%c2":"=&v"(lo[ks]):"v"(vb),"i"(d0*4096+ks*1024):"memory");
      asm volatile("ds_read_b64_tr_b16 %0,%1 offset:%c2":"=&v"(hi[ks]):"v"(vb),"i"(d0*4096+ks*1024+512):"memory");}
    asm volatile("s_waitcnt lgkmcnt(0)":::"memory");SBAR();
    #define PK(k) (bf16x8){lo[k][0],lo[k][1],lo[k][2],lo[k][3],hi[k][0],hi[k][1],hi[k][2],hi[k][3]}
    o[d0]=__builtin_amdgcn_mfma_f32_32x32x16_bf16(pa0,PK(0),o[d0],0,0,0);
    o[d0]=__builtin_amdgcn_mfma_f32_32x32x16_bf16(pa1,PK(1),o[d0],0,0,0);
    o[d0]=__builtin_amdgcn_mfma_f32_32x32x16_bf16(pa2,PK(2),o[d0],0,0,0);
    o[d0]=__builtin_amdgcn_mfma_f32_32x32x16_bf16(pa3,PK(3),o[d0],0,0,0);
    #undef PK
  }
}

#ifndef ATTN_STORE16
#define ATTN_STORE16(p,v) (*(u32x4*)(p)=(v))
#endif
template<int THRL> __device__ __forceinline__ void attn_unit(int b,int h,int qb,const bf16*Q,const bf16*__restrict__ K,const bf16*__restrict__ V,bf16*O,const unsigned long long*MASK,char*shm){
  int tid_=threadIdx.x; asm volatile("":"+v"(tid_)); const int tid=tid_,lane=tid&63,r32=lane&31,hi=lane>>5; const int wid=__builtin_amdgcn_readfirstlane(tid>>6);
  const long rowbase=(long)b*SEQ; const int q0=qb*QB;
  const bf16*Qw=Q+(rowbase+q0+wid*QBLK)*DM+h*D;
  const bf16*Kh=K+rowbase*DM+h*D,*Vh=V+rowbase*DM+h*D;
  const unsigned lds0=(unsigned)(uintptr_t)shm;
  float*wsf=(float*)(shm+LDS_WS)+wid*64;
  const bf16*ksrc=Kh+(long)lane*DM+wid*8;
  const bf16*vsrc=Vh+(long)(16*(wid&3)+(lane>>2))*DM+(wid>>2)*32+(lane&3)*8;
  const unsigned kdst=lds0+LDS_K+wid*1024, vdst=lds0+LDS_V+wid*1024;
  #define DMA_K(t,slot) glds16(ksrc+(long)(t)*KVBLK*DM,(unsigned)__builtin_amdgcn_readfirstlane(kdst+(slot)))
  #define DMA_V(t,slot) glds16(vsrc+(long)(t)*KVBLK*DM,(unsigned)__builtin_amdgcn_readfirstlane(vdst+(slot)))
  const int vb0=(int)(lds0+LDS_V)+((lane>>4)&1)*32+(lane&3)*8+(4*hi+((lane&15)>>2))*64;
  const char*Kbase=shm+LDS_K; bf16x8 kf[8];
  const lds_cptr shm3=(lds_cptr)shm; const lds_cptr kp0=shm3+LDS_K+hi*1024+r32*16; const lds_cptr vp0=shm3+LDS_V+((lane>>4)&1)*32+(lane&3)*8+(4*hi+((lane&15)>>2))*64;
  const int NT=(q0+QB)/KVBLK;
  DMA_K(0,0);DMA_V(0,0);DMA_K(1,SLOTB);
  bf16x8 qr[4];
  #pragma unroll
  for(int d0=0;d0<4;++d0)qr[d0]=*reinterpret_cast<const bf16x8*>(&Qw[(long)r32*DM+d0*16+hi*8]);
  float mhat=0.f,l_reg=0.f,negmh=0.f;f32x16 o[2];o[0]=f32x16{};o[1]=f32x16{};float NINF=-INFINITY;asm volatile("":"+v"(NINF));
  unsigned long long mbase=(unsigned long long)(uintptr_t)(MASK+((size_t)((b*256+qb*8+wid)*128))*32);asm volatile("":"+s"(mbase));
  const cmask_ptr mp0=(cmask_ptr)mbase;
  bool resc=false;
  #define RESC() do{ if(resc){ asm volatile("s_waitcnt lgkmcnt(0)":::"memory"); \
      _Pragma("unroll") for(int d_=0;d_<2;++d_) _Pragma("unroll") for(int r=0;r<16;++r)o[d_][r]*=wsf[crow(r,hi)]; } }while(0)
  f32x16 pA0,pA1,pB0,pB1;
  int sl_prev=0,sl_cur=0,sl_next=SLOTB;
  #define ROT() do{sl_prev=sl_cur;sl_cur=sl_next;sl_next=(sl_next==(NSLOT-1)*SLOTB)?0:sl_next+SLOTB;}while(0)
  DMA_K(2,2*SLOTB);
  WAIT_BAR(3);
  mkc(pA0,mp0,negmh,NINF);mkc(pA1,mp0+16,negmh,NINF);
  qkt(pA0,pA1,Kbase,qr,r32,hi);asm volatile("s_nop 15\n\ts_nop 7":"+v"(pA0),"+v"(pA1));
  { const float rm=rowmax(pA0,pA1);
    if(__any(rm>(float)THRL)){ const float dl=__builtin_fmaxf(rm,0.f); mhat+=dl; negmh=-mhat;
      _Pragma("unroll") for(int r=0;r<16;++r){pA0[r]-=dl;pA1[r]-=dl;} } }
  _Pragma("unroll") for(int r=0;r<16;++r){pA0[r]=__builtin_amdgcn_exp2f(pA0[r]);pA1[r]=__builtin_amdgcn_exp2f(pA1[r]);}
  WAIT_BAR(0);
  DMA_K(3,0);DMA_V(1,SLOTB);
  ROT();
  kload8(kf,kp0+sl_cur);
  WAIT_BAR(2);
  s16x4 vlo[8],vhi[8]; u32x4 pw0,pw1,pw2,pw3;
  #define PKW(P,B) cvtpk_s(P[B],P[B+1])
  #define PAF(k) __builtin_bit_cast(bf16x8,pw##k)
  #define VFR(i) (bf16x8){vlo[i][0],vlo[i][1],vlo[i][2],vlo[i][3],vhi[i][0],vhi[i][1],vhi[i][2],vhi[i][3]}
  #define PIN(x) asm volatile("":"+v"(x))
  #define MX3(a,b,c) __builtin_fmaxf(__builtin_fmaxf((a),(b)),(c))
  #define GAPA(MF,A0,A1,A2,A3,W0,W1,PW) do{ MF; sacc+=A0; sacc+=A1; sacc+=A2; sacc+=A3; PIN(sacc); W0; W1; PIN(PW); SBAR(); }while(0)
  #define EX(v) __builtin_amdgcn_exp2f(v)
  #define GAPB(MF,X,B) do{ MF; X[B]=EX(X[B]); X[B+1]=EX(X[B+1]); X[B+2]=EX(X[B+2]); X[B+3]=EX(X[B+3]); PIN(X); SBAR(); }while(0)
  #define VRD(i) do{ vlo[i]=vtr(vp_+(((i)>>2)*4096+((i)&3)*1024)); vhi[i]=vtr(vp_+(((i)>>2)*4096+((i)&3)*1024+512)); }while(0)
  #define KRD(G,j) do{ if(G){ kload2(kf,kp0+sl_next,j); SBAR(); } }while(0)
  #define STEP(C0,C1,P0,P1,t,GK,GV,GL) do{ SBAR(); \
    { const cmask_ptr mp_=mp0+(size_t)(t)*32; mkc(C0,mp_,negmh,NINF); mkc(C1,mp_+16,negmh,NINF); } SBAR(); \
    const lds_cptr vp_=vp0+sl_prev; \
    VRD(0); SBAR(); float sacc=(P0[0]+P0[1]); \
    GAPA(C0=__builtin_amdgcn_mfma_f32_32x32x16_bf16(kf[0],qr[0],C0,0,0,0), P0[2],P0[3],P0[4],P0[5],     pw0[0]=PKW(P0,0), pw0[1]=PKW(P0,2), pw0); \
    VRD(4); SBAR(); GAPA(C1=__builtin_amdgcn_mfma_f32_32x32x16_bf16(kf[1],qr[0],C1,0,0,0), P0[6],P0[7],P0[8],P0[9],     pw0[2]=PKW(P0,4), pw0[3]=PKW(P0,6), pw0); \
    VRD(1); SBAR(); GAPA(C0=__builtin_amdgcn_mfma_f32_32x32x16_bf16(kf[2],qr[1],C0,0,0,0),   P0[10],P0[11],P0[12],P0[13], pw1[0]=PKW(P0,8), pw1[1]=PKW(P0,10), pw1); \
    VRD(5); SBAR(); GAPA(C1=__builtin_amdgcn_mfma_f32_32x32x16_bf16(kf[3],qr[1],C1,0,0,0),   P0[14],P0[15],P1[0],P1[1],   pw1[2]=PKW(P0,12),pw1[3]=PKW(P0,14), pw1); \
    VRD(2); SBAR(); GAPA(C0=__builtin_amdgcn_mfma_f32_32x32x16_bf16(kf[4],qr[2],C0,0,0,0),   P1[2],P1[3],P1[4],P1[5],     pw2[0]=PKW(P1,0), pw2[1]=PKW(P1,2), pw2); \
    VRD(6); SBAR(); GAPA(C1=__builtin_amdgcn_mfma_f32_32x32x16_bf16(kf[5],qr[2],C1,0,0,0),   P1[6],P1[7],P1[8],P1[9],     pw2[2]=PKW(P1,4), pw2[3]=PKW(P1,6), pw2); \
    VRD(3); SBAR(); GAPA(C0=__builtin_amdgcn_mfma_f32_32x32x16_bf16(kf[6],qr[3],C0,0,0,0),   P1[10],P1[11],P1[12],P1[13], pw3[0]=PKW(P1,8), pw3[1]=PKW(P1,10), pw3); \
    VRD(7); SBAR(); GAPA(C1=__builtin_amdgcn_mfma_f32_32x32x16_bf16(kf[7],qr[3],C1,0,0,0),   P1[14],P1[15],0.f,0.f,       pw3[2]=PKW(P1,12),pw3[3]=PKW(P1,14), pw3); \
    l_reg+=sacc; \
    if(GK){DMA_K((t)+3,sl_cur);} if(GV){DMA_V((t)+1,sl_next);} \
    { float a=MX3(C0[0],C0[1],C1[0]),b=MX3(C0[2],C0[3],C1[1]); a=MX3(a,C1[2],C1[3]); \
      _Pragma("unroll") for(int r=4;r<16;r+=4){a=MX3(a,C0[r],C0[r+1]);b=MX3(b,C0[r+2],C0[r+3]);a=MX3(a,C1[r],C1[r+1]);b=MX3(b,C1[r+2],C1[r+3]);} \
      float rm=__builtin_fmaxf(a,b); { auto rr=__builtin_amdgcn_permlane32_swap(__float_as_uint(rm),__float_as_uint(rm),false,false); rm=__builtin_fmaxf(__uint_as_float(rr[0]),__uint_as_float(rr[1])); } \
      resc=false; \
      if(__builtin_expect(__any(rm>(float)THRL),0)){ const float dl=__builtin_fmaxf(rm,0.f); mhat+=dl; \
        _Pragma("unroll") for(int r=0;r<16;++r){C0[r]-=dl;C1[r]-=dl;} \
        negmh=-mhat; \
        const float f=__builtin_amdgcn_exp2f(-dl); l_reg*=f; if(hi==0)wsf[r32]=f; resc=true; } } \
    SBAR(); \
    GAPB(o[0]=__builtin_amdgcn_mfma_f32_32x32x16_bf16(PAF(0),VFR(0),o[0],0,0,0), C0,0); \
    GAPB(o[1]=__builtin_amdgcn_mfma_f32_32x32x16_bf16(PAF(0),VFR(4),o[1],0,0,0), C0,4); \
    KRD(GL,0); GAPB(o[0]=__builtin_amdgcn_mfma_f32_32x32x16_bf16(PAF(1),VFR(1),o[0],0,0,0), C0,8); \
    KRD(GL,1); GAPB(o[1]=__builtin_amdgcn_mfma_f32_32x32x16_bf16(PAF(1),VFR(5),o[1],0,0,0), C0,12); \
    KRD(GL,2); GAPB(o[0]=__builtin_amdgcn_mfma_f32_32x32x16_bf16(PAF(2),VFR(2),o[0],0,0,0), C1,0); \
    KRD(GL,3); GAPB(o[1]=__builtin_amdgcn_mfma_f32_32x32x16_bf16(PAF(2),VFR(6),o[1],0,0,0), C1,4); \
    GAPB(o[0]=__builtin_amdgcn_mfma_f32_32x32x16_bf16(PAF(3),VFR(3),o[0],0,0,0), C1,8); \
    GAPB(o[1]=__builtin_amdgcn_mfma_f32_32x32x16_bf16(PAF(3),VFR(7),o[1],0,0,0), C1,12); \
    }while(0)
  int t=1;
  for(;t+5<NT;t+=2){
    STEP(pB0,pB1,pA0,pA1,t,true,true,true);     WAIT_BAR(2); RESC(); ROT();
    STEP(pA0,pA1,pB0,pB1,t+1,true,true,true);   WAIT_BAR(2); RESC(); ROT();
  }
  #define ENDW(tt) do{ if((tt)+3<NT){WAIT_BAR(2);} else if((tt)+2<NT){WAIT_BAR(1);} else {WAIT_BAR(0);} }while(0)
  for(;t+1<NT;t+=2){
    STEP(pB0,pB1,pA0,pA1,t,(t+3<NT),(t+1<NT),(t+1<NT));       ENDW(t);   RESC(); ROT();
    STEP(pA0,pA1,pB0,pB1,t+1,(t+4<NT),(t+2<NT),(t+2<NT));     ENDW(t+1); RESC(); ROT();
  }
  STEP(pB0,pB1,pA0,pA1,NT-1,false,false,false); RESC();
  { float sacc=pB0[0]+pB0[1]; _Pragma("unroll") for(int r=2;r<16;++r)sacc+=pB0[r]; _Pragma("unroll") for(int r=0;r<16;++r)sacc+=pB1[r]; l_reg+=sacc;
    pw0=(u32x4){PKW(pB0,0),PKW(pB0,2),PKW(pB0,4),PKW(pB0,6)};pw1=(u32x4){PKW(pB0,8),PKW(pB0,10),PKW(pB0,12),PKW(pB0,14)};pw2=(u32x4){PKW(pB1,0),PKW(pB1,2),PKW(pB1,4),PKW(pB1,6)};pw3=(u32x4){PKW(pB1,8),PKW(pB1,10),PKW(pB1,12),PKW(pB1,14)};
    SBAR(); pv(o,vb0+sl_cur,PAF(0),PAF(1),PAF(2),PAF(3)); }
  #undef PKW
  #undef PAF
  #undef VFR
  #undef PIN
  #undef MX3
  #undef GAPA
  #undef GAPB
  #undef EX
  #undef VRD
  #undef KRD
  #undef STEP
  #undef ENDW
  {auto rr=__builtin_amdgcn_permlane32_swap(__float_as_uint(l_reg),__float_as_uint(l_reg),false,false);l_reg=__uint_as_float(rr[0])+__uint_as_float(rr[1]);}
  if(hi==0)wsf[32+r32]=l_reg;asm volatile("s_waitcnt lgkmcnt(0)":::"memory");
  float rli[16];
  #pragma unroll
  for(int r=0;r<16;++r)rli[r]=__builtin_amdgcn_rcpf(wsf[32+crow(r,hi)]);
  bf16*Ow=O+(rowbase+q0+wid*QBLK)*DM+h*D;
  { bf16*stg=(bf16*)(shm+LDS_OST)+wid*2048;
    #pragma unroll
    for(int r=0;r<16;++r){const int orow=crow(r,hi);
      #pragma unroll
      for(int d0=0;d0<2;++d0)stg[orow*64+d0*32+r32]=__float2bfloat16(o[d0][r]*rli[r]);}
    asm volatile("s_waitcnt lgkmcnt(0)":::"memory");
    #pragma unroll
    for(int i=0;i<4;++i){const int row=i*8+(lane>>3),ch=lane&7; const u32x4 v=*(const u32x4*)(stg+row*64+ch*8); ATTN_STORE16(Ow+(long)row*DM+ch*8,v);} }
  asm volatile("s_waitcnt lgkmcnt(0)\n\ts_barrier":::"memory");
  #undef DMA_K
  #undef DMA_V
  #undef RESC
  #undef ROT
}
constexpr int ATTN_LDS_BYTES=LDS_BYTES;
struct AttnTensors { const bf16* Q; const bf16* K; const bf16* V; bf16* O; const unsigned long long* MASK; };
struct AttnUnit { int bh; int qb; };
struct StaticOrder {
  int vcu,G;
  __device__ __forceinline__ explicit StaticOrder(int grid,int block):vcu((grid%8==0)?(block%8)*(grid/8)+block/8:block),G(grid){}
  __device__ __forceinline__ bool next(int i,AttnUnit&u)const{ const int idx=vcu+i*G; if(idx>=512)return false; const int j=idx&255,s=j&15; u.bh=j>>4; u.qb=(idx<256)?s:31-s; return true; }
  __device__ __forceinline__ void a_ready(const AttnUnit&)const{}
  __device__ __forceinline__ void done(const AttnUnit&)const{}
};
template<class Sched,int THRL=8> __device__ __forceinline__ void attn_phase(char*lds,const AttnTensors&T,const Sched&S){
  AttnUnit u;
  for(int i=0;S.next(i,u);++i){ S.a_ready(u); attn_unit<THRL>(u.bh/NHEAD,u.bh%NHEAD,u.qb,T.Q,T.K,T.V,T.O,T.MASK,lds); S.done(u); }
}
#undef SBAR
#undef WAIT_BAR
}
constexpr int NWAVES = 8;
#ifndef MK_PER_PHASE
#define MK_PER_PHASE 0
#endif
constexpr int NPH = 20;

constexpr int BATCH = 2, T = 8192, D = 1024, M = BATCH * T;
constexpr int INW = 4392, INP = 4608;
constexpr int ZQ = 0, ZK = 512, ZV = 1024, ZQI = 1536, ZKI = 1792, ZWI = 1824, ZU = 2048, ZGA = 2560, ZGP = 3584;
constexpr int FF = 2816, FFE = 3584, NE = 8;
constexpr int TOPK = 256;
constexpr int MROWS = 34816;
constexpr float EPS = 1e-6f;

constexpr size_t MiB = 1u << 20;
constexpr size_t WS_CTL = 0, CTL_ZERO_BYTES = 1 * MiB;
constexpr size_t WS_TAB16 = 1 * MiB, WS_TAB8 = 1 * MiB + 512 * 1024;
constexpr size_t WS_SSQP = 2 * MiB;
constexpr size_t WS_ROUTE = 3 * MiB, WS_POS = 3 * MiB + 256 * 1024;
constexpr size_t WS_META = 4 * MiB;
constexpr size_t WS_WIN = 6 * MiB, WS_PA = 24 * MiB, WS_WEFF = 26 * MiB, WS_WOUT = 28 * MiB, WS_W13 = 32 * MiB, WS_W2 = 43 * MiB;
constexpr size_t WS_XB = 52 * MiB;
constexpr size_t WS_ZB = 84 * MiB;
constexpr size_t WS_HB = 84 * MiB;
constexpr size_t WS_Q = 228 * MiB, WS_K = 244 * MiB, WS_V = 260 * MiB, WS_QI = 276 * MiB, WS_KI = 284 * MiB, WS_WI = 285 * MiB, WS_DIFF = 286 * MiB;
constexpr size_t WS_MASK = 302 * MiB;
constexpr size_t WS_T1 = 334 * MiB, WS_MB = 366 * MiB;
constexpr size_t WS_W13E = 6 * MiB, WS_W2E = 118 * MiB, WS_AP = 174 * MiB, WS_HE = 242 * MiB, WS_END = 480 * MiB;
static_assert(WS_W13E + (size_t)NE * 2 * FFE * D * 2 <= WS_W2E && WS_W2E + (size_t)NE * D * FFE * 2 <= WS_AP && WS_AP + (size_t)MROWS * D * 2 <= WS_HE && WS_HE + (size_t)MROWS * FFE * 2 <= WS_END, "MoE map");
static_assert(WS_ZB + (size_t)M * INP * 2 <= WS_Q && WS_MB + (size_t)M * D * 2 <= WS_END && WS_W2 + (size_t)D * FF * 2 <= WS_XB && WS_HB + (size_t)M * FF * 2 <= WS_Q, "layer map");
constexpr int CW_BAR = 4096;
constexpr int CW_CNT = 16384;
constexpr int CW_CUR = 16384 + 64 * 8;

constexpr int RING_OFF = 0, RING_BYTES = 131072;
constexpr int LDSCTL_OFF = 132096, MISC_OFF = LDSCTL_OFF + 320;
constexpr int LDS_BYTES = 147456;
static_assert(MISC_OFF + 128 <= LDS_BYTES, "LDS map");

#define GAS __attribute__((address_space(1)))
#define LAS __attribute__((address_space(3)))
typedef unsigned short bf16;
typedef unsigned v4u __attribute__((ext_vector_type(4)));
typedef float f32x4 __attribute__((ext_vector_type(4)));
typedef short bf16x8 __attribute__((ext_vector_type(8)));
typedef GAS unsigned gu32;
typedef GAS unsigned long long gu64;
#define RLX_AGENT __ATOMIC_RELAXED, __HIP_MEMORY_SCOPE_AGENT
#define LDS_WAIT() asm volatile("s_waitcnt lgkmcnt(0)" ::: "memory")
#define VM_WAIT() asm volatile("s_waitcnt vmcnt(0)" ::: "memory")
__device__ __forceinline__ unsigned long long rt() { return __builtin_amdgcn_s_memrealtime(); }
__device__ __forceinline__ unsigned f2bf(float f) { unsigned u = __builtin_bit_cast(unsigned, f); return (u + 0x7fffu + ((u >> 16) & 1u)) >> 16; }
__device__ __forceinline__ unsigned pk2(float lo, float hi) { return f2bf(lo) | (f2bf(hi) << 16); }

#define XB_TMO      128
#define XB_XCNT(j)  (256  + 64 * (j))
#define XB_XSUB(j)  (1280 + 64 * (j))
#define XB_XGEN(j)  (2304 + 64 * (j))
#define XB_TOP      3328
#define XB_TOPGEN   3392
#define XCD_BAR_WORDS 3456
#define XB_SPIN_CAP (1u << 18)

__device__ __forceinline__ unsigned xb_ld(unsigned* p)              { return __hip_atomic_load(p, __ATOMIC_RELAXED, __HIP_MEMORY_SCOPE_AGENT); }
__device__ __forceinline__ unsigned xb_add(unsigned* p, unsigned v) { return __hip_atomic_fetch_add(p, v, __ATOMIC_RELAXED, __HIP_MEMORY_SCOPE_AGENT); }
__device__ __forceinline__ unsigned xb_xcc_id() { return (unsigned)__builtin_amdgcn_s_getreg((3 << 11) | 20) & 0xFu; }
#define XB_SPIN(cond, bar) do { unsigned _sp = 0; while (cond) { __builtin_amdgcn_s_sleep(1); \
    if ((++_sp & 255u) == 0u) { if (xb_ld(&(bar)[XB_TMO])) break; if (_sp > XB_SPIN_CAP) { atomicAdd(&(bar)[XB_TMO], 1u); break; } } } } while (0)

struct XcdBarrier {
    unsigned* bar; unsigned x;
    volatile LAS unsigned* st;
};

__device__ __forceinline__ XcdBarrier xcd_barrier_post(unsigned* bar, volatile LAS unsigned* st) {
    XcdBarrier b; b.bar = bar; b.x = xb_xcc_id(); b.st = st;
    if (threadIdx.x == 0) (void)xb_add(&bar[XB_XCNT(b.x)], 1u);
    return b;
}
__device__ __forceinline__ void xcd_barrier_complete(unsigned* bar, unsigned x, unsigned& nloc, unsigned& nx) {
    const unsigned G = gridDim.x * gridDim.y * gridDim.z;
    unsigned sum, cnt, mine, sp = 0u;
    for (;;) {
        sum = 0u; cnt = 0u; mine = 0u;
#pragma unroll
        for (unsigned j = 0; j < 16; ++j) { const unsigned c = xb_ld(&bar[XB_XCNT(j)]); sum += c; cnt += (c > 0u) ? 1u : 0u; mine = (j == x) ? c : mine; }
        if (sum == G) break;
        __builtin_amdgcn_s_sleep(1);
        if ((++sp & 255u) == 0u) { if (xb_ld(&bar[XB_TMO])) break; if (sp > XB_SPIN_CAP) { atomicAdd(&bar[XB_TMO], 1u); break; } }
    }
    nloc = mine > 0u ? mine : 1u; nx = cnt > 0u ? cnt : 1u;
}

__device__ __forceinline__ void xcd_barrier(const XcdBarrier& b) {
    asm volatile("s_waitcnt vmcnt(0)" ::: "memory");
    __syncthreads();
    if (threadIdx.x == 0) {
        unsigned* bar = b.bar;
        __builtin_amdgcn_s_waitcnt(0);
        unsigned nloc = b.st[0], nx = b.st[1];
        if (nloc == 0u) { xcd_barrier_complete(bar, b.x, nloc, nx); b.st[0] = nloc; b.st[1] = nx; }
        const unsigned old = xb_add(&bar[XB_XSUB(b.x)], 1u);
        const unsigned gen = old / nloc;
        if (old + 1u == (gen + 1u) * nloc) {
            __builtin_amdgcn_fence(__ATOMIC_RELEASE, "agent");
            asm volatile("s_waitcnt vmcnt(0)" ::: "memory");
            const unsigned og = xb_add(&bar[XB_TOP], 1u);
            const unsigned tg = og / nx;
            if (og + 1u == (tg + 1u) * nx) xb_add(&bar[XB_TOPGEN], 1u);
            else XB_SPIN(xb_ld(&bar[XB_TOPGEN]) == tg, bar);
            __builtin_amdgcn_fence(__ATOMIC_ACQUIRE, "agent");
            xb_add(&bar[XB_XGEN(b.x)], 1u);
            asm volatile("s_waitcnt vmcnt(0)" ::: "memory");
        } else {
            XB_SPIN(xb_ld(&bar[XB_XGEN(b.x)]) == gen, bar);
            __builtin_amdgcn_fence(__ATOMIC_ACQUIRE, "agent");
            asm volatile("s_waitcnt vmcnt(0)" ::: "memory");
        }
    }
    __syncthreads();
}

struct Frame {
    LAS unsigned char* lds;
    volatile LAS unsigned* MISC;
    gu32* ctl;
    int tid, lane, wave;
    int vcu, G;
    unsigned char* ws;
    float* out;
};
__device__ __forceinline__ float wave_sum(float v) {
#pragma unroll
    for (int o = 1; o < 64; o <<= 1) v += __shfl_xor(v, o);
    return v;
}
__device__ __forceinline__ float bfl(unsigned w) { return __uint_as_float(w << 16); }
__device__ __forceinline__ float bfh(unsigned w) { return __uint_as_float(w & 0xffff0000u); }
__device__ __forceinline__ void unpk8(const v4u w, float (&v)[8]) { v[0] = bfl(w.x); v[1] = bfh(w.x); v[2] = bfl(w.y); v[3] = bfh(w.y); v[4] = bfl(w.z); v[5] = bfh(w.z); v[6] = bfl(w.w); v[7] = bfh(w.w); }
__device__ __forceinline__ v4u pk8(const float (&v)[8]) { v4u o; o.x = pk2(v[0], v[1]); o.y = pk2(v[2], v[3]); o.z = pk2(v[4], v[5]); o.w = pk2(v[6], v[7]); return o; }

struct RowMap { int mode, a;
    __device__ __forceinline__ int operator()(int n) const { return mode == 0 ? a + n : mode == 1 ? (n < 1832 ? n : n + 216) : 256 * (n >> 7) + (n & 127) + a; } };
__device__ __forceinline__ void tr_item(const float* W, int K, int N, bf16* WT, const float* gain, const RowMap mp, LAS float* scr, int item, int lane) {
    const int nblk = (N + 31) / 32, kb = item / nblk, nb = item % nblk, k0 = 64 * kb, n0 = 32 * nb;
    const int nn = n0 + (lane & 31); const bool okn = nn < N;
#pragma unroll 8
    for (int i = 0; i < 32; ++i) { const int kk = 2 * i + (lane >> 5); float v = okn ? W[(size_t)(k0 + kk) * N + nn] : 0.f; if (gain) v *= gain[k0 + kk]; scr[kk * 33 + (lane & 31)] = v; }
    LDS_WAIT(); asm volatile("" ::: "memory");
    const int c = lane & 7;
#pragma unroll
    for (int j = 0; j < 4; ++j) { const int n = (lane >> 3) + 8 * j;
        if (n0 + n < N) { const LAS float* s = scr + (8 * c) * 33 + n;
            v4u o; o.x = pk2(s[0 * 33], s[1 * 33]); o.y = pk2(s[2 * 33], s[3 * 33]); o.z = pk2(s[4 * 33], s[5 * 33]); o.w = pk2(s[6 * 33], s[7 * 33]);
            *(GAS v4u*)(WT + (size_t)mp(n0 + n) * K + k0 + 8 * c) = o; } }
    LDS_WAIT(); asm volatile("" ::: "memory");
}
__device__ __forceinline__ float inv16(int i) { return i == 0 ? 1.0f : i == 1 ? 0.1939227432012558f : i == 2 ? 0.03760603070259094f : i == 3 ? 0.007292664609849453f : i == 4 ? 0.0014142135623842478f : i == 5 ? 0.00027424818836152554f : i == 6 ? 5.3182957344688475e-05f : 1.0313385246263351e-05f; }
__device__ __forceinline__ float2 cs_of(float ang) {
    const double a = (double)ang, k = __builtin_rint(a * 0.15915494309189535), r = a - k * 6.283185307179586;
    const float rr = (float)(r * 0.15915494309189535);
    return make_float2(__builtin_amdgcn_cosf(rr), __builtin_amdgcn_sinf(rr));
}

__device__ __forceinline__ void p0_prologue(Frame& F, const float* const* in) {
    LAS float* scr = (LAS float*)(F.lds + RING_OFF + F.wave * 16384);
    int lane_ = F.lane; asm volatile("" : "+v"(lane_)); const int gw = F.vcu * NWAVES + F.wave, NGW = F.G * NWAVES, lane = lane_;
    const float* x = in[0];
    constexpr int I_WIN = 16 * 138, I_PA = 8 * 32, I_WO = 16 * 32, I_W1 = 16 * 88, I_W2 = 44 * 32;
    constexpr int I_L = I_WIN + I_PA + I_WO, NIT = 2 * I_L + 2 * I_W1 + I_W2;
    for (int it = gw; it < NIT; it += NGW) {
        int r = it;
        if (r < 2 * I_L) { const int L = r / I_L; r -= L * I_L;
            if (r < I_WIN) { tr_item(in[2] + (size_t)L * D * INW, D, INW, (bf16*)(F.ws + WS_WIN) + (size_t)L * INP * D, in[1] + L * D, RowMap{1, 0}, scr, r, lane); continue; } r -= I_WIN;
            if (r < I_PA) { tr_item(in[7] + (size_t)L * 512 * D, 512, D, (bf16*)(F.ws + WS_PA) + (size_t)L * D * 512, nullptr, RowMap{0, 0}, scr, r, lane); continue; } r -= I_PA;
            tr_item(in[9] + (size_t)L * D * D, D, D, (bf16*)(F.ws + WS_WOUT) + (size_t)L * D * D, nullptr, RowMap{0, 0}, scr, r, lane); continue; }
        r -= 2 * I_L;
        if (r < I_W1) { tr_item(in[11], D, FF, (bf16*)(F.ws + WS_W13), in[10], RowMap{2, 0}, scr, r, lane); continue; } r -= I_W1;
        if (r < I_W1) { tr_item(in[12], D, FF, (bf16*)(F.ws + WS_W13), in[10], RowMap{2, 128}, scr, r, lane); continue; } r -= I_W1;
        tr_item(in[13], FF, D, (bf16*)(F.ws + WS_W2), nullptr, RowMap{0, 0}, scr, r, lane);
    }
    for (int it = gw; it < 2 * 216; it += NGW) { const int L = it / 216, rr = 1832 + it % 216; GAS v4u* o = (GAS v4u*)((bf16*)(F.ws + WS_WIN) + ((size_t)L * INP + rr) * D) + lane; o[0] = (v4u){0u, 0u, 0u, 0u}; o[64] = (v4u){0u, 0u, 0u, 0u}; }
    for (int it = gw; it < 2 * 4 * 16 * 8; it += NGW) {
        const int cc = it & 7, nb = (it >> 3) & 15, g = (it >> 7) & 3, L = it >> 9; const int n = nb * 64 + lane, c0 = cc * 16;
        const float* wp = in[5] + ((size_t)(L * 4 + g) * 128 + c0) * 128; const float* ps = in[6] + L * 512 + g * 128; const float* pb = in[8] + ((size_t)L * 512 + g * 128) * D + n;
        float acc[16];
#pragma unroll
        for (int c = 0; c < 16; ++c) acc[c] = 0.f;
        for (int d = 0; d < 128; ++d) { const float v = ps[d] * pb[(size_t)d * D];
#pragma unroll
            for (int c = 0; c < 16; ++c) acc[c] += wp[c * 128 + d] * v; }
        GAS v4u* o = (GAS v4u*)((bf16*)(F.ws + WS_WEFF) + ((size_t)L * D + n) * 512 + g * 128 + c0);
        v4u o0, o1; o0.x = pk2(acc[0], acc[1]); o0.y = pk2(acc[2], acc[3]); o0.z = pk2(acc[4], acc[5]); o0.w = pk2(acc[6], acc[7]); o1.x = pk2(acc[8], acc[9]); o1.y = pk2(acc[10], acc[11]); o1.z = pk2(acc[12], acc[13]); o1.w = pk2(acc[14], acc[15]);
        o[0] = o0; o[1] = o1;
    }
    { float2* t16 = (float2*)(F.ws + WS_TAB16); float2* t8 = (float2*)(F.ws + WS_TAB8);
      for (int i = gw * 64 + lane; i < T * 12; i += NGW * 64) { const int t = i / 12, j = i % 12;
          if (j < 8) t16[t * 8 + j] = cs_of((float)t * inv16(j)); else t8[t * 4 + (j - 8)] = cs_of((float)t * inv16(2 * (j - 8))); } }
    for (int m = gw; m < M; m += NGW) {
        const GAS f32x4* xr = (const GAS f32x4*)(x + (size_t)m * D) + lane; f32x4 v[4]; float s = 0.f;
#pragma unroll
        for (int j = 0; j < 4; ++j) { v[j] = xr[64 * j]; s += (v[j].x * v[j].x + v[j].y * v[j].y) + (v[j].z * v[j].z + v[j].w * v[j].w); }
        s = wave_sum(s);
        GAS unsigned long long* o8 = (GAS unsigned long long*)((bf16*)(F.ws + WS_XB) + (size_t)m * D) + lane;
#pragma unroll
        for (int j = 0; j < 4; ++j) o8[64 * j] = (unsigned long long)pk2(v[j].x, v[j].y) | ((unsigned long long)pk2(v[j].z, v[j].w) << 32);
        if (lane < 16) ((float*)(F.ws + WS_SSQP))[(size_t)m * 16 + lane] = lane == 0 ? s : 0.f;
    }
}

__device__ __forceinline__ void post_phase(Frame& F, int L, const float* qn, const float* kn) {
    int lane_ = F.lane; asm volatile("" : "+v"(lane_)); const int gw = F.vcu * NWAVES + F.wave, NGW = F.G * NWAVES, l = lane_;
    const bf16* ZB = (const bf16*)(F.ws + WS_ZB);
    const float2* t16 = (const float2*)(F.ws + WS_TAB16); const float2* t8 = (const float2*)(F.ws + WS_TAB8);
    for (int row = gw; row < M; row += NGW) {
        const bf16* z = ZB + (size_t)row * INP; const int t = row & (T - 1);
        { const int hq = l >> 2, sub = l & 3; const bf16* src = z + hq * 64 + sub * 16;
          float a[8], b[8]; unpk8(*(const GAS v4u*)src, a); unpk8(*(const GAS v4u*)(src + 8), b);
          float ss = 0.f;
#pragma unroll
          for (int i = 0; i < 8; ++i) ss += a[i] * a[i] + b[i] * b[i];
          ss += __shfl_xor(ss, 1); ss += __shfl_xor(ss, 2);
          const float rn = __builtin_amdgcn_rsqf(ss * (1.f / 64.f) + EPS);
          const float* g = (hq < 8 ? qn : kn) + L * 64 + sub * 16;
#pragma unroll
          for (int i = 0; i < 8; ++i) { a[i] *= rn * g[i]; b[i] *= rn * g[8 + i]; }
          if (sub == 0) {
#pragma unroll
              for (int i = 0; i < 8; ++i) { const float2 cs = t16[t * 8 + i]; const float x1 = a[i], x2 = b[i]; a[i] = x1 * cs.x - x2 * cs.y; b[i] = x2 * cs.x + x1 * cs.y; } }
          if (hq < 8) {
#pragma unroll
              for (int i = 0; i < 8; ++i) { a[i] *= attn_body::C2; b[i] *= attn_body::C2; } }
          bf16* dst = (bf16*)(F.ws + (hq < 8 ? WS_Q : WS_K)) + (size_t)row * 512 + (hq & 7) * 64 + sub * 16;
          *(GAS v4u*)dst = pk8(a); *(GAS v4u*)(dst + 8) = pk8(b); }
        *(GAS v4u*)((bf16*)(F.ws + WS_V) + (size_t)row * 512 + 8 * l) = *(const GAS v4u*)(z + ZV + 8 * l);
        if (l < 36) { const bool isq = l < 32; const int sub = l & 3; const bf16* src = isq ? z + ZQI + (l >> 2) * 32 + sub * 8 : z + ZKI + sub * 8;
            float a[8]; unpk8(*(const GAS v4u*)src, a);
            if (sub == 0) {
#pragma unroll
                for (int i = 0; i < 4; ++i) { const float2 cs = t8[t * 4 + i]; const float x1 = a[i], x2 = a[4 + i]; a[i] = x1 * cs.x - x2 * cs.y; a[4 + i] = x2 * cs.x + x1 * cs.y; } }
            bf16* dst = isq ? (bf16*)(F.ws + WS_QI) + (size_t)row * 256 + (l >> 2) * 32 + sub * 8 : (bf16*)(F.ws + WS_KI) + (size_t)row * 32 + sub * 8;
            *(GAS v4u*)dst = pk8(a); }
        if (l == 36) { float a[8]; unpk8(*(const GAS v4u*)(z + ZWI), a); GAS f32x4* o = (GAS f32x4*)((float*)(F.ws + WS_WI) + (size_t)row * 8);
            o[0] = (f32x4){a[0], a[1], a[2], a[3]} * 0.0625f; o[1] = (f32x4){a[4], a[5], a[6], a[7]} * 0.0625f; }
        { const int w = 2 << (l >> 4); float acc[8], u0[8]; unpk8(*(const GAS v4u*)(z + ZU + 8 * l), u0);
#pragma unroll
          for (int i = 0; i < 8; ++i) acc[i] = u0[i];
          for (int j = 1; j < 16; ++j) { if (j < w && j <= t) { float uj[8]; unpk8(*(const GAS v4u*)(z - (size_t)j * INP + ZU + 8 * l), uj);
#pragma unroll
              for (int i = 0; i < 8; ++i) acc[i] += uj[i]; } }
          const float inv = 1.f / (float)((t + 1) < w ? (t + 1) : w);
#pragma unroll
          for (int i = 0; i < 8; ++i) acc[i] = acc[i] * inv - u0[i];
          *(GAS v4u*)((bf16*)(F.ws + WS_DIFF) + (size_t)row * 512 + 8 * l) = pk8(acc); }
    }
}

namespace topk {
typedef float f32x16 __attribute__((ext_vector_type(16)));
constexpr int HROW = 1025;
constexpr int ST_OFF = 32 * HROW * 4;
__device__ __forceinline__ unsigned okey(float s) { const unsigned u = __float_as_uint(s); return (u & 0x80000000u) ? ~u : (u | 0x80000000u); }
__device__ __forceinline__ int crow(int r, int hi) { return (r & 3) + 8 * (r >> 2) + 4 * hi; }
template <int NB> __device__ __forceinline__ void scan_row(const LAS unsigned* hrow, unsigned k, int lane, LAS unsigned* pref, LAS unsigned* krem, int shift) {
    constexpr int WPL = NB / 128;
    unsigned wv[WPL], c = 0;
#pragma unroll
    for (int i = 0; i < WPL; ++i) { wv[i] = hrow[lane * WPL + i]; c += (wv[i] & 0xffffu) + (wv[i] >> 16); }
    unsigned incl = c;
#pragma unroll
    for (int o = 1; o < 64; o <<= 1) { const unsigned tt = __shfl_down(incl, o); if (lane + o < 64) incl += tt; }
    const unsigned above = incl - c;
    if (above < k && k <= incl) {
        unsigned cum = above, bin = 0, kr = 1; bool found = false;
#pragma unroll
        for (int i = WPL - 1; i >= 0; --i) {
            unsigned h = wv[i] >> 16; if (!found && cum + h >= k) { found = true; bin = (unsigned)(lane * WPL + i) * 2u + 1u; kr = k - cum; } cum += h;
            h = wv[i] & 0xffffu;       if (!found && cum + h >= k) { found = true; bin = (unsigned)(lane * WPL + i) * 2u;      kr = k - cum; } cum += h; }
        *pref = (*pref << shift) | bin; *krem = kr;
    }
}
template <int MODE> __device__ __forceinline__ void half_pass(const f32x16& sv, int p, bool diag, int tile, int qabs, int r32, int hi, LAS unsigned* hist, unsigned pref, unsigned& mlo, unsigned& mhi) {
#pragma unroll
    for (int r = 0; r < 16; ++r) {
        const unsigned key = okey(sv[r]);
        const bool valid = !diag || (tile * 64 + 32 * p + crow(r, hi)) <= qabs;
        if (MODE == 0) { if (valid) { const unsigned bin = key >> 21; __hip_atomic_fetch_add(hist + r32 * HROW + (bin >> 1), 1u << (16 * (bin & 1u)), __ATOMIC_RELAXED, __HIP_MEMORY_SCOPE_WORKGROUP); } }
        else if (MODE == 1) { if (valid && (key >> 21) == pref) { const unsigned bin = (key >> 10) & 2047u; __hip_atomic_fetch_add(hist + r32 * HROW + (bin >> 1), 1u << (16 * (bin & 1u)), __ATOMIC_RELAXED, __HIP_MEMORY_SCOPE_WORKGROUP); } }
        else if (MODE == 2) { if (valid && (key >> 10) == pref) { const unsigned bin = key & 1023u; __hip_atomic_fetch_add(hist + r32 * HROW + (bin >> 1), 1u << (16 * (bin & 1u)), __ATOMIC_RELAXED, __HIP_MEMORY_SCOPE_WORKGROUP); } }
        else {
#ifdef DBG_PARITY
            const unsigned long long bal = __ballot(valid && (((crow(r, hi) + r32 + tile) & 3) == 0));
#else
            const unsigned long long bal = __ballot(valid && key >= pref);
#endif
 if (p == 0) { asm("s_nop 4\n\tv_writelane_b32 %0, %1, %2" : "+v"(mlo) : "s"((unsigned)bal), "i"(r)); asm("v_writelane_b32 %0, %1, %2" : "+v"(mhi) : "s"((unsigned)(bal >> 32)), "i"(r)); }
               else { asm("s_nop 4\n\tv_writelane_b32 %0, %1, %2" : "+v"(mlo) : "s"((unsigned)bal), "i"(16 + r)); asm("v_writelane_b32 %0, %1, %2" : "+v"(mhi) : "s"((unsigned)(bal >> 32)), "i"(16 + r)); } }
    }
}
}
__device__ __forceinline__ void topk_phase(Frame& F, int L) {
    using namespace topk;
    int tid_ = F.tid; asm volatile("" : "+v"(tid_)); const int tid = tid_, lane = tid & 63, r32 = lane & 31, hi = lane >> 5, wid = F.wave;
    LAS unsigned* hist = (LAS unsigned*)(F.lds + RING_OFF);
    LAS unsigned* pref = (LAS unsigned*)(F.lds + RING_OFF + ST_OFF); LAS unsigned* krem = pref + 32;
    const bf16* QI = (const bf16*)(F.ws + WS_QI); const bf16* KI = (const bf16*)(F.ws + WS_KI); const float* WI = (const float*)(F.ws + WS_WI);
    unsigned long long* MASK = (unsigned long long*)(F.ws + WS_MASK + (size_t)L * 16 * MiB);
    for (int ui = F.vcu; ui < 512; ui += F.G) {
        const int jj = ui & 255, b = jj >> 7, j32 = ui < 256 ? (jj & 127) : 255 - (jj & 127);
        const int q0 = j32 * 32, ntile = (j32 >> 1) + 1, qabs = q0 + r32; const size_t brow = (size_t)b * T;
        pg8::bf16x8 bq[8][2]; float w[8];
#pragma unroll
        for (int h = 0; h < 8; ++h) { bq[h][0] = *(const pg8::bf16x8*)(QI + (brow + qabs) * 256 + h * 32 + hi * 8); bq[h][1] = *(const pg8::bf16x8*)(QI + (brow + qabs) * 256 + h * 32 + 16 + hi * 8); }
        { const f32x4 w0 = *(const f32x4*)(WI + (brow + qabs) * 8), w1 = *(const f32x4*)(WI + (brow + qabs) * 8 + 4); w[0] = w0.x; w[1] = w0.y; w[2] = w0.z; w[3] = w0.w; w[4] = w1.x; w[5] = w1.y; w[6] = w1.z; w[7] = w1.w; }
        if (tid < 32) { pref[tid] = 0u; krem[tid] = (unsigned)((q0 + tid + 1) < TOPK ? (q0 + tid + 1) : TOPK); }
#define TOPK_MF(A, B, C) __builtin_amdgcn_mfma_f32_32x32x16_bf16(A, B, C, 0, 0, 0)
#define TOPK_SCORES(tile, p) \
        f32x16 sv = f32x16{}; { const bf16* kp = KI + (brow + (size_t)(tile) * 64 + 32 * (p) + r32) * 32 + hi * 8; \
            pg8::bf16x8 a0 = *(const pg8::bf16x8*)kp, a1 = *(const pg8::bf16x8*)(kp + 16); \
            f32x16 d = TOPK_MF(a0, bq[0][0], f32x16{}); d = TOPK_MF(a1, bq[0][1], d); \
            _Pragma("unroll") for (int h = 0; h < 8; ++h) { f32x16 dn = f32x16{}; \
                if (h < 7) { dn = TOPK_MF(a0, bq[(h + 1) & 7][0], f32x16{}); dn = TOPK_MF(a1, bq[(h + 1) & 7][1], dn); } \
                float wh = w[h]; asm volatile("" : "+v"(wh));     \
                _Pragma("unroll") for (int r = 0; r < 16; ++r) sv[r] = __builtin_fmaf(__builtin_fmaxf(d[r], 0.f), wh, sv[r]); \
                asm volatile("" : "+v"(a0), "+v"(a1), "+v"(sv));     \
                d = dn; } }
#define TOPK_ZERO() do { for (int i = tid; i < 32 * HROW; i += NWAVES * 64) hist[i] = 0u; } while (0)
        TOPK_ZERO(); __syncthreads();
        { unsigned d0_ = 0u, d1_ = 0u; for (int hp = 2 * wid; hp < 2 * ntile; hp += (hp & 1) ? 2 * NWAVES - 1 : 1) { const int tile = hp >> 1, p = hp & 1; TOPK_SCORES(tile, p); half_pass<0>(sv, p, tile == ntile - 1, tile, qabs, r32, hi, hist, 0u, d0_, d1_); } }
        __syncthreads();
        for (int rr = 0; rr < 4; ++rr) { const int row = wid * 4 + rr; scan_row<2048>(hist + row * HROW, krem[row], lane, pref + row, krem + row, 11); }
        __syncthreads(); TOPK_ZERO(); __syncthreads();
        { const unsigned pf = pref[r32];
          unsigned d0_ = 0u, d1_ = 0u; for (int hp = 2 * wid; hp < 2 * ntile; hp += (hp & 1) ? 2 * NWAVES - 1 : 1) { const int tile = hp >> 1, p = hp & 1; TOPK_SCORES(tile, p); half_pass<1>(sv, p, tile == ntile - 1, tile, qabs, r32, hi, hist, pf, d0_, d1_); } }
        __syncthreads();
        for (int rr = 0; rr < 4; ++rr) { const int row = wid * 4 + rr; scan_row<2048>(hist + row * HROW, krem[row], lane, pref + row, krem + row, 11); }
        __syncthreads(); TOPK_ZERO(); __syncthreads();
        { const unsigned pf = pref[r32];
          unsigned d0_ = 0u, d1_ = 0u; for (int hp = 2 * wid; hp < 2 * ntile; hp += (hp & 1) ? 2 * NWAVES - 1 : 1) { const int tile = hp >> 1, p = hp & 1; TOPK_SCORES(tile, p); half_pass<2>(sv, p, tile == ntile - 1, tile, qabs, r32, hi, hist, pf, d0_, d1_); } }
        __syncthreads();
        for (int rr = 0; rr < 4; ++rr) { const int row = wid * 4 + rr; scan_row<1024>(hist + row * HROW, krem[row], lane, pref + row, krem + row, 10); }
        __syncthreads();
        { unsigned thr = pref[r32];
#ifdef DBG_FIXTHR
 thr = 0xbe800000u;
#endif
 unsigned long long* mq = MASK + ((size_t)(b * 256 + j32) * 128) * 32; const int nt_att = 4 * (j32 >> 3) + 4;
          for (int tile = wid; tile < nt_att; tile += NWAVES) {
              unsigned mlo = 0u, mhi = 0u;
              if (tile < ntile) { for (int p = 0; p < 2; ++p) { TOPK_SCORES(tile, p); half_pass<3>(sv, p, tile == ntile - 1, tile, qabs, r32, hi, hist, thr, mlo, mhi); } }
              if (lane < 32) mq[(size_t)tile * 32 + lane] = ((unsigned long long)mhi << 32) | mlo; } }
        __syncthreads();
#undef TOPK_SCORES
#undef TOPK_MF
#undef TOPK_ZERO
    }
}

__device__ __forceinline__ void route_phase(Frame& F, const float* gain, const float* wr) {
    const int gw = F.vcu * NWAVES + F.wave, NGW = F.G * NWAVES, lane = F.lane;
    volatile LAS unsigned* lcnt = F.MISC + 16;
    for (int m = gw; m < M; m += NGW) {
        const GAS f32x4* xr = (const GAS f32x4*)(F.out + (size_t)m * D) + lane; f32x4 v[4]; float s = 0.f;
#pragma unroll
        for (int j = 0; j < 4; ++j) { v[j] = xr[64 * j]; s += (v[j].x * v[j].x + v[j].y * v[j].y) + (v[j].z * v[j].z + v[j].w * v[j].w); }
        const float rstd = __builtin_amdgcn_rsqf(wave_sum(s) * (1.f / D) + EPS);
        float lg[8];
#pragma unroll
        for (int e = 0; e < 8; ++e) lg[e] = 0.f;
#pragma unroll
        for (int j = 0; j < 4; ++j) { const int c0 = 4 * lane + 256 * j; const f32x4 g4 = *(const f32x4*)(gain + c0);
#pragma unroll
            for (int i = 0; i < 4; ++i) { const float h = v[j][i] * rstd * g4[i]; const f32x4 wa = *(const f32x4*)(wr + (size_t)(c0 + i) * 8), wb = *(const f32x4*)(wr + (size_t)(c0 + i) * 8 + 4);
                lg[0] += h * wa.x; lg[1] += h * wa.y; lg[2] += h * wa.z; lg[3] += h * wa.w; lg[4] += h * wb.x; lg[5] += h * wb.y; lg[6] += h * wb.z; lg[7] += h * wb.w; } }
#pragma unroll
        for (int e = 0; e < 8; ++e) lg[e] = wave_sum(lg[e]);
        int e0 = 0; float l0 = lg[0];
#pragma unroll
        for (int e = 1; e < 8; ++e) if (lg[e] > l0) { l0 = lg[e]; e0 = e; }
        int e1 = -1; float l1 = -INFINITY;
#pragma unroll
        for (int e = 0; e < 8; ++e) if (e != e0 && lg[e] > l1) { l1 = lg[e]; e1 = e; }
        const float g1 = 1.f / (1.f + __expf(l0 - l1)), g0 = 1.f - g1;
        if (lane == 0) { *(GAS f32x4*)((float*)(F.ws + WS_ROUTE) + (size_t)m * 4) = (f32x4){__uint_as_float((unsigned)e0 | ((unsigned)e1 << 8)), g0, g1, rstd};
            __hip_atomic_fetch_add((LAS unsigned*)lcnt + e0, 1u, __ATOMIC_RELAXED, __HIP_MEMORY_SCOPE_WORKGROUP); __hip_atomic_fetch_add((LAS unsigned*)lcnt + e1, 1u, __ATOMIC_RELAXED, __HIP_MEMORY_SCOPE_WORKGROUP); }
    }
    __syncthreads();
    if (F.tid < 8) __hip_atomic_fetch_add(F.ctl + CW_CNT + 64 * F.tid, lcnt[F.tid], RLX_AGENT);
}
__device__ __forceinline__ void moe_weights_phase(Frame& F, const float* gain, const float* w1, const float* w3, const float* w2) {
    LAS float* scr = (LAS float*)(F.lds + RING_OFF + F.wave * 16384);
    const int gw = F.vcu * NWAVES + F.wave, NGW = F.G * NWAVES, lane = F.lane;
    constexpr int I_UP = 16 * 112, I_DN = 56 * 32, I_E = 2 * I_UP + I_DN;
    for (int it = gw; it < NE * I_E; it += NGW) {
        const int e = it / I_E; int r = it - e * I_E;
        bf16* up = (bf16*)(F.ws + WS_W13E) + (size_t)e * 2 * FFE * D; bf16* dn = (bf16*)(F.ws + WS_W2E) + (size_t)e * D * FFE;
        if (r < I_UP) { tr_item(w1 + (size_t)e * D * FFE, D, FFE, up, gain, RowMap{2, 0}, scr, r, lane); continue; } r -= I_UP;
        if (r < I_UP) { tr_item(w3 + (size_t)e * D * FFE, D, FFE, up, gain, RowMap{2, 128}, scr, r, lane); continue; } r -= I_UP;
        tr_item(w2 + (size_t)e * FFE * D, FFE, D, dn, nullptr, RowMap{0, 0}, scr, r, lane);
    }
}
struct MoeSeg { int t1, t2, t3, t4, t5, t6, t7, nrt; };
__device__ __forceinline__ MoeSeg moe_segments(Frame& F) {
    unsigned c[8];
#pragma unroll
    for (int e = 0; e < 8; ++e) c[e] = (unsigned)__builtin_amdgcn_readfirstlane((int)__hip_atomic_load(F.ctl + CW_CNT + 64 * e, RLX_AGENT));
    MoeSeg s; int a = 0;
    a += (c[0] + 255) >> 8; s.t1 = a; a += (c[1] + 255) >> 8; s.t2 = a; a += (c[2] + 255) >> 8; s.t3 = a; a += (c[3] + 255) >> 8; s.t4 = a;
    a += (c[4] + 255) >> 8; s.t5 = a; a += (c[5] + 255) >> 8; s.t6 = a; a += (c[6] + 255) >> 8; s.t7 = a; a += (c[7] + 255) >> 8; s.nrt = a;
    return s;
}
__device__ __forceinline__ void gather_phase(Frame& F) {
    const MoeSeg sg = moe_segments(F);
    LAS int* earr = (LAS int*)(F.lds + RING_OFF);
    LAS int* parr = earr + 128;
    LAS int* tot = parr + 128;
    LAS int* base = tot + 8;
    const float* ROUTE = (const float*)(F.ws + WS_ROUTE); int* POS = (int*)(F.ws + WS_POS); float* META = (float*)(F.ws + WS_META); bf16* AP = (bf16*)(F.ws + WS_AP);
    for (int e = blockIdx.x; e < 8; e += F.G) {
        const int cnt = (int)__hip_atomic_load(F.ctl + CW_CNT + 64 * e, RLX_AGENT);
        const int toff = e == 0 ? 0 : e == 1 ? sg.t1 : e == 2 ? sg.t2 : e == 3 ? sg.t3 : e == 4 ? sg.t4 : e == 5 ? sg.t5 : e == 6 ? sg.t6 : sg.t7;
        const int r0 = toff * 256 + cnt, r1 = toff * 256 + ((cnt + 255) & ~255);
        for (int r = r0 + F.wave; r < r1; r += NWAVES) { GAS unsigned long long* o8 = (GAS unsigned long long*)(AP + (size_t)r * D) + F.lane;
#pragma unroll
            for (int j = 0; j < 4; ++j) o8[64 * j] = 0ull;
            if (F.lane == 0) *(f32x4*)(META + (size_t)r * 4) = (f32x4){0.f, 0.f, 0.f, 0.f}; } }
    for (int grp = blockIdx.x; grp < M / 64; grp += F.G) {
        const int p = F.tid, tok = grp * 64 + (p >> 1), slot = p & 1; int e = 0;
        if (p < 128) { const unsigned ee = __float_as_uint(ROUTE[(size_t)tok * 4]); e = slot == 0 ? (int)(ee & 0xffu) : (int)((ee >> 8) & 0xffu); earr[p] = e; }
        __syncthreads();
        if (p < 8) { tot[p] = 0; base[p] = 0; }
        __syncthreads();
        { int c0 = 0, c1 = 0, c2 = 0, c3 = 0, c4 = 0, c5 = 0, c6 = 0, c7 = 0;
          for (int t2 = p; t2 < grp * 64; t2 += NWAVES * 64) { const unsigned ee = __float_as_uint(ROUTE[(size_t)t2 * 4]); const int a0 = (int)(ee & 0xffu), a1 = (int)((ee >> 8) & 0xffu);
              c0 += (a0 == 0) + (a1 == 0); c1 += (a0 == 1) + (a1 == 1); c2 += (a0 == 2) + (a1 == 2); c3 += (a0 == 3) + (a1 == 3); c4 += (a0 == 4) + (a1 == 4); c5 += (a0 == 5) + (a1 == 5); c6 += (a0 == 6) + (a1 == 6); c7 += (a0 == 7) + (a1 == 7); }
          if (grp > 0) {
#define LADD(i, v) __hip_atomic_fetch_add(base + (i), (v), __ATOMIC_RELAXED, __HIP_MEMORY_SCOPE_WORKGROUP)
              LADD(0, c0); LADD(1, c1); LADD(2, c2); LADD(3, c3); LADD(4, c4); LADD(5, c5); LADD(6, c6); LADD(7, c7);
#undef LADD
          } }
        __syncthreads();
        if (p < 128) { int rank = 0; for (int j = 0; j < p; ++j) rank += (earr[j] == e);
            const int toff = e == 0 ? 0 : e == 1 ? sg.t1 : e == 2 ? sg.t2 : e == 3 ? sg.t3 : e == 4 ? sg.t4 : e == 5 ? sg.t5 : e == 6 ? sg.t6 : sg.t7;
            const int pos = toff * 256 + base[e] + rank; parr[p] = pos; POS[(size_t)tok * 2 + slot] = pos;
            const f32x4 rt4 = *(const f32x4*)(ROUTE + (size_t)tok * 4); *(f32x4*)(META + (size_t)pos * 4) = (f32x4){rt4.w, slot == 0 ? rt4.y : rt4.z, 0.f, 0.f}; }
        __syncthreads();
        for (int q = F.wave; q < 128; q += NWAVES) { const int tk = grp * 64 + (q >> 1), pos = parr[q];
            const GAS f32x4* xr = (const GAS f32x4*)(F.out + (size_t)tk * D) + F.lane; GAS unsigned long long* o8 = (GAS unsigned long long*)(AP + (size_t)pos * D) + F.lane;
#pragma unroll
            for (int j = 0; j < 4; ++j) { const f32x4 v = xr[64 * j]; o8[64 * j] = (unsigned long long)pk2(v.x, v.y) | ((unsigned long long)pk2(v.z, v.w) << 32); } }
        __syncthreads();
    }
}
__device__ __forceinline__ void fin_phase(Frame& F) {
    const int gw = F.vcu * NWAVES + F.wave, NGW = F.G * NWAVES, lane = F.lane;
    const int* POS = (const int*)(F.ws + WS_POS); const bf16* Y = (const bf16*)(F.ws + WS_AP);
    for (int m = gw; m < M; m += NGW) {
        const int p0 = POS[(size_t)m * 2], p1 = POS[(size_t)m * 2 + 1];
        GAS f32x4* xr = (GAS f32x4*)(F.out + (size_t)m * D) + lane;
        const GAS unsigned long long* y0 = (const GAS unsigned long long*)(Y + (size_t)p0 * D) + lane; const GAS unsigned long long* y1 = (const GAS unsigned long long*)(Y + (size_t)p1 * D) + lane;
#pragma unroll
        for (int j = 0; j < 4; ++j) { f32x4 v = xr[64 * j]; const unsigned long long a = y0[64 * j], b = y1[64 * j];
            v.x += bfl((unsigned)a) + bfl((unsigned)b); v.y += bfh((unsigned)a) + bfh((unsigned)b); v.z += bfl((unsigned)(a >> 32)) + bfl((unsigned)(b >> 32)); v.w += bfh((unsigned)(a >> 32)) + bfh((unsigned)(b >> 32));
            xr[64 * j] = v; }
    }
}

struct Args { const float* in[18]; float* out; unsigned char* ws; int ph_lo, ph_hi; };
__global__ void __launch_bounds__(NWAVES * 64, 2) mk_fwd(Args args) {
    extern __shared__ __attribute__((aligned(16))) unsigned char lds[];
    Frame F;
    F.lds = (LAS unsigned char*)lds;
    F.MISC = (volatile LAS unsigned*)(F.lds + MISC_OFF);
    F.tid = threadIdx.x; F.lane = F.tid & 63; F.wave = __builtin_amdgcn_readfirstlane(F.tid >> 6);
    F.G = gridDim.x; { const int bx = blockIdx.x; F.vcu = (F.G % 8 == 0) ? (bx % 8) * (F.G / 8) + bx / 8 : bx; }
    F.ws = args.ws; F.out = args.out; F.ctl = (gu32*)(args.ws + WS_CTL);
    for (int u = F.tid; u < (LDS_BYTES - LDSCTL_OFF) / 4; u += NWAVES * 64) ((LAS unsigned*)(F.lds + LDSCTL_OFF))[u] = 0u;
    __syncthreads();
    XcdBarrier bar; bar.bar = (unsigned*)(F.ctl + CW_BAR); bar.x = 0; bar.st = nullptr;
    if (!MK_PER_PHASE) bar = xcd_barrier_post((unsigned*)(F.ctl + CW_BAR), F.MISC + 8);
    const int lo = args.ph_lo, hi = args.ph_hi;
#define IN(k) (lo <= (k) && (k) < hi)
#ifndef PH_MASK
#define PH_MASK 0xffff
#endif
#define EN(c) (((PH_MASK) >> (c)) & 1)
#define SEAM(k) do { if (!MK_PER_PHASE && IN(k) && IN((k) + 1)) xcd_barrier(bar); } while (0)
    const float* const* in = args.in;
    bf16* XB = (bf16*)(F.ws + WS_XB); float* SSQP = (float*)(F.ws + WS_SSQP);

    if (EN(0) && IN(0)) { p0_prologue(F, in); } SEAM(0);

    for (int L = 0; L < 2; ++L) {
        const int pb = 1 + 8 * L;
        if (EN(1) && IN(pb)) { pg8::Gemm g{XB, (const bf16*)(F.ws + WS_WIN) + (size_t)L * INP * D, M, INP, D}; pg8::StaticOrder S; S.init(M, INP, F.G, (int)blockIdx.x);
            pg8::EpiRowScale E{(bf16*)(F.ws + WS_ZB), INP, SSQP};
            pg8::gemm_phase<pg8::EpiRowScale, pg8::StaticOrder, true, true>(F.lds + RING_OFF, g, S, E); }
        SEAM(pb);
        if (EN(2) && IN(pb + 1)) { post_phase(F, L, in[3], in[4]); }
        SEAM(pb + 1);
        if (EN(3) && IN(pb + 2)) { topk_phase(F, L); }
        SEAM(pb + 2);
        if (EN(4) && IN(pb + 3)) {
            const attn_body::AttnTensors AT{(const attn_body::bf16*)(F.ws + WS_Q), (const attn_body::bf16*)(F.ws + WS_K), (const attn_body::bf16*)(F.ws + WS_V), (attn_body::bf16*)(F.ws + WS_Q), (const unsigned long long*)(F.ws + WS_MASK + (size_t)L * 16 * MiB)};
            const attn_body::StaticOrder S((int)F.G, (int)blockIdx.x);
            attn_body::attn_phase<attn_body::StaticOrder>((char*)lds + RING_OFF, AT, S); }
        SEAM(pb + 3);
        if (EN(5) && IN(pb + 4)) {
            { pg8::Gemm g{(const bf16*)(F.ws + WS_Q), (const bf16*)(F.ws + WS_PA) + (size_t)L * D * 512, M, D, 512}; pg8::StaticOrder S; S.init(M, D, F.G, (int)blockIdx.x);
              pg8::EpiGate<false> E{(const bf16*)(F.ws + WS_ZB) + ZGA, INP, nullptr, (bf16*)(F.ws + WS_T1)};
              pg8::gemm_phase<pg8::EpiGate<false>, pg8::StaticOrder, true, true>(F.lds + RING_OFF, g, S, E); }
            { pg8::Gemm g{(const bf16*)(F.ws + WS_DIFF), (const bf16*)(F.ws + WS_WEFF) + (size_t)L * D * 512, M, D, 512}; pg8::StaticOrder S; S.init(M, D, F.G, (int)blockIdx.x);
              pg8::EpiGate<true> E{(const bf16*)(F.ws + WS_ZB) + ZGP, INP, (const bf16*)(F.ws + WS_T1), (bf16*)(F.ws + WS_MB)};
              pg8::gemm_phase<pg8::EpiGate<true>, pg8::StaticOrder, true, true>(F.lds + RING_OFF, g, S, E); } }
        SEAM(pb + 4);
        if (EN(6) && IN(pb + 5)) { pg8::Gemm g{(const bf16*)(F.ws + WS_MB), (const bf16*)(F.ws + WS_WOUT) + (size_t)L * D * D, M, D, D}; pg8::StaticOrder S; S.init(M, D, F.G, (int)blockIdx.x);
            pg8::EpiResid E{L == 0 ? in[0] : (const float*)F.out, F.out, XB, SSQP};
            pg8::gemm_phase<pg8::EpiResid, pg8::StaticOrder, true, true>(F.lds + RING_OFF, g, S, E); }
        SEAM(pb + 5);
        if (L == 0) {
            if (EN(7) && IN(7)) { pg8::Gemm g{XB, (const bf16*)(F.ws + WS_W13), M, 2 * FF, D}; pg8::StaticOrder S; S.init(M, 2 * FF, F.G, (int)blockIdx.x);
                pg8::EpiSwiGLU<false> E{(bf16*)(F.ws + WS_HB), FF, 2 * FF / 256, SSQP, nullptr};
                pg8::gemm_phase<pg8::EpiSwiGLU<false>, pg8::StaticOrder, true, true>(F.lds + RING_OFF, g, S, E); }
            SEAM(7);
            if (EN(8) && IN(8)) { pg8::Gemm g{(const bf16*)(F.ws + WS_HB), (const bf16*)(F.ws + WS_W2), M, D, FF}; pg8::StaticOrder S; S.init(M, D, F.G, (int)blockIdx.x);
                pg8::EpiResid E{(const float*)F.out, F.out, XB, SSQP};
                pg8::gemm_phase<pg8::EpiResid, pg8::StaticOrder, true, true>(F.lds + RING_OFF, g, S, E); }
            SEAM(8);
        }
    }
    if (EN(9) && IN(15)) { moe_weights_phase(F, in[10] + D, in[15], in[16], in[17]); route_phase(F, in[10] + D, in[14]); }
    SEAM(15);
    if (EN(10) && IN(16)) { gather_phase(F); }
    SEAM(16);
    if (EN(11) && IN(17)) { const MoeSeg sg = moe_segments(F);
        pg8::Gemm g{(const bf16*)(F.ws + WS_AP), (const bf16*)(F.ws + WS_W13E), MROWS, NE * 2 * FFE, D};
        pg8::GroupedOrder S{2 * FFE / 256, F.G, (int)blockIdx.x, sg.nrt, sg.t1, sg.t2, sg.t3, sg.t4, sg.t5, sg.t6, sg.t7};
        pg8::EpiSwiGLU<true> E{(bf16*)(F.ws + WS_HE), FFE, 2 * FFE / 256, nullptr, (const float*)(F.ws + WS_META)};
        pg8::gemm_phase<pg8::EpiSwiGLU<true>, pg8::GroupedOrder, true, true>(F.lds + RING_OFF, g, S, E); }
    SEAM(17);
    if (EN(12) && IN(18)) { const MoeSeg sg = moe_segments(F);
        pg8::Gemm g{(const bf16*)(F.ws + WS_HE), (const bf16*)(F.ws + WS_W2E), MROWS, NE * D, FFE};
        pg8::GroupedOrder S{D / 256, F.G, (int)blockIdx.x, sg.nrt, sg.t1, sg.t2, sg.t3, sg.t4, sg.t5, sg.t6, sg.t7};
        pg8::EpiPlain E{(bf16*)(F.ws + WS_AP), D, D / 256};
        pg8::gemm_phase<pg8::EpiPlain, pg8::GroupedOrder, true, true>(F.lds + RING_OFF, g, S, E); }
    SEAM(18);
    if (EN(13) && IN(19)) { fin_phase(F); }
#undef IN
#undef SEAM
}

#if defined(DBG_UPTO)
__global__ void dbg_dump(const unsigned short* buf, float* out, int pitch, int width) {
    for (size_t i = (size_t)blockIdx.x * blockDim.x + threadIdx.x; i < (size_t)M * D; i += (size_t)gridDim.x * blockDim.x) { if (width == 0) { const size_t w = i >> 3; const int tile = (int)((w >> 5) & 127), j32 = (int)((w >> 12) & 255); out[i] = tile < 4 * (j32 >> 3) + 4 ? (float)__popc((unsigned)((const unsigned char*)buf)[i]) : 0.f; continue; } const size_t m = i / D; const int c = (int)(i % D) % width; out[i] = __uint_as_float((unsigned)buf[m * pitch + c] << 16); }
}
#endif
extern "C" void kernel_launch(void* const* d_in, const int* in_sizes, int n_in, void* d_out, int out_size, void* d_ws, size_t ws_size, hipStream_t stream) {
    static int grid = 0;
    if (grid == 0) {
        if (n_in != 18 || in_sizes[0] != M * D || out_size != M * D || ws_size < WS_END) { fprintf(stderr, "kernel_launch: unexpected shapes or workspace (n_in %d, ws %zu < %zu); nothing launched\n", n_in, ws_size, (size_t)WS_END); grid = -1; return; }
        int dev = 0, cus = 0, per_cu = 0;
        if (hipGetDevice(&dev) != hipSuccess || hipDeviceGetAttribute(&cus, hipDeviceAttributeMultiprocessorCount, dev) != hipSuccess) { grid = -1; return; }
        if (hipFuncSetAttribute((const void*)mk_fwd, hipFuncAttributeMaxDynamicSharedMemorySize, LDS_BYTES) != hipSuccess) { fprintf(stderr, "kernel_launch: hipFuncSetAttribute failed\n"); grid = -1; return; }
        if (hipOccupancyMaxActiveBlocksPerMultiprocessor(&per_cu, (const void*)mk_fwd, NWAVES * 64, LDS_BYTES) != hipSuccess || per_cu < 1) fprintf(stderr, "kernel_launch: occupancy query reports %d\n", per_cu);
        (void)hipGetLastError();
        grid = cus;
    }
    if (grid < 0) return;
    if (hipMemsetAsync((char*)d_ws + WS_CTL, 0, CTL_ZERO_BYTES, stream) != hipSuccess) return;
    Args a{};
    for (int i = 0; i < 18; ++i) a.in[i] = (const float*)d_in[i];
    a.out = (float*)d_out; a.ws = (unsigned char*)d_ws;
#if defined(DBG_UPTO)
    for (int ph = 0; ph <= DBG_UPTO; ++ph) { a.ph_lo = ph; a.ph_hi = ph + 1; hipLaunchKernelGGL(mk_fwd, dim3(grid), dim3(NWAVES * 64), LDS_BYTES, stream, a); }
    hipLaunchKernelGGL(dbg_dump, dim3(4096), dim3(256), 0, stream, (const unsigned short*)((unsigned char*)d_ws + (size_t)DBG_OFF_MIB * MiB), (float*)d_out, DBG_PITCH, DBG_WIDTH);
#elif MK_PER_PHASE
    for (int ph = 0; ph < NPH; ++ph) { a.ph_lo = ph; a.ph_hi = ph + 1; hipLaunchKernelGGL(mk_fwd, dim3(grid), dim3(NWAVES * 64), LDS_BYTES, stream, a); }
#else
    a.ph_lo = 0; a.ph_hi = NPH; hipLaunchKernelGGL(mk_fwd, dim3(grid), dim3(NWAVES * 64), LDS_BYTES, stream, a);
#endif
}
```

```cpp
#define MK_PER_PHASE 0
#include <hip/hip_runtime.h>
#include <cstdio>
#include <cstdint>
__device__ __forceinline__ int mk_lane() { int l; asm volatile("v_mbcnt_lo_u32_b32 %0, -1, 0\n\tv_mbcnt_hi_u32_b32 %0, -1, %0" : "=v"(l)); return l; }
namespace pg8 {
#define PG8_LAS __attribute__((address_space(3)))
typedef unsigned short bf16_t;
typedef short bf16x8 __attribute__((ext_vector_type(8)));
typedef float f32x4 __attribute__((ext_vector_type(4)));
typedef unsigned u32x4 __attribute__((ext_vector_type(4)));
constexpr int BM = 256, BK = 64, HALF = 128, HTB = HALF * BK * 2  , STAGE_BYTES = 8 * HTB, NXCD = 8, WGM = 8;

__host__ __device__ __forceinline__ int lds_byte(int r, int c) { const int st = (r >> 4) * 2 + (c >> 5), rr = r & 15, cc = c & 31, ob = rr * 64 + cc * 2; return st * 1024 + (ob ^ (((ob >> 9) & 1) << 5)); }
__host__ __device__ __forceinline__ void stage_rc(int b, int& R, int& C) { const int st = b / 1024, sb = b % 1024, swz = sb ^ (((sb >> 9) & 1) << 5); R = (st >> 1) * 16 + swz / 64; C = (st & 1) * 32 + (swz % 64) / 2; }
__host__ __device__ __forceinline__ int perm32(int rho) { const int n = rho >> 4, i = rho & 15; return 8 * (i >> 2) + 4 * n + (i & 3); }

struct Unit { int pm, pn, ko; };
struct Gemm { const bf16_t* A; const bf16_t* Bt; int M, N, K, ld; int pnsplit; long long bt2off; const bf16_t* A2; const bf16_t* Bt2; int nt1; };

struct StaticOrder {
    int nM, nN, nwg, G, c;
    __host__ __device__ void init(int M, int N, int G_, int c_) { nM = M / BM; nN = N / BM; nwg = nM * nN; G = G_; c = c_; }
    __host__ __device__ bool next(int i, Unit& u) const {
        const long L = (long)i * G + c; if (L >= nwg) return false;
        int wgid = (int)L; { const int q = nwg / NXCD, r = nwg % NXCD, xcd = wgid % NXCD, off = wgid / NXCD; wgid = (xcd < r ? xcd * (q + 1) : r * (q + 1) + (xcd - r) * q) + off; }
        const int nig = WGM * nN, gid = wgid / nig, fm = gid * WGM, gsz = (nM - fm) < WGM ? (nM - fm) : WGM;
        u.pm = fm + ((wgid % nig) % gsz); u.pn = (wgid % nig) / gsz; u.ko = 0; return true;
    }
    __device__ __forceinline__ void a_ready(const Unit&) const {}
    __device__ __forceinline__ void done(const Unit&) const {}
};

__device__ __forceinline__ unsigned cvt_pk_bf16(float lo, float hi) { unsigned r; asm volatile("v_cvt_pk_bf16_f32 %0, %1, %2" : "=v"(r) : "v"(lo), "v"(hi)); return r; }
typedef float f32x2 __attribute__((ext_vector_type(2)));
__device__ __forceinline__ float bf_lo(unsigned w) { return __uint_as_float(w << 16); }
__device__ __forceinline__ float bf_hi(unsigned w) { return __uint_as_float(w & 0xffff0000u); }
__device__ __forceinline__ float fsigmoid(float x) { return __builtin_amdgcn_rcpf(1.f + __builtin_amdgcn_exp2f(-1.4426950408889634f * x)); }
__device__ __forceinline__ u32x4 pack8(const f32x4 v0, const f32x4 v1) { u32x4 w; w.x = cvt_pk_bf16(v0[0], v0[1]); w.y = cvt_pk_bf16(v0[2], v0[3]); w.z = cvt_pk_bf16(v1[0], v1[1]); w.w = cvt_pk_bf16(v1[2], v1[3]); return w; }
typedef unsigned u32x2 __attribute__((ext_vector_type(2)));
__device__ __forceinline__ unsigned pk4_fp8(const f32x4 v) { int p = __builtin_amdgcn_cvt_pk_fp8_f32(v[0], v[1], 0, false); p = __builtin_amdgcn_cvt_pk_fp8_f32(v[2], v[3], p, true); return (unsigned)p; }
__device__ __forceinline__ void unpack8(const u32x4 w, f32x4& v0, f32x4& v1) { v0 = (f32x4){bf_lo(w.x), bf_hi(w.x), bf_lo(w.y), bf_hi(w.y)}; v1 = (f32x4){bf_lo(w.z), bf_hi(w.z), bf_lo(w.w), bf_hi(w.w)}; }
__device__ __forceinline__ float rstd_from_parts(const float* ssqp, int row) {
    const f32x4* p = (const f32x4*)(ssqp + (size_t)row * 16);
    const f32x4 a = p[0], b = p[1], c = p[2], d = p[3];
    const float s = (((a[0] + a[1]) + (a[2] + a[3])) + ((b[0] + b[1]) + (b[2] + b[3]))) + (((c[0] + c[1]) + (c[2] + c[3])) + ((d[0] + d[1]) + (d[2] + d[3])));
    return __builtin_amdgcn_rsqf(s * (1.0f / 1024.0f) + 1e-6f);
}
__device__ __forceinline__ void rstd8(const float* ssqp, int row0, int fr, int fq, float (&rsv)[8], float mul) {
    float mine[2];
#pragma unroll
    for (int j = 0; j < 2; ++j) { const int k = 2 * fq + j; mine[j] = rstd_from_parts(ssqp, row0 + (k >> 2) * HALF + (k & 3) * 16) * mul; }
#pragma unroll
    for (int k = 0; k < 8; ++k) rsv[k] = __shfl(mine[k & 1], fr + 16 * (k >> 1));
}
template <bool ADD> struct EpiGate {
    static constexpr bool PERM = true, AFTER_DRAIN = false;
    const bf16_t* G; int ldg; const bf16_t* T; bf16_t* O;
    __device__ __forceinline__ void operator()(const f32x4 (&acc)[2][2][4][2], const Unit& u, int wr, int wc, int fr, int fq) const {
        const int row0 = u.pm * BM + wr * 64 + fr, col0 = u.pn * BM + wc * 32 + 8 * fq;
#pragma unroll
        for (int am = 0; am < 8; am += 2) {
            u32x4 gw[2][2], tw[2][2];
#pragma unroll
            for (int k = 0; k < 2; ++k)
#pragma unroll
                for (int bj = 0; bj < 2; ++bj) { const int row = row0 + ((am + k) >> 2) * HALF + ((am + k) & 3) * 16, col = col0 + bj * HALF; gw[k][bj] = *(const u32x4*)(G + (size_t)row * ldg + col); if (ADD) tw[k][bj] = *(const u32x4*)(T + (size_t)row * 1024 + col); }
#pragma unroll
            for (int k = 0; k < 2; ++k)
#pragma unroll
                for (int bj = 0; bj < 2; ++bj) { const int ai = (am + k) >> 2, m = (am + k) & 3; const int row = row0 + ai * HALF + m * 16, col = col0 + bj * HALF;
                    f32x4 g0, g1; unpack8(gw[k][bj], g0, g1);
                    f32x4 v0 = acc[ai][bj][m][0] * g0, v1 = acc[ai][bj][m][1] * g1;
                    if (ADD) { f32x4 t0, t1; unpack8(tw[k][bj], t0, t1); v0 += t0; v1 += t1; }
                    *(u32x4*)(O + (size_t)row * 1024 + col) = pack8(v0, v1); } }
    }
};
struct EpiGate2 {
    static constexpr bool PERM = true, AFTER_DRAIN = false;
    const bf16_t* G; int ldg; bf16_t* O;
    __device__ __forceinline__ void mid(f32x4 (&acc)[2][2][4][2], const Unit& u, int wr, int wc, int fr, int fq) const {
        const int row0 = u.pm * BM + wr * 64 + fr, col0 = u.pn * BM + wc * 32 + 8 * fq;
#pragma unroll
        for (int am = 0; am < 8; am += 2) {
            u32x4 ga[2][2], gp[2][2];
#pragma unroll
            for (int k = 0; k < 2; ++k)
#pragma unroll
                for (int bj = 0; bj < 2; ++bj) { const int row = row0 + ((am + k) >> 2) * HALF + ((am + k) & 3) * 16, col = col0 + bj * HALF; ga[k][bj] = *(const u32x4*)(G + (size_t)row * ldg + col); gp[k][bj] = *(const u32x4*)(G + (size_t)row * ldg + 1024 + col); }
#pragma unroll
            for (int k = 0; k < 2; ++k)
#pragma unroll
                for (int bj = 0; bj < 2; ++bj) { const int ai = (am + k) >> 2, m = (am + k) & 3;
                    f32x4 a0, a1, p0, p1; unpack8(ga[k][bj], a0, a1); unpack8(gp[k][bj], p0, p1);
#pragma unroll
                    for (int i = 0; i < 4; ++i) { acc[ai][bj][m][0][i] *= a0[i] * __builtin_amdgcn_rcpf(__builtin_fmaxf(p0[i], 1e-30f)); acc[ai][bj][m][1][i] *= a1[i] * __builtin_amdgcn_rcpf(__builtin_fmaxf(p1[i], 1e-30f)); } } }
    }
    __device__ __forceinline__ void operator()(const f32x4 (&acc)[2][2][4][2], const Unit& u, int wr, int wc, int fr, int fq) const {
        const int row0 = u.pm * BM + wr * 64 + fr, col0 = u.pn * BM + wc * 32 + 8 * fq;
#pragma unroll
        for (int am = 0; am < 8; am += 2) {
            u32x4 gp[2][2];
#pragma unroll
            for (int k = 0; k < 2; ++k)
#pragma unroll
                for (int bj = 0; bj < 2; ++bj) { const int row = row0 + ((am + k) >> 2) * HALF + ((am + k) & 3) * 16, col = col0 + bj * HALF; gp[k][bj] = *(const u32x4*)(G + (size_t)row * ldg + 1024 + col); }
#pragma unroll
            for (int k = 0; k < 2; ++k)
#pragma unroll
                for (int bj = 0; bj < 2; ++bj) { const int ai = (am + k) >> 2, m = (am + k) & 3; const int row = row0 + ai * HALF + m * 16, col = col0 + bj * HALF;
                    f32x4 p0, p1; unpack8(gp[k][bj], p0, p1);
                    *(u32x4*)(O + (size_t)row * 1024 + col) = pack8(acc[ai][bj][m][0] * p0, acc[ai][bj][m][1] * p1); } }
    }
};
template <bool OB8> struct EpiResid {
    static constexpr bool PERM = true, AFTER_DRAIN = false;
    bf16_t* rb; unsigned char* o8; float* ssqp; float sc, so;
    __device__ __forceinline__ void operator()(const f32x4 (&acc)[2][2][4][2], const Unit& u, int wr, int wc, int fr, int fq) const {
        const int row0 = u.pm * BM + wr * 64 + fr, col0 = u.pn * BM + wc * 32 + 8 * fq;
#pragma unroll
        for (int am = 0; am < 8; am += 4) {
            u32x4 rv[4][2];
#pragma unroll
            for (int k = 0; k < 4; ++k)
#pragma unroll
                for (int bj = 0; bj < 2; ++bj) { const size_t off = (size_t)(row0 + ((am + k) >> 2) * HALF + ((am + k) & 3) * 16) * 1024 + col0 + bj * HALF; rv[k][bj] = *(const u32x4*)(rb + off); }
#pragma unroll
            for (int k = 0; k < 4; ++k) { const int ai = (am + k) >> 2, m = (am + k) & 3; const int row = row0 + ai * HALF + m * 16; float ss = 0.f;
#pragma unroll
                for (int bj = 0; bj < 2; ++bj) { const size_t off = (size_t)row * 1024 + col0 + bj * HALF;
                    f32x4 r0, r1; unpack8(rv[k][bj], r0, r1);
                    const f32x4 v0 = acc[ai][bj][m][0] * sc + r0, v1 = acc[ai][bj][m][1] * sc + r1;
                    *(u32x4*)(rb + off) = pack8(v0, v1);
                    if (OB8) { u32x2 w8; w8.x = pk4_fp8(v0 * so); w8.y = pk4_fp8(v1 * so); *(u32x2*)(o8 + off) = w8; }
                    ss += ((v0[0] * v0[0] + v0[1] * v0[1]) + (v0[2] * v0[2] + v0[3] * v0[3])) + ((v1[0] * v1[0] + v1[1] * v1[1]) + (v1[2] * v1[2] + v1[3] * v1[3])); }
                ss += __shfl_xor(ss, 16); ss += __shfl_xor(ss, 32);
                if (fq == 0) ssqp[(size_t)row * 16 + u.pn * 4 + wc] = ss; } }
    }
};
template <bool GROUPED> struct EpiSwiGLU {
    static constexpr bool PERM = true, AFTER_DRAIN = false;
    bf16_t* O; int ldo; int nct; const float* ssqp; const float* meta; float rsc, gsc;
    __device__ __forceinline__ void operator()(const f32x4 (&acc)[2][2][4][2], const Unit& u, int wr, int wc, int fr, int fq) const {
        const int row0 = u.pm * BM + wr * 64 + fr, col0 = (u.pn % nct) * HALF + wc * 32 + 8 * fq;
        float rsv[8], gtv[8];
#pragma unroll
        for (int k = 0; k < 8; ++k) { const int row = row0 + (k >> 2) * HALF + (k & 3) * 16;
            if (GROUPED) { const f32x2 mt = *(const f32x2*)(meta + (size_t)row * 4); rsv[k] = mt.x; gtv[k] = mt.y; } else gtv[k] = gsc; }
        if (!GROUPED) rstd8(ssqp, row0, fr, fq, rsv, rsc);
#pragma unroll
        for (int ai = 0; ai < 2; ++ai)
#pragma unroll
            for (int m = 0; m < 4; ++m) { const int row = row0 + ai * HALF + m * 16; const float rs = rsv[ai * 4 + m], gt = gtv[ai * 4 + m];
                f32x4 o[2];
#pragma unroll
                for (int n = 0; n < 2; ++n)
#pragma unroll
                    for (int i = 0; i < 4; ++i) { const float a1 = acc[ai][0][m][n][i] * rs, a3 = acc[ai][1][m][n][i] * rs; o[n][i] = a1 * fsigmoid(a1) * a3 * gt; }
                u32x2 w8; w8.x = pk4_fp8(o[0]); w8.y = pk4_fp8(o[1]); *(u32x2*)((unsigned char*)O + (size_t)row * ldo + col0) = w8; }
    }
};
struct EpiPlain {
    static constexpr bool PERM = true, AFTER_DRAIN = false;
    bf16_t* O; int ldo; int nct; float sc;
    __device__ __forceinline__ void operator()(const f32x4 (&acc)[2][2][4][2], const Unit& u, int wr, int wc, int fr, int fq) const {
        const int row0 = u.pm * BM + wr * 64 + fr, col0 = (u.pn % nct) * BM + wc * 32 + 8 * fq;
#pragma unroll
        for (int ai = 0; ai < 2; ++ai)
#pragma unroll
            for (int m = 0; m < 4; ++m) { bf16_t* rowp = O + (size_t)(row0 + ai * HALF + m * 16) * ldo + col0;
#pragma unroll
                for (int bj = 0; bj < 2; ++bj) *(u32x4*)(rowp + bj * HALF) = pack8(acc[ai][bj][m][0] * sc, acc[ai][bj][m][1] * sc); }
    }
};
struct GroupedOrder {
    int nct, G, c, nrt, t1, t2, t3, t4, t5, t6, t7, l0, l1, ksplit, kchunk;
    __device__ __forceinline__ bool next(int i, Unit& u) const {
        const int S = i * G + c; if (S >= (l1 - l0) * ksplit) return false;
        const int L = l0 + S / ksplit, kp = S % ksplit;
        const int rt = L / nct, ct = L % nct;
        const int e = (rt >= t1) + (rt >= t2) + (rt >= t3) + (rt >= t4) + (rt >= t5) + (rt >= t6) + (rt >= t7);
        u.pm = rt; u.pn = e * nct + ct; u.ko = kp * kchunk; return true;
    }
    __device__ __forceinline__ void a_ready(const Unit&) const {}
    __device__ __forceinline__ void done(const Unit&) const {}
};
struct EpiSlab {
    static constexpr bool PERM = true, AFTER_DRAIN = false;
    float* S; int nct, rt0, ksplit, kchunk; float sc;
    __device__ __forceinline__ void operator()(const f32x4 (&acc)[2][2][4][2], const Unit& u, int wr, int wc, int fr, int fq) const {
        float* T = S + ((size_t)((u.pm - rt0) * nct + (u.pn % nct)) * ksplit + u.ko / kchunk) * (BM * BM);
        const int r0 = wr * 64 + fr, c0 = wc * 32 + 8 * fq;
#pragma unroll
        for (int ai = 0; ai < 2; ++ai)
#pragma unroll
            for (int m = 0; m < 4; ++m) { float* rowp = T + (unsigned)((r0 + ai * HALF + m * 16) * BM + c0);
#pragma unroll
                for (int bj = 0; bj < 2; ++bj) { *(f32x4*)(rowp + bj * HALF) = acc[ai][bj][m][0] * sc; *(f32x4*)(rowp + bj * HALF + 4) = acc[ai][bj][m][1] * sc; } }
    }
};
typedef int i32x4 __attribute__((ext_vector_type(4)));
typedef int i32x8 __attribute__((ext_vector_type(8)));
__device__ __forceinline__ i32x8 cat8(const bf16x8 a, const bf16x8 b) { return __builtin_shufflevector(__builtin_bit_cast(i32x4, a), __builtin_bit_cast(i32x4, b), 0, 1, 2, 3, 4, 5, 6, 7); }
__device__ __forceinline__ bf16x8 half8(const i32x8 v, int k) { return k == 0 ? __builtin_bit_cast(bf16x8, __builtin_shufflevector(v, v, 0, 1, 2, 3)) : __builtin_bit_cast(bf16x8, __builtin_shufflevector(v, v, 4, 5, 6, 7)); }
template <class E, class = void> struct epi_has_mid { static constexpr bool value = false; };
template <class E> struct epi_has_mid<E, decltype((void)&E::mid)> { static constexpr bool value = true; };
template <class Epi, class Sched, bool ALIGN_EPI = false, bool SP2 = false, bool F8 = false>
__device__ __forceinline__ void gemm_phase(PG8_LAS unsigned char* lds, const Gemm g, const Sched& S, const Epi& E, const int wv  ) {
    int wv_ = wv; asm volatile("" : "+s"(wv_)); int tid_ = wv_ * 64 + mk_lane(); asm volatile("" : "+v"(tid_));
    const int tid = tid_, wid = wv_, lane = tid & 63, wr = wid >> 2, wc = wid & 3, fr = lane & 15, fq = lane >> 4;
    const int K = g.K, nt = K / BK;
    unsigned voffA[2], voffB[2];
#pragma unroll
    for (int i = 0; i < 2; ++i) { int R, C; stage_rc(tid * 16 + i * 8192, R, C); const int Rb = Epi::PERM ? ((R & ~31) + perm32(R & 31)) : R;
        voffA[i] = (unsigned)(R * g.ld + C) * 2u; voffB[i] = (unsigned)(Rb * g.ld + C) * 2u; }
    const size_t kstep = (size_t)(BK * 2);
    const size_t hstep = (size_t)HALF * g.ld * 2;
    const size_t tstep = 2 * hstep;
    const unsigned ldsw = (unsigned)wid * 1024u;
    const int aoff = lds_byte(wr * 64 + fr, fq * 8), boff = lds_byte(wc * 32 + fr, fq * 8);
#define PG8_SA(b, h) (((b) * 2 + (h)) * HTB)
#define PG8_SB(b, h) ((4 + (b) * 2 + (h)) * HTB)
#define PG8_STAGE(bufoff, gbase, voff) do { const char* _g = (const char*)(gbase); if constexpr (F8) asm volatile("" : "+s"(_g));   \
        _Pragma("unroll") for (int _i = 0; _i < 2; ++_i) { unsigned _v = (voff)[F8 ? 0 : _i]; if constexpr (F8) asm volatile("" : "+v"(_v));   \
        __builtin_amdgcn_global_load_lds((const unsigned*)(_g + (F8 ? (size_t)_i * 128 * g.ld : (size_t)0) + _v), (PG8_LAS unsigned*)(lds + (bufoff) + ldsw + _i * 8192), 16, 0, 0); } } while (0)
#define PG8_LDA(dst, b, h) do { _Pragma("unroll") for (int m = 0; m < 4; ++m) dst[m] = cat8(*(const PG8_LAS bf16x8*)(lds + PG8_SA(b, h) + aoff + m * 2048), *(const PG8_LAS bf16x8*)(lds + PG8_SA(b, h) + aoff + m * 2048 + 1024)); } while (0)
#define PG8_LDB(dst, b, h) do { _Pragma("unroll") for (int n = 0; n < 2; ++n) dst[n] = cat8(*(const PG8_LAS bf16x8*)(lds + PG8_SB(b, h) + boff + n * 2048), *(const PG8_LAS bf16x8*)(lds + PG8_SB(b, h) + boff + n * 2048 + 1024)); } while (0)
#define PG8_MMA(ai, bj, At, Bt) do { __builtin_amdgcn_s_setprio(1); _Pragma("unroll") for (int m = 0; m < 4; ++m) _Pragma("unroll") for (int n = 0; n < 2; ++n) _Pragma("unroll") for (int k = 0; k < 2; ++k) \
        acc[ai][bj][m][n] = __builtin_amdgcn_mfma_f32_16x16x32_bf16(half8(Bt[n], k), half8(At[m], k), acc[ai][bj][m][n], 0, 0, 0); __builtin_amdgcn_s_setprio(0); } while (0)
#define PG8_MMA8(ai, bj, At, Bt) do { __builtin_amdgcn_s_setprio(1); _Pragma("unroll") for (int m = 0; m < 4; ++m) _Pragma("unroll") for (int n = 0; n < 2; ++n) \
        acc[ai][bj][m][n] = __builtin_amdgcn_mfma_scale_f32_16x16x128_f8f6f4(Bt[n], At[m], acc[ai][bj][m][n], 0, 0, 0, 0x7f7f7f7f, 0, 0x7f7f7f7f); __builtin_amdgcn_s_setprio(0); } while (0)
#define PG8_MM(ai, bj, At, Bt) do { if constexpr (F8) PG8_MMA8(ai, bj, At, Bt); else PG8_MMA(ai, bj, At, Bt); } while (0)
#define PG8_WAIT_V(n) asm volatile("s_waitcnt vmcnt(" #n ")" ::: "memory")
#define PG8_WAIT_L(n) asm volatile("s_waitcnt lgkmcnt(" #n ")" ::: "memory")
#define PG8_BAR __builtin_amdgcn_s_barrier()
#define PG8_SCHED __builtin_amdgcn_sched_barrier(0)
    Unit cur, nxt; int ui = 0;
    if (!S.next(0, cur)) return;
    f32x4 acc[2][2][4][2];
#pragma unroll
    for (int a = 0; a < 2; ++a)
#pragma unroll
        for (int b = 0; b < 2; ++b)
#pragma unroll
            for (int m = 0; m < 4; ++m)
#pragma unroll
                for (int n = 0; n < 2; ++n) acc[a][b][m][n] = (f32x4){0.f, 0.f, 0.f, 0.f};
    i32x8 At[4], B0[2], B1[2];
    const char* cA = (const char*)g.A + (size_t)cur.pm * tstep + (size_t)cur.ko * 2; const char* cB = (const char*)g.Bt + (size_t)cur.pn * tstep + (size_t)cur.ko * 2 + (g.pnsplit > 0 && cur.pn >= g.pnsplit ? g.bt2off : 0ll);
    S.a_ready(cur);
    if constexpr (SP2) {
        PG8_STAGE(PG8_SB(0, 0), cB, voffB); PG8_STAGE(PG8_SB(0, 1), cB + hstep, voffB); PG8_STAGE(PG8_SA(0, 0), cA, voffA); PG8_STAGE(PG8_SA(0, 1), cA + hstep, voffA);
        if (wr == 1) PG8_BAR;
        PG8_WAIT_V(2); PG8_BAR;
        PG8_STAGE(PG8_SB(1, 0), cB + kstep, voffB); PG8_STAGE(PG8_SA(1, 0), cA + kstep, voffA); PG8_STAGE(PG8_SB(1, 1), cB + hstep + kstep, voffB);
        PG8_WAIT_V(6); PG8_BAR;
    } else {
        PG8_STAGE(PG8_SB(0, 0), cB, voffB); PG8_STAGE(PG8_SA(0, 0), cA, voffA); PG8_STAGE(PG8_SB(0, 1), cB + hstep, voffB); PG8_STAGE(PG8_SA(0, 1), cA + hstep, voffA);
        if (wr == 1) PG8_BAR;
        PG8_WAIT_V(4); PG8_BAR;
        PG8_STAGE(PG8_SB(1, 0), cB + kstep, voffB); PG8_STAGE(PG8_SA(1, 0), cA + kstep, voffA); PG8_STAGE(PG8_SB(1, 1), cB + hstep + kstep, voffB);
        PG8_WAIT_V(6); PG8_BAR;
    }
    const long long dA = g.nt1 > 0 ? (long long)((const char*)g.A2 - (const char*)g.A) - (long long)g.nt1 * (long long)kstep : 0ll, dB = g.nt1 > 0 ? (long long)((const char*)g.Bt2 - (const char*)g.Bt) - (long long)g.nt1 * (long long)kstep : 0ll;
    for (;;) {
        const bool has_next = S.next(ui + 1, nxt);
        const char* nA = has_next ? (const char*)g.A + (size_t)nxt.pm * tstep + (size_t)nxt.ko * 2 : cA; const char* nB = has_next ? (const char*)g.Bt + (size_t)nxt.pn * tstep + (size_t)nxt.ko * 2 + (g.pnsplit > 0 && nxt.pn >= g.pnsplit ? g.bt2off : 0ll) : cB;
#pragma unroll 1
        for (int t = 0; t < nt; t += 2) {
            const bool last = (t == nt - 2);
            const long long o1 = (g.nt1 > 0 && t + 1 >= g.nt1) ? 1ll : 0ll, o2 = (g.nt1 > 0 && t + 2 >= g.nt1) ? 1ll : 0ll;
            const char* a1 = cA + (size_t)(t + 1) * kstep + o1 * dA;
            const char* a2 = last ? nA : cA + (size_t)(t + 2) * kstep + o2 * dA; const char* b2 = last ? nB : cB + (size_t)(t + 2) * kstep + o2 * dB;
            if constexpr (epi_has_mid<Epi>::value) { if (g.nt1 > 0 && t == g.nt1) { const int t2_ = mk_lane(); E.mid(acc, cur, wr, wc, t2_ & 15, t2_ >> 4); } }
            const char* a3 = a2 + kstep; const char* b3 = b2 + kstep;
            if (last && has_next) S.a_ready(nxt);
            if constexpr (SP2) {
            PG8_LDB(B0, 0, 0); PG8_LDB(B1, 0, 1); PG8_SCHED; PG8_LDA(At, 0, 0); PG8_STAGE(PG8_SA(1, 1), a1 + hstep, voffA);
            PG8_WAIT_V(8); PG8_WAIT_L(0); PG8_BAR; PG8_MM(0, 0, At, B0); PG8_MM(0, 1, At, B1); PG8_BAR; PG8_SCHED;
            PG8_LDA(At, 0, 1); PG8_STAGE(PG8_SB(0, 0), b2, voffB); PG8_STAGE(PG8_SB(0, 1), b2 + hstep, voffB); PG8_STAGE(PG8_SA(0, 0), a2, voffA);
            PG8_WAIT_V(8); PG8_WAIT_L(0); PG8_BAR; PG8_MM(1, 0, At, B0); PG8_MM(1, 1, At, B1); PG8_BAR; PG8_SCHED;
            PG8_LDB(B0, 1, 0); PG8_LDB(B1, 1, 1); PG8_SCHED; PG8_LDA(At, 1, 0); PG8_STAGE(PG8_SA(0, 1), a2 + hstep, voffA);
            PG8_WAIT_V(8); PG8_WAIT_L(0); PG8_BAR; PG8_MM(0, 0, At, B0); PG8_MM(0, 1, At, B1); PG8_BAR; PG8_SCHED;
            PG8_LDA(At, 1, 1); PG8_STAGE(PG8_SB(1, 0), b3, voffB); PG8_STAGE(PG8_SB(1, 1), b3 + hstep, voffB); PG8_STAGE(PG8_SA(1, 0), a3, voffA);
            PG8_WAIT_V(8); PG8_WAIT_L(0); PG8_BAR; PG8_MM(1, 0, At, B0); PG8_MM(1, 1, At, B1); PG8_BAR; PG8_SCHED;
            } else {
            PG8_LDB(B0, 0, 0); PG8_SCHED; PG8_LDA(At, 0, 0); PG8_STAGE(PG8_SA(1, 1), a1 + hstep, voffA);
            PG8_WAIT_L(8); PG8_BAR; PG8_WAIT_L(0); PG8_MM(0, 0, At, B0); PG8_BAR; PG8_SCHED;
            PG8_LDB(B1, 0, 1); PG8_STAGE(PG8_SB(0, 0), b2, voffB);
            PG8_BAR; PG8_WAIT_L(0); PG8_MM(0, 1, At, B1); PG8_BAR;
            PG8_LDA(At, 0, 1); PG8_STAGE(PG8_SA(0, 0), a2, voffA);
            PG8_BAR; PG8_WAIT_L(0); PG8_MM(1, 0, At, B0); PG8_BAR; PG8_SCHED;
            PG8_STAGE(PG8_SB(0, 1), b2 + hstep, voffB);
            PG8_WAIT_V(6); PG8_BAR; PG8_MM(1, 1, At, B1); PG8_BAR;
            PG8_LDB(B0, 1, 0); PG8_SCHED; PG8_LDA(At, 1, 0); PG8_STAGE(PG8_SA(0, 1), a2 + hstep, voffA);
            PG8_WAIT_L(8); PG8_BAR; PG8_WAIT_L(0); PG8_MM(0, 0, At, B0); PG8_BAR; PG8_SCHED;
            PG8_LDB(B1, 1, 1); PG8_STAGE(PG8_SB(1, 0), b3, voffB);
            PG8_BAR; PG8_WAIT_L(0); PG8_MM(0, 1, At, B1); PG8_BAR;
            PG8_LDA(At, 1, 1); PG8_STAGE(PG8_SA(1, 0), a3, voffA);
            PG8_BAR; PG8_WAIT_L(0); PG8_MM(1, 0, At, B0); PG8_BAR; PG8_SCHED;
            PG8_STAGE(PG8_SB(1, 1), b3 + hstep, voffB);
            PG8_WAIT_V(6); PG8_BAR; PG8_MM(1, 1, At, B1); PG8_BAR;
            }
        }
        if constexpr (ALIGN_EPI) { if (wr == 0) PG8_BAR; }
        if constexpr (!Epi::AFTER_DRAIN) { int fr_ = fr, fq_ = fq; if constexpr (F8 || epi_has_mid<Epi>::value) { int t2_ = (int)__builtin_amdgcn_mbcnt_hi(~0u, __builtin_amdgcn_mbcnt_lo(~0u, 0u)); asm volatile("" : "+v"(t2_)); fr_ = t2_ & 15; fq_ = t2_ >> 4; }   E(acc, cur, wr, wc, fr_, fq_); S.done(cur); }
        if (!has_next) break;
#pragma unroll
        for (int a = 0; a < 2; ++a)
#pragma unroll
            for (int b = 0; b < 2; ++b)
#pragma unroll
                for (int m = 0; m < 4; ++m)
#pragma unroll
                    for (int n = 0; n < 2; ++n) acc[a][b][m][n] = (f32x4){0.f, 0.f, 0.f, 0.f};
        cur = nxt; cA = nA; cB = nB; ++ui;
        if constexpr (ALIGN_EPI) { if (wr == 1) PG8_BAR; }
    }
    PG8_WAIT_V(0);
    if constexpr (!ALIGN_EPI) { if (wr == 0) PG8_BAR; }
    PG8_BAR;
    if constexpr (Epi::AFTER_DRAIN) { E.fused(acc, cur, wr, wc, fr, fq, lds, wid, lane); S.done(cur); }
#undef PG8_SA
#undef PG8_SB
#undef PG8_STAGE
#undef PG8_LDA
#undef PG8_LDB
#undef PG8_MMA
#undef PG8_MMA8
#undef PG8_MM
#undef PG8_WAIT_V
#undef PG8_WAIT_L
#undef PG8_BAR
#undef PG8_SCHED
}
}
#include <hip/hip_bf16.h>
#include <cmath>
namespace attn_body {
using bf16=__hip_bfloat16;
using bf16x8=__attribute__((ext_vector_type(8)))short;
using s16x4=__attribute__((ext_vector_type(4)))short;
using f32x16=__attribute__((ext_vector_type(16)))float;
using u32x4=__attribute__((ext_vector_type(4)))unsigned;
constexpr int BATCH=2,NHEAD=8,SEQ=8192,D=64,DM=NHEAD*D;
constexpr int NW=8,QBLK=32,QB=QBLK*NW,KVBLK=64,NQB=SEQ/QB;
constexpr int ATTN_PITCH=DM, ATTN_UNIT_ROWS=QB;
__device__ __forceinline__ int crow(int r,int hi){return (r&3)+8*(r>>2)+4*hi;}
#define SBAR() __builtin_amdgcn_sched_barrier(0)
typedef const __attribute__((address_space(4))) unsigned long long* cmask_ptr;
__device__ __forceinline__ float msel(unsigned long long m,float if_set,float if_clear){float r;asm("v_cndmask_b32_e64 %0, %1, %2, %3":"=v"(r):"v"(if_clear),"v"(if_set),"s"(m));return r;}
typedef unsigned long long u64x8 __attribute__((ext_vector_type(8)));
__device__ __forceinline__ void mload16(u64x8&a,u64x8&b,unsigned long long base,int t){
  const __attribute__((address_space(4))) u64x8* p=(const __attribute__((address_space(4))) u64x8*)(base+(unsigned long long)t*256ull);
  a=p[0];b=p[1];
}
__device__ __forceinline__ void mkc16(f32x16&c,const u64x8&a,const u64x8&b,float negmh,float ninf){
  #pragma unroll
  for(int r=0;r<8;++r){c[r]=msel(a[r],negmh,ninf);c[8+r]=msel(b[r],negmh,ninf);}
}

constexpr int NSLOT=3, SLOTB=8192;
constexpr int LDS_K=0, LDS_V=NSLOT*SLOTB, LDS_WS=2*NSLOT*SLOTB, LDS_OST=LDS_WS+NW*64*4, LDS_BYTES=LDS_OST+NW*4096;
constexpr float C2=0.125f*1.4426950408889634f;
__device__ __forceinline__ void glds16(const void*gsrc,unsigned lds_dst){unsigned keep;
  asm volatile("s_mov_b32 %0, m0\n\ts_mov_b32 m0, %2\n\ts_nop 0\n\tglobal_load_lds_dwordx4 %1, off\n\ts_mov_b32 m0, %0":"=&s"(keep):"v"(gsrc),"s"(lds_dst):"memory");}
__device__ __forceinline__ float max3f(float a,float b,float c){float r;asm("v_max3_f32 %0, %1, %2, %3":"=v"(r):"v"(a),"v"(b),"v"(c));return r;}
__device__ __forceinline__ float max2f(float a,float b){float r;asm("v_max_f32_e32 %0, %1, %2":"=v"(r):"v"(a),"v"(b));return r;}
__device__ __forceinline__ float fadd_s(float a,float b){float r;asm("v_add_f32_e32 %0, %1, %2":"=v"(r):"v"(a),"v"(b));return r;}
__device__ __forceinline__ float fsub_s(float a,float b){float r;asm("v_sub_f32_e32 %0, %1, %2":"=v"(r):"v"(a),"v"(b));return r;}
typedef float f32x2_t __attribute__((ext_vector_type(2))); typedef __bf16 bf16x2_t __attribute__((ext_vector_type(2)));
__device__ __forceinline__ unsigned cvtpk_s(float lo,float hi){f32x2_t v={lo,hi};bf16x2_t b=__builtin_convertvector(v,bf16x2_t);return __builtin_bit_cast(unsigned,b);}
#define WAIT_BAR(N) do{ asm volatile("s_waitcnt vmcnt(" #N ") lgkmcnt(0)\n\ts_barrier":::"memory"); __builtin_amdgcn_s_waitcnt(0xC07F); }while(0)

__device__ __forceinline__ void qkt(f32x16&p0,f32x16&p1,const char*Kslot,const bf16x8*qr,int r32,int hi){
  const char*kb=Kslot+hi*1024+r32*16;
  #pragma unroll
  for(int d0=0;d0<4;++d0){
    const bf16x8 b0=*reinterpret_cast<const bf16x8*>(kb+d0*2048);
    const bf16x8 b1=*reinterpret_cast<const bf16x8*>(kb+d0*2048+512);
    p0=__builtin_amdgcn_mfma_f32_32x32x16_bf16(b0,qr[d0],p0,0,0,0);p1=__builtin_amdgcn_mfma_f32_32x32x16_bf16(b1,qr[d0],p1,0,0,0);}
}
typedef __attribute__((address_space(3))) const char* lds_cptr;
typedef short v4i16_t __attribute__((ext_vector_type(4)));
__device__ __forceinline__ void kload8(bf16x8*kf,lds_cptr kp){
  kf[0]=*(const __attribute__((address_space(3))) bf16x8*)(kp);      kf[1]=*(const __attribute__((address_space(3))) bf16x8*)(kp+512);
  kf[2]=*(const __attribute__((address_space(3))) bf16x8*)(kp+2048); kf[3]=*(const __attribute__((address_space(3))) bf16x8*)(kp+2560);
  kf[4]=*(const __attribute__((address_space(3))) bf16x8*)(kp+4096); kf[5]=*(const __attribute__((address_space(3))) bf16x8*)(kp+4608);
  kf[6]=*(const __attribute__((address_space(3))) bf16x8*)(kp+6144); kf[7]=*(const __attribute__((address_space(3))) bf16x8*)(kp+6656);
}
__device__ __forceinline__ void kload2(bf16x8*kf,lds_cptr kp,int j){ kf[2*j]=*(const __attribute__((address_space(3))) bf16x8*)(kp+j*2048); kf[2*j+1]=*(const __attribute__((address_space(3))) bf16x8*)(kp+j*2048+512); }
__device__ __forceinline__ s16x4 vtr(lds_cptr p){ return __builtin_bit_cast(s16x4,__builtin_amdgcn_ds_read_tr16_b64_v4i16((__attribute__((address_space(3))) v4i16_t*)p)); }
__device__ __forceinline__ float rowmax(const f32x16&p0,const f32x16&p1){
  float a=max3f(p0[0],p0[1],p1[0]),b=max3f(p0[2],p0[3],p1[1]);a=max3f(a,p1[2],p1[3]);
  #pragma unroll
  for(int r=4;r<16;r+=4){a=max3f(a,p0[r],p0[r+1]);b=max3f(b,p0[r+2],p0[r+3]);a=max3f(a,p1[r],p1[r+1]);b=max3f(b,p1[r+2],p1[r+3]);}
  const float m=max2f(a,b);
  auto rr=__builtin_amdgcn_permlane32_swap(__float_as_uint(m),__float_as_uint(m),false,false);
  return max2f(__uint_as_float(rr[0]),__uint_as_float(rr[1]));
}
__device__ __forceinline__ void pv(f32x16*o,int vb,bf16x8 pa0,bf16x8 pa1,bf16x8 pa2,bf16x8 pa3){
  #pragma unroll
  for(int d0=0;d0<2;++d0){s16x4 lo[4],hi[4];
    #pragma unroll
    for(int ks=0;ks<4;++ks){
      asm volatile("ds_read_b64_tr_b16 %0,%1 offset:%c2":"=&v"(lo[ks]):"v"(vb),"i"(d0*4096+ks*1024):"memory");
      asm volatile("ds_read_b64_tr_b16 %0,%1 offset:%c2":"=&v"(hi[ks]):"v"(vb),"i"(d0*4096+ks*1024+512):"memory");}
    asm volatile("s_waitcnt lgkmcnt(0)":::"memory");SBAR();
    #define PK(k) (bf16x8){lo[k][0],lo[k][1],lo[k][2],lo[k][3],hi[k][0],hi[k][1],hi[k][2],hi[k][3]}
    o[d0]=__builtin_amdgcn_mfma_f32_32x32x16_bf16(pa0,PK(0),o[d0],0,0,0);
    o[d0]=__builtin_amdgcn_mfma_f32_32x32x16_bf16(pa1,PK(1),o[d0],0,0,0);
    o[d0]=__builtin_amdgcn_mfma_f32_32x32x16_bf16(pa2,PK(2),o[d0],0,0,0);
    o[d0]=__builtin_amdgcn_mfma_f32_32x32x16_bf16(pa3,PK(3),o[d0],0,0,0);
    #undef PK
  }
}

#ifndef ATTN_STORE16
#define ATTN_STORE16(p,v) (*(u32x4*)(p)=(v))
#endif
template<int THRL> __device__ __forceinline__ void attn_unit(int b,int h,int qb,const bf16*Q,const bf16*__restrict__ K,const bf16*__restrict__ V,bf16*O,const unsigned long long*MASK,char*shm,const int wv){
  int wv_=wv; asm volatile("":"+s"(wv_)); int tid_=wv_*64+mk_lane(); asm volatile("":"+v"(tid_)); const int tid=tid_,lane=tid&63,r32=lane&31,hi=lane>>5; const int wid=wv_;
  const long rowbase=(long)b*SEQ; const int q0=qb*QB;
  const bf16*Qw=Q+(rowbase+q0+wid*QBLK)*DM+h*D;
  const bf16*Kh=K+rowbase*DM+h*D,*Vh=V+rowbase*DM+h*D;
  const unsigned lds0=(unsigned)(uintptr_t)shm;
  float*wsf=(float*)(shm+LDS_WS)+wid*64;
  const bf16*ksrc=Kh+(long)lane*DM+wid*8;
  const bf16*vsrc=Vh+(long)(16*(wid&3)+(lane>>2))*DM+(wid>>2)*32+(lane&3)*8;
  const unsigned kdst=lds0+LDS_K+wid*1024, vdst=lds0+LDS_V+wid*1024;
  #define DMA_K(t,slot) glds16(ksrc+(long)(t)*KVBLK*DM,(unsigned)__builtin_amdgcn_readfirstlane(kdst+(slot)))
  #define DMA_V(t,slot) glds16(vsrc+(long)(t)*KVBLK*DM,(unsigned)__builtin_amdgcn_readfirstlane(vdst+(slot)))
  const int vb0=(int)(lds0+LDS_V)+((lane>>4)&1)*32+(lane&3)*8+(4*hi+((lane&15)>>2))*64;
  const char*Kbase=shm+LDS_K; bf16x8 kf[8];
  const lds_cptr shm3=(lds_cptr)shm; const lds_cptr kp0=shm3+LDS_K+hi*1024+r32*16; const lds_cptr vp0=shm3+LDS_V+((lane>>4)&1)*32+(lane&3)*8+(4*hi+((lane&15)>>2))*64;
  const int NT=(q0+QB)/KVBLK;
  DMA_K(0,0);DMA_V(0,0);DMA_K(1,SLOTB);
  bf16x8 qr[4];
  #pragma unroll
  for(int d0=0;d0<4;++d0)qr[d0]=*reinterpret_cast<const bf16x8*>(&Qw[(long)r32*DM+d0*16+hi*8]);
  float mhat=0.f,l_reg=0.f,negmh=0.f;f32x16 o[2];o[0]=f32x16{};o[1]=f32x16{};float NINF=-INFINITY;asm volatile("":"+v"(NINF));
  unsigned long long mbase=(unsigned long long)(uintptr_t)(MASK+((size_t)((b*256+qb*8+wid)*128))*32);asm volatile("":"+s"(mbase));
  bool resc=false;
  #define RESC() do{ if(resc){ asm volatile("s_waitcnt lgkmcnt(0)":::"memory"); \
      _Pragma("unroll") for(int d_=0;d_<2;++d_) _Pragma("unroll") for(int r=0;r<16;++r)o[d_][r]*=wsf[crow(r,hi)]; } }while(0)
  f32x16 pA0,pA1,pB0,pB1;
  int sl_prev=0,sl_cur=0,sl_next=SLOTB;
  #define ROT() do{sl_prev=sl_cur;sl_cur=sl_next;sl_next=(sl_next==(NSLOT-1)*SLOTB)?0:sl_next+SLOTB;}while(0)
  DMA_K(2,2*SLOTB);
  WAIT_BAR(3);
  u64x8 mA0,mA1,mB0,mB1;
  mload16(mA0,mA1,mbase,0);mload16(mB0,mB1,mbase+128ull,0);
  mkc16(pA0,mA0,mA1,negmh,NINF);mkc16(pA1,mB0,mB1,negmh,NINF);SBAR();
  mload16(mA0,mA1,mbase,1);mload16(mB0,mB1,mbase+128ull,1);SBAR();
  qkt(pA0,pA1,Kbase,qr,r32,hi);asm volatile("s_nop 15\n\ts_nop 7":"+v"(pA0),"+v"(pA1));
  { const float rm=rowmax(pA0,pA1);
    if(__any(rm>(float)THRL)){ const float dl=__builtin_fmaxf(rm,0.f); mhat+=dl; negmh=-mhat;
      _Pragma("unroll") for(int r=0;r<16;++r){pA0[r]-=dl;pA1[r]-=dl;} } }
  _Pragma("unroll") for(int r=0;r<16;++r){pA0[r]=__builtin_amdgcn_exp2f(pA0[r]);pA1[r]=__builtin_amdgcn_exp2f(pA1[r]);}
  WAIT_BAR(0);
  DMA_K(3,0);DMA_V(1,SLOTB);
  ROT();
  kload8(kf,kp0+sl_cur);
  WAIT_BAR(2);
  s16x4 vlo[8],vhi[8]; u32x4 pw0,pw1,pw2,pw3;
  #define PKW(P,B) cvtpk_s(P[B],P[B+1])
  #define PAF(k) __builtin_bit_cast(bf16x8,pw##k)
  #define VFR(i) (bf16x8){vlo[i][0],vlo[i][1],vlo[i][2],vlo[i][3],vhi[i][0],vhi[i][1],vhi[i][2],vhi[i][3]}
  #define PIN(x) asm volatile("":"+v"(x))
  #define MX3(a,b,c) __builtin_fmaxf(__builtin_fmaxf((a),(b)),(c))
  #define GAPA(MF,A0,A1,A2,A3,W0,W1,PW) do{ MF; sacc+=A0; sacc+=A1; sacc+=A2; sacc+=A3; PIN(sacc); W0; W1; PIN(PW); SBAR(); }while(0)
  #define EX(v) __builtin_amdgcn_exp2f(v)
  #define GAPB(MF,X,B) do{ MF; X[B]=EX(X[B]); X[B+1]=EX(X[B+1]); X[B+2]=EX(X[B+2]); X[B+3]=EX(X[B+3]); PIN(X); SBAR(); }while(0)
  #define VRD(i) do{ vlo[i]=vtr(vp_+(((i)>>2)*4096+((i)&3)*1024)); vhi[i]=vtr(vp_+(((i)>>2)*4096+((i)&3)*1024+512)); }while(0)
  #define KRD(G,j) do{ if(G){ kload2(kf,kp0+sl_next,j); SBAR(); } }while(0)
  #define STEP(C0,C1,P0,P1,t,GK,GV,GL) do{ SBAR(); \
    mkc16(C0,mA0,mA1,negmh,NINF); SBAR(); \
    const lds_cptr vp_=vp0+sl_prev; \
    VRD(0); SBAR(); float sacc=(P0[0]+P0[1]); \
    GAPA(C0=__builtin_amdgcn_mfma_f32_32x32x16_bf16(kf[0],qr[0],C0,0,0,0), P0[2],P0[3],P0[4],P0[5],     pw0[0]=PKW(P0,0), pw0[1]=PKW(P0,2), pw0); \
    mkc16(C1,mB0,mB1,negmh,NINF); SBAR(); { const int tn_=((t)+1<NT)?(t)+1:(t); mload16(mA0,mA1,mbase,tn_); mload16(mB0,mB1,mbase+128ull,tn_); } SBAR();     \
    VRD(4); SBAR(); GAPA(C1=__builtin_amdgcn_mfma_f32_32x32x16_bf16(kf[1],qr[0],C1,0,0,0), P0[6],P0[7],P0[8],P0[9],     pw0[2]=PKW(P0,4), pw0[3]=PKW(P0,6), pw0); \
    VRD(1); SBAR(); GAPA(C0=__builtin_amdgcn_mfma_f32_32x32x16_bf16(kf[2],qr[1],C0,0,0,0),   P0[10],P0[11],P0[12],P0[13], pw1[0]=PKW(P0,8), pw1[1]=PKW(P0,10), pw1); \
    VRD(5); SBAR(); GAPA(C1=__builtin_amdgcn_mfma_f32_32x32x16_bf16(kf[3],qr[1],C1,0,0,0),   P0[14],P0[15],P1[0],P1[1],   pw1[2]=PKW(P0,12),pw1[3]=PKW(P0,14), pw1); \
    VRD(2); SBAR(); GAPA(C0=__builtin_amdgcn_mfma_f32_32x32x16_bf16(kf[4],qr[2],C0,0,0,0),   P1[2],P1[3],P1[4],P1[5],     pw2[0]=PKW(P1,0), pw2[1]=PKW(P1,2), pw2); \
    VRD(6); SBAR(); GAPA(C1=__builtin_amdgcn_mfma_f32_32x32x16_bf16(kf[5],qr[2],C1,0,0,0),   P1[6],P1[7],P1[8],P1[9],     pw2[2]=PKW(P1,4), pw2[3]=PKW(P1,6), pw2); \
    VRD(3); SBAR(); GAPA(C0=__builtin_amdgcn_mfma_f32_32x32x16_bf16(kf[6],qr[3],C0,0,0,0),   P1[10],P1[11],P1[12],P1[13], pw3[0]=PKW(P1,8), pw3[1]=PKW(P1,10), pw3); \
    VRD(7); SBAR(); GAPA(C1=__builtin_amdgcn_mfma_f32_32x32x16_bf16(kf[7],qr[3],C1,0,0,0),   P1[14],P1[15],0.f,0.f,       pw3[2]=PKW(P1,12),pw3[3]=PKW(P1,14), pw3); \
    l_reg+=sacc; \
    if(GK){DMA_K((t)+3,sl_cur);} if(GV){DMA_V((t)+1,sl_next);} \
    { float a=MX3(C0[0],C0[1],C1[0]),b=MX3(C0[2],C0[3],C1[1]); a=MX3(a,C1[2],C1[3]); \
      _Pragma("unroll") for(int r=4;r<16;r+=4){a=MX3(a,C0[r],C0[r+1]);b=MX3(b,C0[r+2],C0[r+3]);a=MX3(a,C1[r],C1[r+1]);b=MX3(b,C1[r+2],C1[r+3]);} \
      float rm=__builtin_fmaxf(a,b); { auto rr=__builtin_amdgcn_permlane32_swap(__float_as_uint(rm),__float_as_uint(rm),false,false); rm=__builtin_fmaxf(__uint_as_float(rr[0]),__uint_as_float(rr[1])); } \
      resc=false; \
      if(__builtin_expect(__any(rm>(float)THRL),0)){ const float dl=__builtin_fmaxf(rm,0.f); mhat+=dl; \
        _Pragma("unroll") for(int r=0;r<16;++r){C0[r]-=dl;C1[r]-=dl;} \
        negmh=-mhat; \
        const float f=__builtin_amdgcn_exp2f(-dl); l_reg*=f; if(hi==0)wsf[r32]=f; resc=true; } } \
    SBAR(); \
    GAPB(o[0]=__builtin_amdgcn_mfma_f32_32x32x16_bf16(PAF(0),VFR(0),o[0],0,0,0), C0,0); \
    GAPB(o[1]=__builtin_amdgcn_mfma_f32_32x32x16_bf16(PAF(0),VFR(4),o[1],0,0,0), C0,4); \
    KRD(GL,0); GAPB(o[0]=__builtin_amdgcn_mfma_f32_32x32x16_bf16(PAF(1),VFR(1),o[0],0,0,0), C0,8); \
    KRD(GL,1); GAPB(o[1]=__builtin_amdgcn_mfma_f32_32x32x16_bf16(PAF(1),VFR(5),o[1],0,0,0), C0,12); \
    KRD(GL,2); GAPB(o[0]=__builtin_amdgcn_mfma_f32_32x32x16_bf16(PAF(2),VFR(2),o[0],0,0,0), C1,0); \
    KRD(GL,3); GAPB(o[1]=__builtin_amdgcn_mfma_f32_32x32x16_bf16(PAF(2),VFR(6),o[1],0,0,0), C1,4); \
    GAPB(o[0]=__builtin_amdgcn_mfma_f32_32x32x16_bf16(PAF(3),VFR(3),o[0],0,0,0), C1,8); \
    GAPB(o[1]=__builtin_amdgcn_mfma_f32_32x32x16_bf16(PAF(3),VFR(7),o[1],0,0,0), C1,12); \
    }while(0)
  int t=1;
  for(;t+5<NT;t+=2){
    STEP(pB0,pB1,pA0,pA1,t,true,true,true);     WAIT_BAR(2); RESC(); ROT();
    STEP(pA0,pA1,pB0,pB1,t+1,true,true,true);   WAIT_BAR(2); RESC(); ROT();
  }
  #define ENDW(tt) do{ if((tt)+3<NT){WAIT_BAR(2);} else if((tt)+2<NT){WAIT_BAR(1);} else {WAIT_BAR(0);} }while(0)
  for(;t+1<NT;t+=2){
    STEP(pB0,pB1,pA0,pA1,t,(t+3<NT),(t+1<NT),(t+1<NT));       ENDW(t);   RESC(); ROT();
    STEP(pA0,pA1,pB0,pB1,t+1,(t+4<NT),(t+2<NT),(t+2<NT));     ENDW(t+1); RESC(); ROT();
  }
  STEP(pB0,pB1,pA0,pA1,NT-1,false,false,false); RESC();
  { float sacc=pB0[0]+pB0[1]; _Pragma("unroll") for(int r=2;r<16;++r)sacc+=pB0[r]; _Pragma("unroll") for(int r=0;r<16;++r)sacc+=pB1[r]; l_reg+=sacc;
    pw0=(u32x4){PKW(pB0,0),PKW(pB0,2),PKW(pB0,4),PKW(pB0,6)};pw1=(u32x4){PKW(pB0,8),PKW(pB0,10),PKW(pB0,12),PKW(pB0,14)};pw2=(u32x4){PKW(pB1,0),PKW(pB1,2),PKW(pB1,4),PKW(pB1,6)};pw3=(u32x4){PKW(pB1,8),PKW(pB1,10),PKW(pB1,12),PKW(pB1,14)};
    SBAR(); pv(o,vb0+sl_cur,PAF(0),PAF(1),PAF(2),PAF(3)); }
  #undef PKW
  #undef PAF
  #undef VFR
  #undef PIN
  #undef MX3
  #undef GAPA
  #undef GAPB
  #undef EX
  #undef VRD
  #undef KRD
  #undef STEP
  #undef ENDW
  {auto rr=__builtin_amdgcn_permlane32_swap(__float_as_uint(l_reg),__float_as_uint(l_reg),false,false);l_reg=__uint_as_float(rr[0])+__uint_as_float(rr[1]);}
  if(hi==0)wsf[32+r32]=l_reg;asm volatile("s_waitcnt lgkmcnt(0)":::"memory");
  float rli[16];
  #pragma unroll
  for(int r=0;r<16;++r)rli[r]=__builtin_amdgcn_rcpf(wsf[32+crow(r,hi)]);
  bf16*Ow=O+(rowbase+q0+wid*QBLK)*DM+h*D;
  { bf16*stg=(bf16*)(shm+LDS_OST)+wid*2048;
    #pragma unroll
    for(int r=0;r<16;++r){const int orow=crow(r,hi);
      #pragma unroll
      for(int d0=0;d0<2;++d0)stg[orow*64+d0*32+r32]=__float2bfloat16(o[d0][r]*rli[r]);}
    asm volatile("s_waitcnt lgkmcnt(0)":::"memory");
    #pragma unroll
    for(int i=0;i<4;++i){const int row=i*8+(lane>>3),ch=lane&7; const u32x4 v=*(const u32x4*)(stg+row*64+ch*8); ATTN_STORE16(Ow+(long)row*DM+ch*8,v);} }
  asm volatile("s_waitcnt lgkmcnt(0)\n\ts_barrier":::"memory");
  #undef DMA_K
  #undef DMA_V
  #undef RESC
  #undef ROT
}
constexpr int ATTN_LDS_BYTES=LDS_BYTES;
struct AttnTensors { const bf16* Q; const bf16* K; const bf16* V; bf16* O; const unsigned long long* MASK; };
struct AttnUnit { int bh; int qb; };
struct StaticOrder {
  int vcu,G;
  __device__ __forceinline__ explicit StaticOrder(int grid,int block):vcu((grid%8==0)?(block%8)*(grid/8)+block/8:block),G(grid){}
  __device__ __forceinline__ bool next(int i,AttnUnit&u)const{ const int idx=vcu+i*G; if(idx>=512)return false; const int j=idx&255,s=j&15; u.bh=j>>4; u.qb=(idx<256)?s:31-s; return true; }
  __device__ __forceinline__ void a_ready(const AttnUnit&)const{}
  __device__ __forceinline__ void done(const AttnUnit&)const{}
};
template<class Sched,int THRL=8> __device__ __forceinline__ void attn_phase(char*lds,const AttnTensors&T,const Sched&S,const int wv){
  AttnUnit u;
  for(int i=0;S.next(i,u);++i){ S.a_ready(u); attn_unit<THRL>(u.bh/NHEAD,u.bh%NHEAD,u.qb,T.Q,T.K,T.V,T.O,T.MASK,lds,wv); S.done(u); }
}
#undef SBAR
#undef WAIT_BAR
}
constexpr int NWAVES = 8;
#ifndef MK_PER_PHASE
#define MK_PER_PHASE 0
#endif
constexpr int NPH = 18;

constexpr int BATCH = 2, T = 8192, D = 1024, M = BATCH * T;
constexpr int INW = 4392, INP = 4608;
constexpr int FF = 2816, FFE = 3584, NE = 8;
constexpr int TOPK = 256;
constexpr int MROWS = 34816;
constexpr float EPS = 1e-6f;

constexpr size_t MiB = 1u << 20;
constexpr size_t WS_CTL = 0, CTL_ZERO_BYTES = 1 * MiB;
constexpr size_t WS_TAB16 = 1 * MiB, WS_TAB8 = 1 * MiB + 512 * 1024;
constexpr size_t WS_GAINS = 1 * MiB + 768 * 1024;
constexpr size_t WS_SSQP = 2 * MiB;
constexpr size_t WS_ROUTE = 3 * MiB, WS_POS = 3 * MiB + 256 * 1024;
constexpr size_t WS_GCNT = 3 * MiB + 512 * 1024;
constexpr size_t WS_META = 4 * MiB;
constexpr size_t WS_WIN = 6 * MiB, WS_PA = 24 * MiB, WS_WEFF = 26 * MiB, WS_WOUT = 28 * MiB, WS_W13 = 32 * MiB, WS_W2 = 43 * MiB;
constexpr size_t WS_XB = 52 * MiB;
constexpr size_t WS_U = 84 * MiB, WS_SG = 100 * MiB;
constexpr size_t WS_HB = 84 * MiB;
constexpr size_t WS_Q = 228 * MiB, WS_K = 244 * MiB, WS_V = 260 * MiB, WS_QI = 276 * MiB  , WS_KI = 285 * MiB, WS_WI = 286 * MiB, WS_DIFF = 287 * MiB;
constexpr size_t WS_MASK = 303 * MiB;
constexpr size_t WS_T1 = 335 * MiB, WS_MB = 367 * MiB;
constexpr size_t WS_X8 = WS_T1;
constexpr size_t WS_AO = 399 * MiB;
constexpr size_t WS_SLAB = 84 * MiB;
constexpr size_t DO_W2E = 0, DO_W13E = 28 * MiB;
constexpr int W13E_SPLIT = 5;
constexpr size_t WS_W13E = 84 * MiB, WS_W2E = 140 * MiB, WS_AP = 174 * MiB, WS_Y = 208 * MiB, WS_HE = 280 * MiB, WS_END = 480 * MiB;
static_assert(WS_XB + (size_t)M * D * 2 <= WS_W13E && WS_SLAB + (size_t)32 * 7 * 65536 * 4 <= WS_W2E && WS_W13E + (size_t)NE * 2 * FFE * D <= WS_W2E && WS_W2E + (size_t)NE * D * FFE <= WS_AP && WS_AP + (size_t)MROWS * D <= WS_Y && WS_Y + (size_t)MROWS * D * 2 <= WS_HE && WS_HE + (size_t)MROWS * FFE <= WS_END, "MoE map");
static_assert(WS_SG + (size_t)M * 2048 * 2 <= WS_Q && WS_MB + (size_t)M * D * 2 <= WS_END && WS_W2 + (size_t)D * FF * 2 <= WS_XB && WS_HB + (size_t)M * FF * 2 <= WS_Q, "layer map");
constexpr int CW_BAR = 4096;
constexpr int CW_CNT = 16384;
constexpr int CW_CUR = 16384 + 64 * 8;
constexpr int CW_WQ = 16384 + 64 * 16;

constexpr int RING_OFF = 0, RING_BYTES = 131072;
constexpr int LDSCTL_OFF = 151808, MISC_OFF = LDSCTL_OFF + 320;
constexpr int SEL_OFF = 152576;
constexpr int LDS_BYTES = 163840;
static_assert(MISC_OFF + 128 <= SEL_OFF && SEL_OFF + 4096 <= LDS_BYTES, "LDS map");

#define GAS __attribute__((address_space(1)))
#define LAS __attribute__((address_space(3)))
typedef unsigned short bf16;
typedef unsigned v4u __attribute__((ext_vector_type(4)));
typedef float f32x4 __attribute__((ext_vector_type(4)));
typedef short bf16x8 __attribute__((ext_vector_type(8)));
typedef GAS unsigned gu32;
typedef GAS unsigned long long gu64;
#define RLX_AGENT __ATOMIC_RELAXED, __HIP_MEMORY_SCOPE_AGENT
#define LDS_WAIT() asm volatile("s_waitcnt lgkmcnt(0)" ::: "memory")
#define VM_WAIT() asm volatile("s_waitcnt vmcnt(0)" ::: "memory")
__device__ __forceinline__ unsigned long long rt() { return __builtin_amdgcn_s_memrealtime(); }
__device__ __forceinline__ unsigned f2bf(float f) { unsigned u = __builtin_bit_cast(unsigned, f); return (u + 0x7fffu + ((u >> 16) & 1u)) >> 16; }
__device__ __forceinline__ unsigned pk2(float lo, float hi) { return pg8::cvt_pk_bf16(lo, hi); }

#define XB_TMO      128
#define XB_XCNT(j)  (256  + 64 * (j))
#define XB_XSUB(j)  (1280 + 64 * (j))
#define XB_XGEN(j)  (2304 + 64 * (j))
#define XB_TOP      3328
#define XB_TOPGEN   3392
#define XCD_BAR_WORDS 3456
#define XB_SPIN_CAP (1u << 18)

__device__ __forceinline__ unsigned xb_ld(unsigned* p)              { return __hip_atomic_load(p, __ATOMIC_RELAXED, __HIP_MEMORY_SCOPE_AGENT); }
__device__ __forceinline__ unsigned xb_add(unsigned* p, unsigned v) { return __hip_atomic_fetch_add(p, v, __ATOMIC_RELAXED, __HIP_MEMORY_SCOPE_AGENT); }
__device__ __forceinline__ unsigned xb_xcc_id() { return (unsigned)__builtin_amdgcn_s_getreg((3 << 11) | 20) & 0xFu; }
#define XB_SPIN(cond, bar) do { unsigned _sp = 0; while (cond) { __builtin_amdgcn_s_sleep(1); \
    if ((++_sp & 255u) == 0u) { if (xb_ld(&(bar)[XB_TMO])) break; if (_sp > XB_SPIN_CAP) { atomicAdd(&(bar)[XB_TMO], 1u); break; } } } } while (0)

struct XcdBarrier {
    unsigned* bar; unsigned x; int wv;
    volatile LAS unsigned* st;
};

__device__ __forceinline__ XcdBarrier xcd_barrier_post(unsigned* bar, volatile LAS unsigned* st, int wv) {
    XcdBarrier b; b.bar = bar; b.x = xb_xcc_id(); b.st = st; b.wv = wv;
    if (wv == 0 && mk_lane() == 0) (void)xb_add(&bar[XB_XCNT(b.x)], 1u);
    return b;
}
__device__ __forceinline__ void xcd_barrier_complete(unsigned* bar, unsigned x, unsigned& nloc, unsigned& nx) {
    const unsigned G = gridDim.x * gridDim.y * gridDim.z;
    unsigned sum, cnt, mine, sp = 0u;
    for (;;) {
        sum = 0u; cnt = 0u; mine = 0u;
#pragma unroll
        for (unsigned j = 0; j < 16; ++j) { const unsigned c = xb_ld(&bar[XB_XCNT(j)]); sum += c; cnt += (c > 0u) ? 1u : 0u; mine = (j == x) ? c : mine; }
        if (sum == G) break;
        __builtin_amdgcn_s_sleep(1);
        if ((++sp & 255u) == 0u) { if (xb_ld(&bar[XB_TMO])) break; if (sp > XB_SPIN_CAP) { atomicAdd(&bar[XB_TMO], 1u); break; } }
    }
    nloc = mine > 0u ? mine : 1u; nx = cnt > 0u ? cnt : 1u;
}

__device__ __forceinline__ void xcd_barrier(const XcdBarrier& b) {
    asm volatile("s_waitcnt vmcnt(0)" ::: "memory");
    __syncthreads();
    if (b.wv == 0 && mk_lane() == 0) {
        unsigned* bar = b.bar;
        __builtin_amdgcn_s_waitcnt(0);
        unsigned nloc = b.st[0], nx = b.st[1];
        if (nloc == 0u) { xcd_barrier_complete(bar, b.x, nloc, nx); b.st[0] = nloc; b.st[1] = nx; }
        const unsigned old = xb_add(&bar[XB_XSUB(b.x)], 1u);
        const unsigned gen = old / nloc;
        if (old + 1u == (gen + 1u) * nloc) {
            __builtin_amdgcn_fence(__ATOMIC_RELEASE, "agent");
            asm volatile("s_waitcnt vmcnt(0)" ::: "memory");
            const unsigned og = xb_add(&bar[XB_TOP], 1u);
            const unsigned tg = og / nx;
            if (og + 1u == (tg + 1u) * nx) xb_add(&bar[XB_TOPGEN], 1u);
            else XB_SPIN(xb_ld(&bar[XB_TOPGEN]) == tg, bar);
            __builtin_amdgcn_fence(__ATOMIC_ACQUIRE, "agent");
            xb_add(&bar[XB_XGEN(b.x)], 1u);
            asm volatile("s_waitcnt vmcnt(0)" ::: "memory");
        } else {
            XB_SPIN(xb_ld(&bar[XB_XGEN(b.x)]) == gen, bar);
            __builtin_amdgcn_fence(__ATOMIC_ACQUIRE, "agent");
            asm volatile("s_waitcnt vmcnt(0)" ::: "memory");
        }
    }
    __syncthreads();
}

namespace pg8 {
struct EpiInProj {
    static constexpr bool PERM = true, AFTER_DRAIN = false;
    unsigned char* ws; const float* gains; float c2;
    __device__ __forceinline__ void operator()(const f32x4 (&acc)[2][2][4][2], const Unit& u, int wr, int wc, int fr, int fq) const {
        const int row0 = u.pm * BM + wr * 64 + fr, pn = u.pn; const float* ssqp = (const float*)(ws + WS_SSQP);
        float rsv[8];
#pragma unroll
        for (int k = 0; k < 8; ++k) rsv[k] = 0.f;
        rstd8(ssqp, row0, fr, fq, rsv, 1.f);
        if (pn < 4) {
            const bool isq = pn < 2; const int head = 4 * (pn & 1) + wc; const float* g = gains + (isq ? 0 : 64); const f32x2* t16 = (const f32x2*)(ws + WS_TAB16);
            const int db0 = fq == 0 ? 0 : 8 * fq + 8, db1 = fq == 0 ? 8 : 8 * fq + 32;
            const f32x4 g00 = *(const f32x4*)(g + db0), g01 = *(const f32x4*)(g + db0 + 4), g10 = *(const f32x4*)(g + db1), g11 = *(const f32x4*)(g + db1 + 4);
            bf16_t* dst = (bf16_t*)(ws + (isq ? WS_Q : WS_K)) + head * 64; const float sc = isq ? c2 : 1.f;
#pragma unroll
            for (int ai = 0; ai < 2; ++ai)
#pragma unroll
                for (int m = 0; m < 4; ++m) { const int row = row0 + ai * HALF + m * 16; const float rs = rsv[ai * 4 + m];
                    f32x4 a0 = acc[ai][0][m][0] * rs, a1 = acc[ai][0][m][1] * rs, b0 = acc[ai][1][m][0] * rs, b1 = acc[ai][1][m][1] * rs;
                    float ss = ((a0[0] * a0[0] + a0[1] * a0[1]) + (a0[2] * a0[2] + a0[3] * a0[3])) + ((a1[0] * a1[0] + a1[1] * a1[1]) + (a1[2] * a1[2] + a1[3] * a1[3]))
                             + ((b0[0] * b0[0] + b0[1] * b0[1]) + (b0[2] * b0[2] + b0[3] * b0[3])) + ((b1[0] * b1[0] + b1[1] * b1[1]) + (b1[2] * b1[2] + b1[3] * b1[3]));
                    ss += __shfl_xor(ss, 16); ss += __shfl_xor(ss, 32);
                    const float rn = __builtin_amdgcn_rsqf(ss * (1.f / 64.f) + 1e-6f);
                    a0 = a0 * rn * g00; a1 = a1 * rn * g01; b0 = b0 * rn * g10; b1 = b1 * rn * g11;
                    if (fq == 0) { const f32x2* cs = t16 + (size_t)(row & 8191) * 8;
#pragma unroll
                        for (int j = 0; j < 4; ++j) { const f32x2 c0 = cs[j], c1 = cs[4 + j]; const float x1 = a0[j], x2 = b0[j], y1 = a1[j], y2 = b1[j];
                            a0[j] = x1 * c0.x - x2 * c0.y; b0[j] = x2 * c0.x + x1 * c0.y; a1[j] = y1 * c1.x - y2 * c1.y; b1[j] = y2 * c1.x + y1 * c1.y; } }
                    *(u32x4*)(dst + (size_t)row * 512 + db0) = pack8(a0 * sc, a1 * sc); *(u32x4*)(dst + (size_t)row * 512 + db1) = pack8(b0 * sc, b1 * sc); }
        } else if (pn == 6 || pn == 7) {
            const int col8 = wc * 32 + 8 * fq; const f32x2* t8 = (const f32x2*)(ws + WS_TAB8); bf16_t* QI = (bf16_t*)(ws + WS_QI); bf16_t* KI = (bf16_t*)(ws + WS_KI); float* WI = (float*)(ws + WS_WI);
#pragma unroll
            for (int ai = 0; ai < 2; ++ai)
#pragma unroll
                for (int m = 0; m < 4; ++m) { const int row = row0 + ai * HALF + m * 16; const float rs = rsv[ai * 4 + m]; const f32x2* cs = t8 + (size_t)(row & 8191) * 4;
#pragma unroll
                    for (int bj = 0; bj < 2; ++bj) { f32x4 a0 = acc[ai][bj][m][0] * rs, a1 = acc[ai][bj][m][1] * rs;
                        if (pn == 6 || (bj == 0 && wc == 0)) {
                            if (fq == 0) {
#pragma unroll
                                for (int j = 0; j < 4; ++j) { const f32x2 c = cs[j]; const float x1 = a0[j], x2 = a1[j]; a0[j] = x1 * c.x - x2 * c.y; a1[j] = x2 * c.x + x1 * c.y; } }
                            if (pn == 6) *(u32x4*)(QI + (size_t)row * 288 + bj * HALF + col8) = pack8(a0, a1); else *(u32x4*)(KI + (size_t)row * 32 + 8 * fq) = pack8(a0, a1); }
                        else if (bj == 0 && wc == 1 && fq == 0) { *(f32x4*)(WI + (size_t)row * 8) = a0 * 0.03125f; *(f32x4*)(WI + (size_t)row * 8 + 4) = a1 * 0.03125f; } } }
        } else {
            const bool sg = pn >= 10; const int ld = sg ? 2048 : 512, colt = (pn < 6 ? pn - 4 : pn < 10 ? pn - 8 : pn - 10) * BM;
            bf16_t* dst = (bf16_t*)(ws + (pn < 6 ? WS_V : pn < 10 ? WS_U : WS_SG));
            const int col0 = colt + wc * 32 + 8 * fq;
#pragma unroll
            for (int ai = 0; ai < 2; ++ai)
#pragma unroll
                for (int m = 0; m < 4; ++m) { const int row = row0 + ai * HALF + m * 16; const float rs = rsv[ai * 4 + m];
#pragma unroll
                    for (int bj = 0; bj < 2; ++bj) { f32x4 a0 = acc[ai][bj][m][0] * rs, a1 = acc[ai][bj][m][1] * rs;
                        if (sg) {
#pragma unroll
                            for (int i = 0; i < 4; ++i) { a0[i] = fsigmoid(a0[i]); a1[i] = fsigmoid(a1[i]); } }
                        *(u32x4*)(dst + (size_t)row * ld + col0 + bj * HALF) = pack8(a0, a1); } }
        }
    }
};
}
struct Frame {
    LAS unsigned char* lds;
    volatile LAS unsigned* MISC;
    gu32* ctl;
    int tid, lane, wave;
    int vcu, G;
    unsigned char* ws;
    float* out;
};
__device__ __forceinline__ float wave_sum(float v) {
#pragma unroll
    for (int o = 1; o < 64; o <<= 1) v += __shfl_xor(v, o);
    return v;
}
__device__ __forceinline__ float bfl(unsigned w) { return __uint_as_float(w << 16); }
__device__ __forceinline__ float bfh(unsigned w) { return __uint_as_float(w & 0xffff0000u); }
__device__ __forceinline__ void unpk8(const v4u w, float (&v)[8]) { v[0] = bfl(w.x); v[1] = bfh(w.x); v[2] = bfl(w.y); v[3] = bfh(w.y); v[4] = bfl(w.z); v[5] = bfh(w.z); v[6] = bfl(w.w); v[7] = bfh(w.w); }
__device__ __forceinline__ v4u pk8(const float (&v)[8]) { v4u o; o.x = pk2(v[0], v[1]); o.y = pk2(v[2], v[3]); o.z = pk2(v[4], v[5]); o.w = pk2(v[6], v[7]); return o; }

struct RowMap { int mode, a;
    __device__ __forceinline__ int operator()(int n) const {
        if (mode == 0) return a + n;
        if (mode == 2) return 256 * (n >> 7) + (n & 127) + a;
        if (n >= 1832) return n + 216;
        if (n >= 1024) return n;
        const int h = (n & 511) >> 6, d = n & 63, wc = h & 3, base = (n & ~511) + 256 * (h >> 2);
        return base + (d < 8 ? 32 * wc + d : d < 16 ? 128 + 32 * wc + d - 8 : d < 40 ? 32 * wc + d - 8 : 128 + 32 * wc + d - 32); } };
constexpr float MOE_SX = 8.f, MOE_SW1 = 64.f, MOE_SH = 8.f, MOE_SW2 = 128.f;
struct TrS { const float* W; bf16* WT; const float* gain; float scale; int K, N, k0, n0, f8; RowMap mp; };
__device__ __forceinline__ void tr32_load(const TrS& t, f32x4 (&v)[8], float (&gv)[8], int lane) {
    const int nq = t.n0 + 4 * (lane & 7), kr = lane >> 3; const bool okn = nq < t.N;
    const float* gp = t.gain ? t.gain + t.k0 : t.W; const float gsc = t.f8 ? t.scale : 1.f;
#pragma unroll
    for (int i = 0; i < 8; ++i) { const float gl = gp[8 * i + kr]; gv[i] = (t.gain ? gl : 1.f) * gsc; }
#pragma unroll
    for (int i = 0; i < 8; ++i) v[i] = okn ? __builtin_nontemporal_load((const GAS f32x4*)(t.W + (size_t)(t.k0 + 8 * i + kr) * t.N + nq)) : (f32x4){0.f, 0.f, 0.f, 0.f};
}
__device__ __forceinline__ void tr32_store(const TrS& t, const f32x4 (&v)[8], const float (&gv)[8], LAS float* scr, int lane) {
    const int kr = lane >> 3;
#pragma unroll
    for (int i = 0; i < 8; ++i) { const int kk = 8 * i + kr; const float g = gv[i]; LAS float* d = scr + kk * 33 + 4 * (lane & 7);
        d[0] = v[i].x * g; d[1] = v[i].y * g; d[2] = v[i].z * g; d[3] = v[i].w * g; }
    LDS_WAIT(); asm volatile("" ::: "memory");
    const int c = lane & 7;
#pragma unroll
    for (int j = 0; j < 4; ++j) { const int n = (lane >> 3) + 8 * j;
        if (t.n0 + n < t.N) { const LAS float* s = scr + (8 * c) * 33 + n;
            if (t.f8) { pg8::u32x2 o; o.x = pg8::pk4_fp8((f32x4){s[0 * 33], s[1 * 33], s[2 * 33], s[3 * 33]}); o.y = pg8::pk4_fp8((f32x4){s[4 * 33], s[5 * 33], s[6 * 33], s[7 * 33]});
                *(GAS pg8::u32x2*)((unsigned char*)t.WT + (size_t)t.mp(t.n0 + n) * t.K + t.k0 + 8 * c) = o; }
            else { v4u o; o.x = pk2(s[0 * 33], s[1 * 33]); o.y = pk2(s[2 * 33], s[3 * 33]); o.z = pk2(s[4 * 33], s[5 * 33]); o.w = pk2(s[6 * 33], s[7 * 33]);
                *(GAS v4u*)(t.WT + (size_t)t.mp(t.n0 + n) * t.K + t.k0 + 8 * c) = o; } } }
    LDS_WAIT(); asm volatile("" ::: "memory");
}
struct TrItem { const float* W; unsigned char* WT; const float* gain; float scale; int K, N, k0, n0; RowMap mp; };
__device__ __forceinline__ void tr64_load(const TrItem& t, f32x4 (&v)[16], float (&gv)[16], int lane) {
    const int nq = t.n0 + 4 * (lane & 15), kr = lane >> 4;
    const float* gp = t.gain ? t.gain + t.k0 : t.W;
#pragma unroll
    for (int i = 0; i < 16; ++i) { const float gl = gp[4 * i + kr]; gv[i] = (t.gain ? gl : 1.f) * t.scale; }
#pragma unroll
    for (int i = 0; i < 16; ++i) v[i] = __builtin_nontemporal_load((const GAS f32x4*)(t.W + (size_t)(t.k0 + 4 * i + kr) * t.N + nq));
}
__device__ __forceinline__ void tr64_store(const TrItem& t, const f32x4 (&v)[16], const float (&gv)[16], LAS float* scr, int lane) {
    const int kr = lane >> 4;
#pragma unroll
    for (int i = 0; i < 16; ++i) { const int kk = 4 * i + kr; const float g = gv[i]; LAS float* d = scr + kk * 65 + 4 * (lane & 15);
        d[0] = v[i].x * g; d[1] = v[i].y * g; d[2] = v[i].z * g; d[3] = v[i].w * g; }
    LDS_WAIT(); asm volatile("" ::: "memory");
    const int c = lane & 7;
#pragma unroll
    for (int j = 0; j < 8; ++j) { const int n = (lane >> 3) + 8 * j; const LAS float* s = scr + (8 * c) * 65 + n;
        pg8::u32x2 o; o.x = pg8::pk4_fp8((f32x4){s[0 * 65], s[1 * 65], s[2 * 65], s[3 * 65]}); o.y = pg8::pk4_fp8((f32x4){s[4 * 65], s[5 * 65], s[6 * 65], s[7 * 65]});
        __builtin_nontemporal_store(o, (GAS pg8::u32x2*)(t.WT + (size_t)t.mp(t.n0 + n) * t.K + t.k0 + 8 * c)); }
    LDS_WAIT(); asm volatile("" ::: "memory");
}
__device__ __forceinline__ float inv16(int i) { return i == 0 ? 1.0f : i == 1 ? 0.1939227432012558f : i == 2 ? 0.03760603070259094f : i == 3 ? 0.007292664609849453f : i == 4 ? 0.0014142135623842478f : i == 5 ? 0.00027424818836152554f : i == 6 ? 5.3182957344688475e-05f : 1.0313385246263351e-05f; }
__device__ __forceinline__ float2 cs_of(float ang) {
    const double a = (double)ang, k = __builtin_rint(a * 0.15915494309189535), r = a - k * 6.283185307179586;
    const float rr = (float)(r * 0.15915494309189535);
    return make_float2(__builtin_amdgcn_cosf(rr), __builtin_amdgcn_sinf(rr));
}

__device__ __forceinline__ void p0_prologue(Frame& F, const float* const* in) {
    LAS float* scr = (LAS float*)(F.lds + RING_OFF + F.wave * 16384);
    int lane_ = F.lane; asm volatile("" : "+v"(lane_)); const int gw = F.vcu * NWAVES + F.wave, NGW = F.G * NWAVES, lane = lane_;
    const float* x = in[0];
    constexpr int I_WIN = 16 * 138, I_PA = 8 * 32, I_WO = 16 * 32, I_W1 = 16 * 88, I_W2 = 44 * 32;
    constexpr int I_L = I_WIN + I_PA + I_WO, NIT = 2 * I_L + 2 * I_W1 + I_W2;
    auto item = [&](int it) -> TrS { TrS t; int r = it; t.scale = 1.f; t.f8 = 0; t.gain = nullptr; t.mp = RowMap{0, 0};
        if (r < 2 * I_L) { const int L = r / I_L; r -= L * I_L;
            if (r < I_WIN) { t.W = in[2] + (size_t)L * D * INW; t.K = D; t.N = INW; t.WT = (bf16*)(F.ws + WS_WIN) + (size_t)L * INP * D; t.gain = in[1] + L * D; t.mp = RowMap{1, 0}; }
            else if (r < I_WIN + I_PA) { r -= I_WIN; t.W = in[7] + (size_t)L * 512 * D; t.K = 512; t.N = D; t.WT = (bf16*)(F.ws + WS_PA) + (size_t)L * D * 512; }
            else { r -= I_WIN + I_PA; t.W = in[9] + (size_t)L * D * D; t.K = D; t.N = D; t.WT = (bf16*)(F.ws + WS_WOUT) + (size_t)L * D * D; } }
        else { r -= 2 * I_L; t.f8 = 1;
            if (r < 2 * I_W1) { const bool third = r >= I_W1; if (third) r -= I_W1; t.W = third ? in[12] : in[11]; t.K = D; t.N = FF; t.WT = (bf16*)(F.ws + WS_W13); t.gain = in[10]; t.mp = RowMap{2, third ? 128 : 0}; t.scale = MOE_SW1; }
            else { r -= 2 * I_W1; t.W = in[13]; t.K = FF; t.N = D; t.WT = (bf16*)(F.ws + WS_W2); t.scale = MOE_SW2; } }
        const int nblk = (t.N + 31) / 32; t.k0 = 64 * (r / nblk); t.n0 = 32 * (r % nblk); return t; };
    if (gw < NIT) { int it = gw; TrS a = item(it), b = a; f32x4 v[8], vn[8]; float gv[8], gn[8]; tr32_load(a, v, gv, lane);
        for (;;) {
            { const int nx = it + NGW; const bool more = nx < NIT; if (more) { b = item(nx); tr32_load(b, vn, gn, lane); } tr32_store(a, v, gv, scr, lane); if (!more) break; it = nx; }
            { const int nx = it + NGW; const bool more = nx < NIT; if (more) { a = item(nx); tr32_load(a, v, gv, lane); } tr32_store(b, vn, gn, scr, lane); if (!more) break; it = nx; } } }
    for (int it = gw; it < 2 * 216; it += NGW) { const int L = it / 216, rr = 1832 + it % 216; GAS v4u* o = (GAS v4u*)((bf16*)(F.ws + WS_WIN) + ((size_t)L * INP + rr) * D) + lane; o[0] = (v4u){0u, 0u, 0u, 0u}; o[64] = (v4u){0u, 0u, 0u, 0u}; }
    for (int it = gw; it < 2 * 4 * 16 * 8; it += NGW) {
        const int cc = it & 7, nb = (it >> 3) & 15, g = (it >> 7) & 3, L = it >> 9; const int n = nb * 64 + lane, c0 = cc * 16;
        const float* wp = in[5] + ((size_t)(L * 4 + g) * 128 + c0) * 128; const float* ps = in[6] + L * 512 + g * 128; const float* pb = in[8] + ((size_t)L * 512 + g * 128) * D + n;
        float acc[16];
#pragma unroll
        for (int c = 0; c < 16; ++c) acc[c] = 0.f;
        { const GAS f32x4* wsrc = (const GAS f32x4*)wp + lane; const GAS f32x4* psv = (const GAS f32x4*)ps;
#pragma unroll
          for (int i = 0; i < 8; ++i) { const int idx = i * 64 + lane; *(LAS f32x4*)(scr + 4 * idx) = wsrc[64 * i] * psv[idx & 31]; } }
        LDS_WAIT(); asm volatile("" ::: "memory");
        for (int d0 = 0; d0 < 128; d0 += 32) {
            float v[32];
#pragma unroll
            for (int dd = 0; dd < 32; ++dd) v[dd] = pb[(size_t)(d0 + dd) * D];
#pragma unroll
            for (int c = 0; c < 16; ++c) {
#pragma unroll
                for (int q4 = 0; q4 < 8; ++q4) { const f32x4 a4 = *(const LAS f32x4*)(scr + c * 128 + d0 + 4 * q4);
                    acc[c] += (a4.x * v[4 * q4] + a4.y * v[4 * q4 + 1]) + (a4.z * v[4 * q4 + 2] + a4.w * v[4 * q4 + 3]); } } }
        LDS_WAIT(); asm volatile("" ::: "memory");
        GAS v4u* o = (GAS v4u*)((bf16*)(F.ws + WS_WEFF) + ((size_t)L * D + n) * 512 + g * 128 + c0);
        v4u o0, o1; o0.x = pk2(acc[0], acc[1]); o0.y = pk2(acc[2], acc[3]); o0.z = pk2(acc[4], acc[5]); o0.w = pk2(acc[6], acc[7]); o1.x = pk2(acc[8], acc[9]); o1.y = pk2(acc[10], acc[11]); o1.z = pk2(acc[12], acc[13]); o1.w = pk2(acc[14], acc[15]);
        o[0] = o0; o[1] = o1;
    }
    if (gw == 0) { for (int i = lane; i < 256; i += 64) { const int L = i >> 7, j = i & 127; ((float*)(F.ws + WS_GAINS))[i] = j < 64 ? in[3][L * 64 + j] : in[4][L * 64 + j - 64]; } }
    { float2* t16 = (float2*)(F.ws + WS_TAB16); float2* t8 = (float2*)(F.ws + WS_TAB8);
      for (int i = gw * 64 + lane; i < T * 12; i += NGW * 64) { const int t = i / 12, j = i % 12;
          if (j < 8) t16[t * 8 + j] = cs_of((float)t * inv16(j)); else t8[t * 4 + (j - 8)] = cs_of((float)t * inv16(2 * (j - 8))); } }
    for (int m = gw; m < M; m += 4 * NGW) {
        f32x4 va[4][4]; int mr[4];
#pragma unroll
        for (int k = 0; k < 4; ++k) { mr[k] = m + k * NGW < M ? m + k * NGW : m; const GAS f32x4* xa = (const GAS f32x4*)(x + (size_t)mr[k] * D) + lane;
#pragma unroll
            for (int j = 0; j < 4; ++j) va[k][j] = xa[64 * j]; }
#pragma unroll
        for (int k = 0; k < 4; ++k) { float sa = 0.f;
#pragma unroll
            for (int j = 0; j < 4; ++j) sa += (va[k][j].x * va[k][j].x + va[k][j].y * va[k][j].y) + (va[k][j].z * va[k][j].z + va[k][j].w * va[k][j].w);
            sa = wave_sum(sa);
            GAS unsigned long long* oa = (GAS unsigned long long*)((bf16*)(F.ws + WS_XB) + (size_t)mr[k] * D) + lane;
#pragma unroll
            for (int j = 0; j < 4; ++j) oa[64 * j] = (unsigned long long)pk2(va[k][j].x, va[k][j].y) | ((unsigned long long)pk2(va[k][j].z, va[k][j].w) << 32);
            if (lane < 16) ((float*)(F.ws + WS_SSQP))[(size_t)mr[k] * 16 + lane] = lane == 0 ? sa : 0.f; }
    }
}

__device__ __forceinline__ void diff_rows(Frame& F) {
    int lane_ = F.lane; asm volatile("" : "+v"(lane_)); const int gw = F.vcu * NWAVES + F.wave, NGW = F.G * NWAVES, l = lane_;
    const bf16* U = (const bf16*)(F.ws + WS_U) + 8 * l; const int w = 2 << (l >> 4);
    for (int blk = gw; blk < M / 8; blk += NGW) {
        const int r0 = blk * 8, t0 = r0 & (T - 1);
        v4u pi[16], pc[8], po[8];
#pragma unroll
        for (int j = 1; j <= 16; ++j) { const bool ok = j <= w && t0 >= j; pi[j - 1] = *(const GAS v4u*)(U + (size_t)(ok ? r0 - j : r0) * 512); if (!ok) pi[j - 1] = (v4u){0u, 0u, 0u, 0u}; }
#pragma unroll
        for (int i = 0; i < 8; ++i) { pc[i] = *(const GAS v4u*)(U + (size_t)(r0 + i) * 512); const bool ok = t0 + i >= w; po[i] = *(const GAS v4u*)(U + (size_t)(ok ? r0 + i - w : r0) * 512); if (!ok) po[i] = (v4u){0u, 0u, 0u, 0u}; }
        float S[8];
#pragma unroll
        for (int c = 0; c < 8; ++c) S[c] = 0.f;
#pragma unroll
        for (int j = 0; j < 16; ++j) { float a[8]; unpk8(pi[j], a);
#pragma unroll
            for (int c = 0; c < 8; ++c) S[c] += a[c]; }
#pragma unroll
        for (int i = 0; i < 8; ++i) { float cu[8], ol[8], o[8]; unpk8(pc[i], cu); unpk8(po[i], ol); const int t = t0 + i; const float inv = 1.f / (float)((t + 1) < w ? (t + 1) : w);
#pragma unroll
            for (int c = 0; c < 8; ++c) { S[c] += cu[c] - ol[c]; o[c] = S[c] * inv - cu[c]; }
            *(GAS v4u*)((bf16*)(F.ws + WS_DIFF) + (size_t)(r0 + i) * 512 + 8 * l) = pk8(o); }
    }
}

namespace topk {
typedef float f32x16 __attribute__((ext_vector_type(16)));
constexpr int HROW = 1025;
constexpr int ST_OFF = 32 * HROW * 4;
constexpr int BQ_OFF = ST_OFF + 512, BQ_PITCH = 624;
static_assert(BQ_OFF + 32 * BQ_PITCH <= LDSCTL_OFF && BQ_OFF % 16 == 0, "top-k LDS map");
constexpr int CAND = 1024;
__device__ __forceinline__ unsigned okey(float s) { const unsigned u = __float_as_uint(s); return u ^ ((unsigned)((int)u >> 31) | 0x80000000u); }
__device__ __forceinline__ int crow(int r, int hi) { return (r & 3) + 8 * (r >> 2) + 4 * hi; }
template <int NB, bool PACKED> __device__ __forceinline__ void scan_row(const LAS unsigned* hrow, unsigned k, int lane, LAS unsigned* pref, LAS unsigned* krem, LAS unsigned* nbin, int shift, unsigned add) {
    constexpr int WPL = PACKED ? NB / 128 : NB / 64;
    unsigned wv[WPL], c = 0;
#pragma unroll
    for (int i = 0; i < WPL; ++i) { wv[i] = hrow[lane * WPL + i]; c += PACKED ? (wv[i] & 0xffffu) + (wv[i] >> 16) : wv[i]; }
    unsigned incl = c;
#pragma unroll
    for (int o = 1; o < 64; o <<= 1) { const unsigned tt = __shfl_down(incl, o); if (lane + o < 64) incl += tt; }
    const unsigned above = incl - c;
    if (above < k && k <= incl) {
        unsigned cum = above, bin = 0, kr = 1, nb = 1; bool found = false;
#pragma unroll
        for (int i = WPL - 1; i >= 0; --i) {
            if (PACKED) {
                unsigned h = wv[i] >> 16; if (!found && cum + h >= k) { found = true; bin = (unsigned)(lane * WPL + i) * 2u + 1u; kr = k - cum; nb = h; } cum += h;
                h = wv[i] & 0xffffu;       if (!found && cum + h >= k) { found = true; bin = (unsigned)(lane * WPL + i) * 2u;      kr = k - cum; nb = h; } cum += h;
            } else { const unsigned h = wv[i]; if (!found && cum + h >= k) { found = true; bin = (unsigned)(lane * WPL + i); kr = k - cum; nb = h; } cum += h; } }
        *pref = ((*pref << shift) | bin) + add; *krem = kr; *nbin = nb;
    }
}
#define TOPK_VALID(r) (!DIAG || (((r) & 3) + 8 * ((r) >> 2)) <= lim2_)
#define TOPK_LIM() const int lim2_ = qabs - tile * 64 - 32 * p - 4 * hi
template <bool DIAG, bool ALL> __device__ __forceinline__ void hist_gen(const float (&sv)[16], int p, int tile, int qabs, int hi, LAS unsigned* hrow, unsigned pref, int sh, int bsh, unsigned bmask) { TOPK_LIM();
#pragma unroll
    for (int r = 0; r < 16; ++r) { const unsigned key = okey(sv[r]);
        if (TOPK_VALID(r) && (ALL || (key >> sh) == pref)) {
            if (ALL) { unsigned ad, inc;
                asm("v_bfe_u32 %0, %2, 22, 10\n\tv_bfe_u32 %1, %2, 21, 1\n\tv_lshl_add_u32 %0, %0, 2, %3\n\tv_mad_u32_u24 %1, %1, %4, 1" : "=&v"(ad), "=&v"(inc) : "v"(key), "v"((unsigned)(uintptr_t)hrow), "s"(0xffffu));
                __hip_atomic_fetch_add((LAS unsigned*)(uintptr_t)ad, inc, __ATOMIC_RELAXED, __HIP_MEMORY_SCOPE_WORKGROUP); }
            else { const unsigned bin = (key >> bsh) & bmask; __hip_atomic_fetch_add(hrow + (bin >> 1), 1u << (16 * (bin & 1u)), __ATOMIC_RELAXED, __HIP_MEMORY_SCOPE_WORKGROUP); } } }
}
template <bool DIAG> __device__ __forceinline__ void cand_half(const float (&sv)[16], int p, int tile, int qabs, int hi, LAS unsigned* lrow, LAS unsigned* lc, unsigned pref, int sh) { TOPK_LIM();
    unsigned m = 0u;
#pragma unroll
    for (int r = 0; r < 16; ++r) { if (TOPK_VALID(r) && (okey(sv[r]) >> sh) == pref) m |= 1u << r; }
    if (m) { unsigned at = __hip_atomic_fetch_add(lc, (unsigned)__popc(m), __ATOMIC_RELAXED, __HIP_MEMORY_SCOPE_WORKGROUP);
#pragma unroll
        for (int r = 0; r < 16; ++r) if (m & (1u << r)) { if (at < (unsigned)CAND) lrow[at] = okey(sv[r]); ++at; } }
}
#define TOPK_CMP8(OP) asm volatile(OP " %0, %8, %16\n\t" OP " %1, %9, %16\n\t" OP " %2, %10, %16\n\t" OP " %3, %11, %16\n\t" OP " %4, %12, %16\n\t" OP " %5, %13, %16\n\t" OP " %6, %14, %16\n\t" OP " %7, %15, %16" \
        : "=s"(c[0]), "=s"(c[1]), "=s"(c[2]), "=s"(c[3]), "=s"(c[4]), "=s"(c[5]), "=s"(c[6]), "=s"(c[7]) : "v"(x[0]), "v"(x[1]), "v"(x[2]), "v"(x[3]), "v"(x[4]), "v"(x[5]), "v"(x[6]), "v"(x[7]), "v"(thr))
template <bool DIAG, int FAST> __device__ __forceinline__ void mask_half(const float (&sv)[16], int p, int tile, int qabs, int hi, unsigned thr, unsigned& mlo, unsigned& mhi) { TOPK_LIM();
#pragma unroll
    for (int r0 = 0; r0 < 16; r0 += 8) {
        unsigned x[8]; unsigned long long c[8];
#pragma unroll
        for (int i = 0; i < 8; ++i) { const int r = r0 + i; x[i] = FAST == 1 ? __float_as_uint(sv[r]) : okey(sv[r]);
            if (DIAG) { if (!TOPK_VALID(r)) x[i] = FAST == 1 ? 0x80000000u : 0u; } }
        if (FAST == 1) TOPK_CMP8("v_cmp_ge_i32_e64"); else if (FAST == 2) TOPK_CMP8("v_cmp_gt_u32_e64"); else TOPK_CMP8("v_cmp_ge_u32_e64");
#pragma unroll
        for (int i = 0; i < 8; ++i) { const unsigned lo = (unsigned)c[i], hi2 = (unsigned)(c[i] >> 32);
            if (p == 0) { asm volatile("v_writelane_b32 %0, %1, %2" : "+v"(mlo) : "s"(lo), "i"(r0 + i)); asm volatile("v_writelane_b32 %0, %1, %2" : "+v"(mhi) : "s"(hi2), "i"(r0 + i)); }
            else { asm volatile("v_writelane_b32 %0, %1, %2" : "+v"(mlo) : "s"(lo), "i"(16 + r0 + i)); asm volatile("v_writelane_b32 %0, %1, %2" : "+v"(mhi) : "s"(hi2), "i"(16 + r0 + i)); } }
    }
}
#undef TOPK_CMP8
__device__ __forceinline__ void mask_store(int p, int lane, unsigned long long* mt, unsigned& mlo, unsigned& mhi) { if (p == 1) { if (lane < 32) mt[lane] = ((unsigned long long)mhi << 32) | mlo; mlo = 0u; mhi = 0u; } }
__device__ __forceinline__ unsigned select_row(const LAS unsigned* list, unsigned n, unsigned krem, unsigned pref, int sh, int lane, LAS unsigned* bins) {
    while (sh > 0) {
        const int db = sh < 7 ? sh : 7, nsh = sh - db; const unsigned dm = (1u << db) - 1u;
        bins[2 * lane] = 0u; bins[2 * lane + 1] = 0u;
        asm volatile("s_waitcnt lgkmcnt(0)" ::: "memory");
#pragma unroll
        for (int j = 0; j < 16; ++j) if ((unsigned)(lane + 64 * j) < n) { const unsigned kj = list[lane + 64 * j]; if ((kj >> sh) == pref) __hip_atomic_fetch_add(bins + ((kj >> nsh) & dm), 1u, __ATOMIC_RELAXED, __HIP_MEMORY_SCOPE_WORKGROUP); }
        asm volatile("s_waitcnt lgkmcnt(0)" ::: "memory");
        const unsigned b0 = bins[2 * lane], b1 = bins[2 * lane + 1], c = b0 + b1;
        unsigned incl = c;
#pragma unroll
        for (int o = 1; o < 64; o <<= 1) { const unsigned tt = __shfl_down(incl, o); if (lane + o < 64) incl += tt; }
        const unsigned above = incl - c; const bool mine = above < krem && krem <= incl;
        const unsigned dig = (above + b1 >= krem) ? (unsigned)(2 * lane + 1) : (unsigned)(2 * lane), kr = (above + b1 >= krem) ? krem - above : krem - above - b1;
        const unsigned long long mb = __ballot(mine); const int src = mb ? (int)__builtin_ctzll(mb) : 0;
        pref = (pref << db) | (unsigned)__builtin_amdgcn_readlane((int)dig, src); krem = (unsigned)__builtin_amdgcn_readlane((int)kr, src); sh = nsh;
    }
    return pref;
}
template <bool DIAG> __device__ __forceinline__ void cand_pos_half(const float (&sv)[16], int p, int tile, int qabs, int hi, LAS unsigned* lrow, LAS unsigned* lc, unsigned last) { TOPK_LIM();
    unsigned m = 0u;
#pragma unroll
    for (int r = 0; r < 16; ++r) { if (TOPK_VALID(r) && (last - okey(sv[r])) < 0x200000u) m |= 1u << r; }
    unsigned at = 0u; if (m) at = __hip_atomic_fetch_add(lc, (unsigned)__popc(m), __ATOMIC_RELAXED, __HIP_MEMORY_SCOPE_WORKGROUP);
    const unsigned pb = 8191u - (unsigned)(tile * 64 + 32 * p + 4 * hi);
    while (__any(m != 0u)) {
        const unsigned r = (unsigned)__builtin_ctz(m | 0x10000u);
#define TOPK_SEL(o, b, x, y) float o; { float e0_ = (x), e1_ = (y); asm volatile("" : "+v"(e0_), "+v"(e1_)); o = (r & (b)) ? e1_ : e0_; }
        TOPK_SEL(a0, 1u, sv[0], sv[1]) TOPK_SEL(a1, 1u, sv[2], sv[3]) TOPK_SEL(a2, 1u, sv[4], sv[5]) TOPK_SEL(a3, 1u, sv[6], sv[7]) TOPK_SEL(a4, 1u, sv[8], sv[9]) TOPK_SEL(a5, 1u, sv[10], sv[11]) TOPK_SEL(a6, 1u, sv[12], sv[13]) TOPK_SEL(a7, 1u, sv[14], sv[15])
        TOPK_SEL(b0, 2u, a0, a1) TOPK_SEL(b1, 2u, a2, a3) TOPK_SEL(b2, 2u, a4, a5) TOPK_SEL(b3, 2u, a6, a7)
        TOPK_SEL(c0, 4u, b0, b1) TOPK_SEL(c1, 4u, b2, b3)
        TOPK_SEL(d0, 8u, c0, c1)
#undef TOPK_SEL
        const unsigned key = okey(d0);
        if (m != 0u) { if (at < (unsigned)CAND) lrow[at] = (((key & 0x1fffffu) >> 2) << 13) | (pb - ((r & 3u) + 8u * ((r >> 2) & 3u))); ++at; }
        m &= m - 1u;
    }
}
__device__ __forceinline__ unsigned select_packed(const LAS unsigned* list, unsigned n, unsigned krem, int lane, LAS unsigned* bins) {
    unsigned pref = 0u; int sh = 32;
    while (sh > 0) {
        const int db = sh == 32 ? 5 : (sh < 7 ? sh : 7), nsh = sh - db; const unsigned dm = (1u << db) - 1u;
        bins[2 * lane] = 0u; bins[2 * lane + 1] = 0u;
        asm volatile("s_waitcnt lgkmcnt(0)" ::: "memory");
#pragma unroll
        for (int j = 0; j < 16; ++j) if ((unsigned)(lane + 64 * j) < n) { const unsigned kj = list[lane + 64 * j]; if (sh == 32 || (kj >> sh) == pref) __hip_atomic_fetch_add(bins + ((kj >> nsh) & dm), 1u, __ATOMIC_RELAXED, __HIP_MEMORY_SCOPE_WORKGROUP); }
        asm volatile("s_waitcnt lgkmcnt(0)" ::: "memory");
        const unsigned b0 = bins[2 * lane], b1 = bins[2 * lane + 1], c = b0 + b1;
        unsigned incl = c;
#pragma unroll
        for (int o = 1; o < 64; o <<= 1) { const unsigned tt = __shfl_down(incl, o); if (lane + o < 64) incl += tt; }
        const unsigned above = incl - c; const bool mine = above < krem && krem <= incl; const bool odd = above + b1 >= krem;
        const unsigned dig = odd ? (unsigned)(2 * lane + 1) : (unsigned)(2 * lane), kr = odd ? krem - above : krem - above - b1, nb = odd ? b1 : b0;
        const unsigned long long mb = __ballot(mine); const int src = mb ? (int)__builtin_ctzll(mb) : 0;
        pref = (pref << db) | (unsigned)__builtin_amdgcn_readlane((int)dig, src); krem = (unsigned)__builtin_amdgcn_readlane((int)kr, src); sh = nsh;
        if ((unsigned)__builtin_amdgcn_readlane((int)nb, src) == krem) break;
    }
    return sh > 0 ? pref << sh : pref;
}
}
#undef TOPK_VALID
#undef TOPK_LIM
__device__ __forceinline__ void topk_phase(Frame& F, int L) {
    using namespace topk;
    int tid_ = F.tid; asm volatile("" : "+v"(tid_)); const int tid = tid_, lane = tid & 63, r32 = lane & 31, hi = lane >> 5, wid = F.wave;
    LAS unsigned* hist = (LAS unsigned*)(F.lds + RING_OFF);
    LAS unsigned* pref = (LAS unsigned*)(F.lds + RING_OFF + ST_OFF); LAS unsigned* krem = pref + 32; LAS unsigned* nbin = pref + 64; LAS unsigned* lcnt = pref + 96;
    const bf16* QI = (const bf16*)(F.ws + WS_QI); const bf16* KI = (const bf16*)(F.ws + WS_KI); const float* WI = (const float*)(F.ws + WS_WI);
    unsigned long long* MASK = (unsigned long long*)(F.ws + WS_MASK + (size_t)L * 16 * MiB);
    for (int ui = F.vcu; ui < 512; ui += F.G) {
        const int jj = ui & 255, b = jj >> 7, j32 = ui < 256 ? (jj & 127) : 255 - (jj & 127);
        const int q0 = j32 * 32, ntile = (j32 >> 1) + 1, qabs = q0 + r32; const size_t brow = (size_t)b * T;
        for (int i = tid; i < 32 * 34; i += NWAVES * 64) { const int rw = i / 34, ch = i % 34;
            *(LAS v4u*)(F.lds + RING_OFF + BQ_OFF + rw * BQ_PITCH + (ch < 32 ? ch * 16 : 576 + (ch - 32) * 16)) = ch < 32 ? *(const v4u*)(QI + (brow + q0 + rw) * 288 + ch * 8) : *(const v4u*)(WI + (brow + q0 + rw) * 8 + (ch - 32) * 4); }
        __syncthreads();
        for (int i = tid; i < 32 * 16; i += NWAVES * 64) { const int rw = i >> 4, dp = i & 15; const LAS unsigned char* rb = F.lds + RING_OFF + BQ_OFF + rw * BQ_PITCH;
            float s0 = 0.f, s1 = 0.f;
#pragma unroll
            for (int h = 0; h < 8; ++h) { const unsigned qq = *(const LAS unsigned*)(rb + 64 * h + 4 * dp); const float wv_ = *(const LAS float*)(rb + 576 + 4 * h); s0 += bfl(qq) * wv_; s1 += bfh(qq) * wv_; }
            *(LAS unsigned*)(rb + 512 + 4 * dp) = pk2(s0, s1); }
        const LAS unsigned char* bqp = F.lds + RING_OFF + BQ_OFF + r32 * BQ_PITCH + hi * 16;
#define TOPK_BQ(h, ks) (*(const LAS pg8::bf16x8*)(bqp + 64 * (h) + 32 * (ks)))
        if (tid < 32) { pref[tid] = 0u; krem[tid] = (unsigned)((q0 + tid + 1) < TOPK ? (q0 + tid + 1) : TOPK); nbin[tid] = 0xffffffffu; lcnt[tid] = 0u; }
        LAS unsigned* hrow = hist + r32 * HROW; LAS unsigned* lrow = hist + r32 * CAND;
#define TOPK_MF(A, B, C) __builtin_amdgcn_mfma_f32_32x32x16_bf16(A, B, C, 0, 0, 0)
#define TOPK_KP(tl) (KI + (brow + (size_t)(tl) * 64 + r32) * 32 + hi * 8)
        const unsigned bqa = (unsigned)(uintptr_t)bqp, wqa = bqa - (unsigned)hi * 16u + 576u;
#define TOPK_LDB(B0, B1, h) do { asm volatile("ds_read_b128 %0, %2 offset:%3\n\tds_read_b128 %1, %2 offset:%4" : "=&v"(B0), "=&v"(B1) : "v"(bqa), "i"(64 * (h)), "i"(64 * (h) + 32)); } while (0)
#define TOPK_LDW(W, h) do { asm volatile("ds_read_b32 %0, %1 offset:%2" : "=&v"(W) : "v"(wqa), "i"(4 * (h))); } while (0)
#define TOPK_LWAIT(B0, B1) asm volatile("s_waitcnt lgkmcnt(0)" : "+v"(B0), "+v"(B1))
#define TOPK_SCORES() \
        float sA[16], sB[16]; { pg8::bf16x8 bl0, bl1, bb0[2], bb1[2]; float wv[2]; TOPK_LDB(bl0, bl1, 8); TOPK_LDB(bb0[0], bb1[0], 0); TOPK_LDB(bb0[1], bb1[1], 1); TOPK_LDW(wv[0], 0); TOPK_LDW(wv[1], 1); \
            TOPK_LWAIT(bl0, bl1); TOPK_LWAIT(bb0[0], bb1[0]); \
            f32x16 l0 = TOPK_MF(a00, bl0, f32x16{}), l1 = TOPK_MF(a10, bl0, f32x16{}); l0 = TOPK_MF(a01, bl1, l0); l1 = TOPK_MF(a11, bl1, l1); \
            f32x16 dA = TOPK_MF(a00, bb0[0], f32x16{}), dB = TOPK_MF(a10, bb0[0], f32x16{}); dA = TOPK_MF(a01, bb1[0], dA); dB = TOPK_MF(a11, bb1[0], dB); \
            asm volatile("s_nop 15" : "+v"(l0), "+v"(l1), "+v"(dA), "+v"(dB));     \
            _Pragma("unroll") for (int r = 0; r < 16; ++r) { sA[r] = l0[r]; sB[r] = l1[r]; } \
            _Pragma("unroll") for (int h = 0; h < 8; ++h) { f32x16 dn = f32x16{}; \
                if (h < 7) { TOPK_LWAIT(bb0[(h + 1) & 1], bb1[(h + 1) & 1]); dn = TOPK_MF(a00, bb0[(h + 1) & 1], f32x16{}); asm volatile("" : "+v"(dn)); }     \
                _Pragma("unroll") for (int r = 0; r < 8; ++r) asm volatile("v_fma_f32 %0, |%1|, %2, %0" : "+v"(sA[r]) : "v"(dA[r]), "v"(wv[h & 1])); \
                if (h < 7) { dn = TOPK_MF(a01, bb1[(h + 1) & 1], dn); asm volatile("" : "+v"(dn)); } \
                _Pragma("unroll") for (int r = 8; r < 16; ++r) asm volatile("v_fma_f32 %0, |%1|, %2, %0" : "+v"(sA[r]) : "v"(dA[r]), "v"(wv[h & 1])); \
                asm volatile("" : "+v"(a00), "+v"(a01));     \
                dA = dn; \
                if (h < 7) { dn = TOPK_MF(a10, bb0[(h + 1) & 1], f32x16{}); asm volatile("" : "+v"(dn)); } \
                _Pragma("unroll") for (int r = 0; r < 8; ++r) asm volatile("v_fma_f32 %0, |%1|, %2, %0" : "+v"(sB[r]) : "v"(dB[r]), "v"(wv[h & 1])); \
                if (h < 7) { dn = TOPK_MF(a11, bb1[(h + 1) & 1], dn); asm volatile("" : "+v"(dn)); \
                    if (h < 6) TOPK_LDB(bb0[h & 1], bb1[h & 1], (h + 2) & 7); }     \
                _Pragma("unroll") for (int r = 8; r < 16; ++r) asm volatile("v_fma_f32 %0, |%1|, %2, %0" : "+v"(sB[r]) : "v"(dB[r]), "v"(wv[h & 1])); \
                asm volatile("" : "+v"(a10), "+v"(a11)); \
                dB = dn; if (h < 6) TOPK_LDW(wv[h & 1], (h + 2) & 7); } }
#define TOPK_LOOP(BODY_N, BODY_D) do { int tile = wid; if (tile < ntile) { const bf16* kp_ = TOPK_KP(tile); \
            pg8::bf16x8 a00 = *(const pg8::bf16x8*)kp_, a01 = *(const pg8::bf16x8*)(kp_ + 16), a10 = *(const pg8::bf16x8*)(kp_ + 1024), a11 = *(const pg8::bf16x8*)(kp_ + 1024 + 16); \
            for (;;) { const bool more = tile + NWAVES < ntile; \
                pg8::bf16x8 n00 = a00, n01 = a01, n10 = a10, n11 = a11; \
                if (more) { const bf16* kn_ = TOPK_KP(tile + NWAVES); n00 = *(const pg8::bf16x8*)kn_; n01 = *(const pg8::bf16x8*)(kn_ + 16); n10 = *(const pg8::bf16x8*)(kn_ + 1024); n11 = *(const pg8::bf16x8*)(kn_ + 1024 + 16); }     \
                TOPK_SCORES(); \
                a00 = n00; a01 = n01; a10 = n10; a11 = n11; \
                if (tile == ntile - 1) { { const float (&sv)[16] = sA; const int p = 0; BODY_D; } { const float (&sv)[16] = sB; const int p = 1; BODY_D; } } \
                else { { const float (&sv)[16] = sA; const int p = 0; BODY_N; } { const float (&sv)[16] = sB; const int p = 1; BODY_N; } } \
                if (!more) break; tile += NWAVES; } } } while (0)
#define TOPK_ZERO() do { for (int i = tid; i < 32 * HROW; i += NWAVES * 64) hist[i] = 0u; } while (0)
#define TOPK_SCAN(NB, PACKED, SHIFT, ADD) do { for (int rr = 0; rr < 4; ++rr) { const int row = wid * 4 + rr; scan_row<NB, PACKED>(hist + row * HROW, krem[row], lane, pref + row, krem + row, nbin + row, SHIFT, ADD); } } while (0)
        int sh = 21;
        bool fused = false;
        unsigned long long* mq = MASK + ((size_t)(b * 256 + j32) * 128) * 32; const int nt_att = 4 * (j32 >> 3) + 4;
#define TOPK_MSTORE() mask_store(p, lane, mq + (size_t)tile * 32, mlo, mhi)
        {
        TOPK_ZERO(); __syncthreads();
        TOPK_LOOP((hist_gen<false, true>(sv, p, tile, qabs, hi, hrow, 0u, 0, 21, 2047u)), (hist_gen<true, true>(sv, p, tile, qabs, hi, hrow, 0u, 0, 21, 2047u)));
        __syncthreads();
        TOPK_SCAN(2048, true, 11, 0u);
        __syncthreads();
        bool big = __any(nbin[r32] > (unsigned)CAND);
        fused = !big;
        if (big) {
            TOPK_ZERO(); __syncthreads();
            { const unsigned pf = pref[r32]; TOPK_LOOP((hist_gen<false, false>(sv, p, tile, qabs, hi, hrow, pf, 21, 10, 2047u)), (hist_gen<true, false>(sv, p, tile, qabs, hi, hrow, pf, 21, 10, 2047u))); }
            __syncthreads();
            TOPK_SCAN(2048, true, 11, 0u);
            __syncthreads();
            sh = 10; big = __any(nbin[r32] > (unsigned)CAND);
            if (big) {
                TOPK_ZERO(); __syncthreads();
                { const unsigned pf = pref[r32]; TOPK_LOOP((hist_gen<false, false>(sv, p, tile, qabs, hi, hrow, pf, 10, 0, 1023u)), (hist_gen<true, false>(sv, p, tile, qabs, hi, hrow, pf, 10, 0, 1023u))); }
                __syncthreads();
                TOPK_SCAN(1024, true, 10, 0u);
                __syncthreads();
                sh = 0;
            }
        }
        }
        if (fused) {
            { const unsigned tb = (pref[r32] << 21) | 0x1fffffu; LAS unsigned* lc = lcnt + r32; unsigned mlo = 0u, mhi = 0u;
              TOPK_LOOP((cand_pos_half<false>(sv, p, tile, qabs, hi, lrow, lc, tb), mask_half<false, 2>(sv, p, tile, qabs, hi, tb, mlo, mhi), TOPK_MSTORE()),
                        (cand_pos_half<true>(sv, p, tile, qabs, hi, lrow, lc, tb), mask_half<true, 2>(sv, p, tile, qabs, hi, tb, mlo, mhi), TOPK_MSTORE())); }
            __syncthreads();
            for (int rr = 0; rr < 4; ++rr) { const int row = wid * 4 + rr; const unsigned n = lcnt[row] < (unsigned)CAND ? lcnt[row] : (unsigned)CAND; const LAS unsigned* lst = hist + row * CAND;
                const unsigned thr = select_packed(lst, n, krem[row], lane, (LAS unsigned*)(F.lds + SEL_OFF) + wid * 128);
                for (int j = 0; j < 16; ++j) { const unsigned idx = (unsigned)(lane + 64 * j); if (idx < n) { const unsigned e = lst[idx];
                    if (e >= thr) { const unsigned pos = 8191u - (e & 8191u), c = pos & 31u, wd = (pos >> 6) * 32u + ((pos >> 5) & 1u) * 16u + (c & 3u) + 4u * (c >> 3);
                        __hip_atomic_fetch_or((unsigned*)mq + 2u * wd + ((c >> 2) & 1u), 1u << row, __ATOMIC_RELAXED, __HIP_MEMORY_SCOPE_WORKGROUP); } } } }
        } else {
        if (sh > 0) {
            { const unsigned pf = pref[r32]; LAS unsigned* lc = lcnt + r32; TOPK_LOOP(cand_half<false>(sv, p, tile, qabs, hi, lrow, lc, pf, sh), cand_half<true>(sv, p, tile, qabs, hi, lrow, lc, pf, sh)); }
            __syncthreads();
            for (int rr = 0; rr < 4; ++rr) { const int row = wid * 4 + rr; const unsigned n = lcnt[row] < (unsigned)CAND ? lcnt[row] : (unsigned)CAND;
                const unsigned thr = select_row(hist + row * CAND, n, krem[row], pref[row], sh, lane, (LAS unsigned*)(F.lds + SEL_OFF) + wid * 128);
                if (lane == 0) pref[row] = thr; }
            __syncthreads();
        }
        { const unsigned thr = pref[r32];
          unsigned mlo = 0u, mhi = 0u;
          if (!__any(thr < 0x80000000u)) { const unsigned tb = thr & 0x7fffffffu;
              TOPK_LOOP((mask_half<false, true>(sv, p, tile, qabs, hi, tb, mlo, mhi), TOPK_MSTORE()), (mask_half<true, true>(sv, p, tile, qabs, hi, tb, mlo, mhi), TOPK_MSTORE())); }
          else { TOPK_LOOP((mask_half<false, false>(sv, p, tile, qabs, hi, thr, mlo, mhi), TOPK_MSTORE()), (mask_half<true, false>(sv, p, tile, qabs, hi, thr, mlo, mhi), TOPK_MSTORE())); }
          }
        }
        for (int tile = ntile + wid; tile < nt_att; tile += NWAVES) if (lane < 32) mq[(size_t)tile * 32 + lane] = 0ull;
        __syncthreads();
#undef TOPK_MSTORE
#undef TOPK_SCAN
#undef TOPK_LOOP
#undef TOPK_SCORES
#undef TOPK_KP
#undef TOPK_LDB
#undef TOPK_LDW
#undef TOPK_LWAIT
#undef TOPK_MF
#undef TOPK_BQ
#undef TOPK_ZERO
    }
}

__device__ __forceinline__ void route_phase(Frame& F, const float* gain, const float* wr) {
    const int lane = F.lane;
    volatile LAS unsigned* lcnt = F.MISC + 16;
    f32x4 wga[4][4], wgb[4][4];
#pragma unroll
    for (int j = 0; j < 4; ++j) { const int c0 = 8 * lane + 512 * (j >> 1) + 4 * (j & 1); const f32x4 g4 = *(const f32x4*)(gain + c0);
#pragma unroll
        for (int i = 0; i < 4; ++i) { wga[j][i] = *(const f32x4*)(wr + (size_t)(c0 + i) * 8) * g4[i]; wgb[j][i] = *(const f32x4*)(wr + (size_t)(c0 + i) * 8 + 4) * g4[i]; } }
    for (int grp = blockIdx.x; grp < M / 64; grp += F.G) {
#pragma unroll 2
    for (int ti = 0; ti < 8; ++ti) { const int m = grp * 64 + F.wave * 8 + ti;
        const GAS v4u* xr = (const GAS v4u*)((const bf16*)(F.ws + WS_XB) + (size_t)m * D) + lane; f32x4 v[4]; float s = 0.f;
#pragma unroll
        for (int jj = 0; jj < 2; ++jj) { const v4u w = xr[64 * jj]; v[2 * jj] = (f32x4){bfl(w.x), bfh(w.x), bfl(w.y), bfh(w.y)}; v[2 * jj + 1] = (f32x4){bfl(w.z), bfh(w.z), bfl(w.w), bfh(w.w)}; }
#pragma unroll
        for (int j = 0; j < 4; ++j) s += (v[j].x * v[j].x + v[j].y * v[j].y) + (v[j].z * v[j].z + v[j].w * v[j].w);
        const float rstd = __builtin_amdgcn_rsqf(wave_sum(s) * (1.f / D) + EPS);
        float lg[8];
#pragma unroll
        for (int e = 0; e < 8; ++e) lg[e] = 0.f;
#pragma unroll
        for (int j = 0; j < 4; ++j) {
#pragma unroll
            for (int i = 0; i < 4; ++i) { const float h = v[j][i]; const f32x4 wa = wga[j][i], wb = wgb[j][i];
                lg[0] += h * wa.x; lg[1] += h * wa.y; lg[2] += h * wa.z; lg[3] += h * wa.w; lg[4] += h * wb.x; lg[5] += h * wb.y; lg[6] += h * wb.z; lg[7] += h * wb.w; } }
#pragma unroll
        for (int e = 0; e < 8; ++e) lg[e] = wave_sum(lg[e]) * rstd;
        int e0 = 0; float l0 = lg[0];
#pragma unroll
        for (int e = 1; e < 8; ++e) if (lg[e] > l0) { l0 = lg[e]; e0 = e; }
        int e1 = -1; float l1 = -INFINITY;
#pragma unroll
        for (int e = 0; e < 8; ++e) if (e != e0 && lg[e] > l1) { l1 = lg[e]; e1 = e; }
        const float g1 = 1.f / (1.f + __expf(l0 - l1)), g0 = 1.f - g1;
        if (lane == 0) { *(GAS f32x4*)((float*)(F.ws + WS_ROUTE) + (size_t)m * 4) = (f32x4){__uint_as_float((unsigned)e0 | ((unsigned)e1 << 8)), g0, g1, rstd};
            __hip_atomic_fetch_add((LAS unsigned*)lcnt + e0, 1u, __ATOMIC_RELAXED, __HIP_MEMORY_SCOPE_WORKGROUP); __hip_atomic_fetch_add((LAS unsigned*)lcnt + e1, 1u, __ATOMIC_RELAXED, __HIP_MEMORY_SCOPE_WORKGROUP); }
    }
    __syncthreads();
    if (F.tid < 8) { const unsigned c = lcnt[F.tid]; ((int*)(F.ws + WS_GCNT))[grp * 8 + F.tid] = (int)c; __hip_atomic_fetch_add(F.ctl + CW_CNT + 64 * F.tid, c, RLX_AGENT); lcnt[F.tid] = 0u; }
    __syncthreads();
    }
}
constexpr int MOE_I_UP = 16 * 56, MOE_I_DN = 56 * 16, MOE_NIT = NE * (2 * MOE_I_UP + MOE_I_DN), MOE_EARLY = NE * MOE_I_DN + W13E_SPLIT * 2 * MOE_I_UP;
constexpr int MOE_K_INPROJ = 3, MOE_K_UP = 1;
__device__ __forceinline__ TrItem moe_item(Frame& F, int it, const float* gain, const float* w1, const float* w3, const float* w2) {
    TrItem t; int r;
    if (it < NE * MOE_I_DN) { const int e = it / MOE_I_DN; r = it - e * MOE_I_DN; t.W = w2 + (size_t)e * FFE * D; t.WT = (unsigned char*)F.out + DO_W2E + (size_t)e * D * FFE; t.gain = nullptr; t.scale = MOE_SW2; t.K = FFE; t.N = D; t.mp = RowMap{0, 0}; }
    else { const int i2 = it - NE * MOE_I_DN, e = i2 / (2 * MOE_I_UP); r = i2 - e * 2 * MOE_I_UP; const bool third = r >= MOE_I_UP; if (third) r -= MOE_I_UP;
        t.W = (third ? w3 : w1) + (size_t)e * D * FFE; t.WT = (e < W13E_SPLIT ? (unsigned char*)F.out + DO_W13E : F.ws + WS_W13E) + (size_t)e * 2 * FFE * D; t.gain = gain; t.scale = MOE_SW1; t.K = D; t.N = FFE; t.mp = RowMap{2, third ? 128 : 0}; }
    const int nblk = t.N / 64; t.k0 = 64 * (r / nblk); t.n0 = 64 * (r % nblk); return t;
}
__device__ __forceinline__ void moe_weights_range(Frame& F, const float* gain, const float* w1, const float* w3, const float* w2, int first, int stride, int count, int limit) {
    LAS float* scr = (LAS float*)(F.lds + RING_OFF + F.wave * 16896);
    const int lane = F.lane;
    int it = first; if (count <= 0 || it >= limit) return;
    TrItem cur = moe_item(F, it, gain, w1, w3, w2); f32x4 v[16]; float gv[16]; tr64_load(cur, v, gv, lane);
    for (int k = 1;; ++k) { const int nx = it + stride; const bool more = k < count && nx < limit;
        TrItem nxt = cur; f32x4 vn[16]; float gn[16];
        if (more) { nxt = moe_item(F, nx, gain, w1, w3, w2); tr64_load(nxt, vn, gn, lane); }
        tr64_store(cur, v, gv, scr, lane);
        if (!more) break;
        it = nx; cur = nxt;
#pragma unroll
        for (int i = 0; i < 16; ++i) { v[i] = vn[i]; gv[i] = gn[i]; } }
}
__device__ __forceinline__ int moe_tail_idle(int G, int nwg) { const int rem = nwg % G; return rem > 0 ? G - rem : 0; }
__device__ __forceinline__ int moe_tail_base(int G, int t) {
    const int n0 = moe_tail_idle(G, (M / 256) * (INP / 256)) * 8 * MOE_K_INPROJ, n2 = moe_tail_idle(G, (M / 256) * (2 * FF / 256)) * 8 * MOE_K_UP;
    const int b = t == 0 ? 0 : t == 1 ? n0 : t == 2 ? 2 * n0 : 2 * n0 + n2; return b < MOE_EARLY ? b : MOE_EARLY; }
__device__ __forceinline__ void moe_tail_work(Frame& F, const float* const* in, int t, int nwg, int kper) {
    const int rem = nwg % F.G, idle = moe_tail_idle(F.G, nwg); if (idle == 0 || (int)blockIdx.x < rem) return;
    asm volatile("s_waitcnt vmcnt(0)" ::: "memory"); __syncthreads();
    const int base = moe_tail_base(F.G, t), lim = moe_tail_base(F.G, t + 1);
    moe_weights_range(F, in[10] + D, in[15], in[16], in[17], base + ((int)blockIdx.x - rem) * 8 + F.wave, idle * 8, kper, lim);
}
struct MoeSeg { int t1, t2, t3, t4, t5, t6, t7, nrt; };
__device__ __forceinline__ MoeSeg moe_segments(Frame& F) {
    unsigned c[8];
#pragma unroll
    for (int e = 0; e < 8; ++e) c[e] = (unsigned)__builtin_amdgcn_readfirstlane((int)__hip_atomic_load(F.ctl + CW_CNT + 64 * e, RLX_AGENT));
    MoeSeg s; int a = 0;
    a += (c[0] + 255) >> 8; s.t1 = a; a += (c[1] + 255) >> 8; s.t2 = a; a += (c[2] + 255) >> 8; s.t3 = a; a += (c[3] + 255) >> 8; s.t4 = a;
    a += (c[4] + 255) >> 8; s.t5 = a; a += (c[5] + 255) >> 8; s.t6 = a; a += (c[6] + 255) >> 8; s.t7 = a; a += (c[7] + 255) >> 8; s.nrt = a;
    return s;
}
__device__ __forceinline__ void gather_phase(Frame& F) {
    const MoeSeg sg = moe_segments(F);
    LAS int* earr = (LAS int*)(F.lds + RING_OFF);
    LAS int* parr = earr + 128;
    LAS int* tot = parr + 128;
    LAS int* base = tot + 8;
    const float* ROUTE = (const float*)(F.ws + WS_ROUTE); int* POS = (int*)(F.ws + WS_POS); float* META = (float*)(F.ws + WS_META); unsigned char* AP = F.ws + WS_AP;
    for (int e = blockIdx.x; e < 8; e += F.G) {
        const int cnt = (int)__hip_atomic_load(F.ctl + CW_CNT + 64 * e, RLX_AGENT);
        const int toff = e == 0 ? 0 : e == 1 ? sg.t1 : e == 2 ? sg.t2 : e == 3 ? sg.t3 : e == 4 ? sg.t4 : e == 5 ? sg.t5 : e == 6 ? sg.t6 : sg.t7;
        const int r0 = toff * 256 + cnt, r1 = toff * 256 + ((cnt + 255) & ~255);
        for (int r = r0 + F.wave; r < r1; r += NWAVES) { GAS unsigned long long* o8 = (GAS unsigned long long*)(AP + (size_t)r * D) + F.lane;
#pragma unroll
            for (int j = 0; j < 2; ++j) o8[64 * j] = 0ull;
            if (F.lane == 0) *(f32x4*)(META + (size_t)r * 4) = (f32x4){0.f, 0.f, 0.f, 0.f}; } }
    for (int grp = blockIdx.x; grp < M / 64; grp += F.G) {
        const int p = F.tid, tok = grp * 64 + (p >> 1), slot = p & 1; int e = 0;
        if (p < 128) { const unsigned ee = __float_as_uint(ROUTE[(size_t)tok * 4]); e = slot == 0 ? (int)(ee & 0xffu) : (int)((ee >> 8) & 0xffu); earr[p] = e; }
        __syncthreads();
        if (p < 8) { tot[p] = 0; base[p] = 0; }
        __syncthreads();
        for (int i = p; i < grp * 8; i += NWAVES * 64) __hip_atomic_fetch_add(base + (i & 7), ((const int*)(F.ws + WS_GCNT))[i], __ATOMIC_RELAXED, __HIP_MEMORY_SCOPE_WORKGROUP);
        __syncthreads();
        if (p < 128) { int rank = 0; for (int j = 0; j < p; ++j) rank += (earr[j] == e);
            const int toff = e == 0 ? 0 : e == 1 ? sg.t1 : e == 2 ? sg.t2 : e == 3 ? sg.t3 : e == 4 ? sg.t4 : e == 5 ? sg.t5 : e == 6 ? sg.t6 : sg.t7;
            const int pos = toff * 256 + base[e] + rank; parr[p] = pos; POS[(size_t)tok * 2 + slot] = pos;
            const f32x4 rt4 = *(const f32x4*)(ROUTE + (size_t)tok * 4); *(f32x4*)(META + (size_t)pos * 4) = (f32x4){rt4.w * (1.f / (MOE_SX * MOE_SW1)), (slot == 0 ? rt4.y : rt4.z) * MOE_SH, 0.f, 0.f}; }
        __syncthreads();
        { const int c4 = p & 255, tsub = p >> 8;
#pragma unroll 1
          for (int it = 0; it < 32; it += 8) { unsigned long long v[8];
#pragma unroll
              for (int k = 0; k < 8; ++k) v[k] = *((const GAS unsigned long long*)((const bf16*)(F.ws + WS_XB) + (size_t)(grp * 64 + 2 * (it + k) + tsub) * D) + c4);
#pragma unroll
              for (int k = 0; k < 8; ++k) { const int tl = 2 * (it + k) + tsub; const unsigned a = (unsigned)v[k], b = (unsigned)(v[k] >> 32); const unsigned w = pg8::pk4_fp8((f32x4){bfl(a), bfh(a), bfl(b), bfh(b)} * MOE_SX);
                  *((GAS unsigned*)(AP + (size_t)parr[2 * tl] * D) + c4) = w; *((GAS unsigned*)(AP + (size_t)parr[2 * tl + 1] * D) + c4) = w; } } }
        __syncthreads();
    }
}
__device__ __forceinline__ f32x4 moe_row4(Frame& F, int pos, int col) {
    if (pos < 128 * 256) { const unsigned long long a = *((const GAS unsigned long long*)((const bf16*)(F.ws + WS_Y) + (size_t)pos * D + col));
        return (f32x4){bfl((unsigned)a), bfh((unsigned)a), bfl((unsigned)(a >> 32)), bfh((unsigned)(a >> 32))}; }
    const float* sl = (const float*)(F.ws + WS_SLAB) + ((size_t)(((pos >> 8) - 128) * 4 + (col >> 8)) * 7) * 65536 + (size_t)(pos & 255) * 256 + (col & 255);
    f32x4 v = *(const GAS f32x4*)sl;
#pragma unroll
    for (int k = 1; k < 7; ++k) v += *(const GAS f32x4*)(sl + (size_t)k * 65536);
    return v;
}
__device__ __forceinline__ void fin_phase(Frame& F) {
    const int gw = F.vcu * NWAVES + F.wave, NGW = F.G * NWAVES, lane = F.lane;
    const int* POS = (const int*)(F.ws + WS_POS);
    for (int m = gw; m < M; m += NGW) {
        const int2 pa = *(const int2*)(POS + (size_t)m * 2);
        GAS f32x4* xa = (GAS f32x4*)(F.out + (size_t)m * D) + lane;
        f32x4 va[4];
#pragma unroll
        for (int j = 0; j < 4; ++j) { const unsigned long long w = *((const GAS unsigned long long*)((const bf16*)(F.ws + WS_XB) + (size_t)m * D + 256 * j) + lane); va[j] = (f32x4){bfl((unsigned)w), bfh((unsigned)w), bfl((unsigned)(w >> 32)), bfh((unsigned)(w >> 32))}; }
        if (pa.x < 128 * 256 && pa.y < 128 * 256) {
            unsigned long long ya[4], yb[4];
#pragma unroll
            for (int j = 0; j < 4; ++j) { ya[j] = *((const GAS unsigned long long*)((const bf16*)(F.ws + WS_Y) + (size_t)pa.x * D + 256 * j) + lane); yb[j] = *((const GAS unsigned long long*)((const bf16*)(F.ws + WS_Y) + (size_t)pa.y * D + 256 * j) + lane); }
#pragma unroll
            for (int j = 0; j < 4; ++j) { const unsigned long long a = ya[j], b = yb[j];
                va[j].x += bfl((unsigned)a) + bfl((unsigned)b); va[j].y += bfh((unsigned)a) + bfh((unsigned)b); va[j].z += bfl((unsigned)(a >> 32)) + bfl((unsigned)(b >> 32)); va[j].w += bfh((unsigned)(a >> 32)) + bfh((unsigned)(b >> 32)); }
        } else {
#pragma unroll
            for (int j = 0; j < 4; ++j) { const int col = 4 * lane + 256 * j; va[j] = va[j] + (moe_row4(F, pa.x, col) + moe_row4(F, pa.y, col)); }
        }
#pragma unroll
        for (int j = 0; j < 4; ++j) xa[64 * j] = va[j];
    }
}

#ifndef GSP2
#define GSP2 true
#endif
struct Args { const float* in[18]; float* out; unsigned char* ws; int ph_lo, ph_hi; };
__global__ void __launch_bounds__(NWAVES * 64, 2) mk_fwd(Args args) {
    extern __shared__ __attribute__((aligned(16))) unsigned char lds[];
    Frame F;
    F.lds = (LAS unsigned char*)lds;
    F.MISC = (volatile LAS unsigned*)(F.lds + MISC_OFF);
    const int wave0 = __builtin_amdgcn_readfirstlane((int)threadIdx.x >> 6);
    F.wave = wave0; F.lane = mk_lane(); F.tid = wave0 * 64 + F.lane;
    F.G = gridDim.x; { const int bx = blockIdx.x; F.vcu = (F.G % 8 == 0) ? (bx % 8) * (F.G / 8) + bx / 8 : bx; }
    F.ws = args.ws; F.out = args.out; F.ctl = (gu32*)(args.ws + WS_CTL);
    for (int u = F.tid; u < (LDS_BYTES - LDSCTL_OFF) / 4; u += NWAVES * 64) ((LAS unsigned*)(F.lds + LDSCTL_OFF))[u] = 0u;
    __syncthreads();
    XcdBarrier bar; bar.bar = (unsigned*)(F.ctl + CW_BAR); bar.x = 0; bar.st = nullptr; bar.wv = wave0;
    if (!MK_PER_PHASE) bar = xcd_barrier_post((unsigned*)(F.ctl + CW_BAR), F.MISC + 8, wave0);
    const int lo = args.ph_lo, hi = args.ph_hi;
#define IN(k) (!MK_PER_PHASE || (lo <= (k) && (k) < hi))
#define FRESH() do { int l_ = mk_lane(), w_ = wave0; unsigned char* ws_ = args.ws; asm volatile("" : "+v"(l_)); asm volatile("" : "+s"(w_)); asm volatile("" : "+s"(ws_)); F.lane = l_; F.tid = w_ * 64 + l_; F.wave = w_; F.ws = ws_; } while (0)
#define SEAM(k) do { if (!MK_PER_PHASE && IN(k) && IN((k) + 1)) xcd_barrier(bar); } while (0)
    const float* const* in = args.in;
    bf16* XB = (bf16*)(F.ws + WS_XB); float* SSQP = (float*)(F.ws + WS_SSQP);

    if (IN(0)) { FRESH(); p0_prologue(F, in); } SEAM(0);

    for (int L = 0; L < 2; ++L) {
        const int pb = 1 + 7 * L;
        if (IN(pb)) { FRESH(); pg8::Gemm g{XB, (const bf16*)(F.ws + WS_WIN) + (size_t)L * INP * D, M, INP, D, D}; pg8::StaticOrder S; S.init(M, INP, F.G, (int)blockIdx.x);
            pg8::EpiInProj E{F.ws, (const float*)(F.ws + WS_GAINS) + L * 128, attn_body::C2};
            pg8::gemm_phase<pg8::EpiInProj, pg8::StaticOrder, true, GSP2>(F.lds + RING_OFF, g, S, E, F.wave);
            FRESH(); moe_tail_work(F, in, L, (M / 256) * (INP / 256), MOE_K_INPROJ); }
        SEAM(pb);
        if (IN(pb + 1)) { FRESH(); diff_rows(F); topk_phase(F, L); }
        SEAM(pb + 1);
        if (IN(pb + 2)) { FRESH();
            const attn_body::AttnTensors AT{(const attn_body::bf16*)(F.ws + WS_Q), (const attn_body::bf16*)(F.ws + WS_K), (const attn_body::bf16*)(F.ws + WS_V), (attn_body::bf16*)(F.ws + WS_AO), (const unsigned long long*)(F.ws + WS_MASK + (size_t)L * 16 * MiB)};
            const attn_body::StaticOrder S((int)F.G, (int)blockIdx.x);
            attn_body::attn_phase<attn_body::StaticOrder>((char*)lds + RING_OFF, AT, S, F.wave); }
        SEAM(pb + 2);
        if (IN(pb + 3)) { FRESH();
            pg8::Gemm g{(const bf16*)(F.ws + WS_AO), (const bf16*)(F.ws + WS_PA) + (size_t)L * D * 512, M, D, 1024, 512, 0, 0ll, (const bf16*)(F.ws + WS_DIFF), (const bf16*)(F.ws + WS_WEFF) + (size_t)L * D * 512, 8};
            pg8::StaticOrder S; S.init(M, D, F.G, (int)blockIdx.x);
            pg8::EpiGate2 E{(const bf16*)(F.ws + WS_SG), 2048, (bf16*)(F.ws + WS_MB)};
            pg8::gemm_phase<pg8::EpiGate2, pg8::StaticOrder, true, GSP2>(F.lds + RING_OFF, g, S, E, F.wave); }
        SEAM(pb + 3);
        if (IN(pb + 4)) { FRESH(); pg8::Gemm g{(const bf16*)(F.ws + WS_MB), (const bf16*)(F.ws + WS_WOUT) + (size_t)L * D * D, M, D, D, D}; pg8::StaticOrder S; S.init(M, D, F.G, (int)blockIdx.x);
            if (L == 0) { pg8::EpiResid<true> E{XB, F.ws + WS_X8, SSQP, 1.f, MOE_SX};
                pg8::gemm_phase<pg8::EpiResid<true>, pg8::StaticOrder, true, GSP2>(F.lds + RING_OFF, g, S, E, F.wave); }
            else { pg8::EpiResid<false> E{XB, nullptr, SSQP, 1.f, 1.f};
                pg8::gemm_phase<pg8::EpiResid<false>, pg8::StaticOrder, true, GSP2>(F.lds + RING_OFF, g, S, E, F.wave); } }
        SEAM(pb + 4);
        if (L == 0) {
            if (IN(6)) { FRESH(); pg8::Gemm g{(const bf16*)(F.ws + WS_X8), (const bf16*)(F.ws + WS_W13), M, 2 * FF, D / 2, D / 2}; pg8::StaticOrder S; S.init(M, 2 * FF, F.G, (int)blockIdx.x);
                pg8::EpiSwiGLU<false> E{(bf16*)(F.ws + WS_HB), FF, 2 * FF / 256, SSQP, nullptr, 1.f / (MOE_SX * MOE_SW1), MOE_SH};
                pg8::gemm_phase<pg8::EpiSwiGLU<false>, pg8::StaticOrder, true, GSP2, true>(F.lds + RING_OFF, g, S, E, F.wave);
                FRESH(); moe_tail_work(F, in, 2, (M / 256) * (2 * FF / 256), MOE_K_UP); }
            SEAM(6);
            if (IN(7)) { FRESH(); pg8::Gemm g{(const bf16*)(F.ws + WS_HB), (const bf16*)(F.ws + WS_W2), M, D, FF / 2, FF / 2}; pg8::StaticOrder S; S.init(M, D, F.G, (int)blockIdx.x);
                pg8::EpiResid<false> E{XB, nullptr, SSQP, 1.f / (MOE_SH * MOE_SW2), 1.f};
                pg8::gemm_phase<pg8::EpiResid<false>, pg8::StaticOrder, true, GSP2, true>(F.lds + RING_OFF, g, S, E, F.wave); }
            SEAM(7);
        }
    }
    if (IN(13)) { FRESH(); moe_weights_range(F, in[10] + D, in[15], in[16], in[17], moe_tail_base(F.G, 3) + F.vcu * NWAVES + F.wave, F.G * NWAVES, 1 << 30, MOE_NIT); route_phase(F, in[10] + D, in[14]); }
    SEAM(13);
    if (IN(14)) { FRESH(); gather_phase(F); }
    SEAM(14);
    if (IN(15)) { FRESH(); const MoeSeg sg = moe_segments(F);
        pg8::Gemm g{(const bf16*)(F.ws + WS_AP), (const bf16*)((unsigned char*)F.out + DO_W13E), MROWS, NE * 2 * FFE, D / 2, D / 2, W13E_SPLIT * (2 * FFE / 256), (long long)((F.ws + WS_W13E) - ((unsigned char*)F.out + DO_W13E))};
        pg8::GroupedOrder S{2 * FFE / 256, F.G, (int)blockIdx.x, sg.nrt, sg.t1, sg.t2, sg.t3, sg.t4, sg.t5, sg.t6, sg.t7, 0, sg.nrt * (2 * FFE / 256), 1, 0};
        pg8::EpiSwiGLU<true> E{(bf16*)(F.ws + WS_HE), FFE, 2 * FFE / 256, nullptr, (const float*)(F.ws + WS_META)};
        pg8::gemm_phase<pg8::EpiSwiGLU<true>, pg8::GroupedOrder, true, GSP2, true>(F.lds + RING_OFF, g, S, E, F.wave); }
    SEAM(15);
    if (IN(16)) { FRESH(); const MoeSeg sg = moe_segments(F);
        { pg8::Gemm g{(const bf16*)(F.ws + WS_HE), (const bf16*)((unsigned char*)F.out + DO_W2E), MROWS, NE * D, FFE / 2, FFE / 2};
          pg8::GroupedOrder S{D / 256, F.G, (int)blockIdx.x, sg.nrt, sg.t1, sg.t2, sg.t3, sg.t4, sg.t5, sg.t6, sg.t7, 0, 128 * (D / 256), 1, 0};
          pg8::EpiPlain E{(bf16*)(F.ws + WS_Y), D, D / 256, 1.f / (MOE_SH * MOE_SW2)};
          pg8::gemm_phase<pg8::EpiPlain, pg8::GroupedOrder, true, GSP2, true>(F.lds + RING_OFF, g, S, E, F.wave); }
        { pg8::Gemm g{(const bf16*)(F.ws + WS_HE), (const bf16*)((unsigned char*)F.out + DO_W2E), MROWS, NE * D, FFE / 14, FFE / 2};
          pg8::GroupedOrder S{D / 256, F.G, (int)blockIdx.x, sg.nrt, sg.t1, sg.t2, sg.t3, sg.t4, sg.t5, sg.t6, sg.t7, 128 * (D / 256), sg.nrt * (D / 256), 7, FFE / 14};
          pg8::EpiSlab E{(float*)(F.ws + WS_SLAB), D / 256, 128, 7, FFE / 14, 1.f / (MOE_SH * MOE_SW2)};
          pg8::gemm_phase<pg8::EpiSlab, pg8::GroupedOrder, true, GSP2, true>(F.lds + RING_OFF, g, S, E, F.wave); }
        }
    SEAM(16);
    if (IN(17)) { FRESH(); fin_phase(F); }
#undef IN
#undef SEAM
}

extern "C" void kernel_launch(void* const* d_in, const int* in_sizes, int n_in, void* d_out, int out_size, void* d_ws, size_t ws_size, hipStream_t stream) {
    static int grid = 0;
    if (grid == 0) {
        if (n_in != 18 || in_sizes[0] != M * D || out_size != M * D || ws_size < WS_END) { fprintf(stderr, "kernel_launch: unexpected shapes or workspace (n_in %d, ws %zu < %zu); nothing launched\n", n_in, ws_size, (size_t)WS_END); grid = -1; return; }
        int dev = 0, cus = 0, per_cu = 0;
        if (hipGetDevice(&dev) != hipSuccess || hipDeviceGetAttribute(&cus, hipDeviceAttributeMultiprocessorCount, dev) != hipSuccess) { grid = -1; return; }
        if (hipFuncSetAttribute((const void*)mk_fwd, hipFuncAttributeMaxDynamicSharedMemorySize, LDS_BYTES) != hipSuccess) { fprintf(stderr, "kernel_launch: hipFuncSetAttribute failed\n"); grid = -1; return; }
        if (hipOccupancyMaxActiveBlocksPerMultiprocessor(&per_cu, (const void*)mk_fwd, NWAVES * 64, LDS_BYTES) != hipSuccess || per_cu < 1) fprintf(stderr, "kernel_launch: occupancy query reports %d\n", per_cu);
        (void)hipGetLastError();
        grid = cus;
    }
    if (grid < 0) return;
    if (hipMemsetAsync((char*)d_ws + WS_CTL, 0, CTL_ZERO_BYTES, stream) != hipSuccess) return;
    Args a{};
    for (int i = 0; i < 18; ++i) a.in[i] = (const float*)d_in[i];
    a.out = (float*)d_out; a.ws = (unsigned char*)d_ws;
#if MK_PER_PHASE
    for (int ph = 0; ph < NPH; ++ph) { a.ph_lo = ph; a.ph_hi = ph + 1; hipLaunchKernelGGL(mk_fwd, dim3(grid), dim3(NWAVES * 64), LDS_BYTES, stream, a); }
#else
    a.ph_lo = 0; a.ph_hi = NPH; hipLaunchKernelGGL(mk_fwd, dim3(grid), dim3(NWAVES * 64), LDS_BYTES, stream, a);
#endif
}
```

```cpp
#define MK_PER_PHASE 0
#include <hip/hip_runtime.h>
#include <cstdio>
#include <cstdint>
__device__ __forceinline__ int mk_lane() { int l; asm volatile("v_mbcnt_lo_u32_b32 %0, -1, 0\n\tv_mbcnt_hi_u32_b32 %0, -1, %0" : "=v"(l)); return l; }
namespace pg8 {
#define PG8_LAS __attribute__((address_space(3)))
typedef unsigned short bf16_t;
typedef short bf16x8 __attribute__((ext_vector_type(8)));
typedef float f32x4 __attribute__((ext_vector_type(4)));
typedef unsigned u32x4 __attribute__((ext_vector_type(4)));
constexpr int BM = 256, BK = 64, HALF = 128, HTB = HALF * BK * 2  , STAGE_BYTES = 8 * HTB, NXCD = 8, WGM = 8;

__host__ __device__ __forceinline__ int lds_byte(int r, int c) { const int st = (r >> 4) * 2 + (c >> 5), rr = r & 15, cc = c & 31, ob = rr * 64 + cc * 2; return st * 1024 + (ob ^ (((ob >> 9) & 1) << 5)); }
__host__ __device__ __forceinline__ void stage_rc(int b, int& R, int& C) { const int st = b / 1024, sb = b % 1024, swz = sb ^ (((sb >> 9) & 1) << 5); R = (st >> 1) * 16 + swz / 64; C = (st & 1) * 32 + (swz % 64) / 2; }
__host__ __device__ __forceinline__ int perm32(int rho) { const int n = rho >> 4, i = rho & 15; return 8 * (i >> 2) + 4 * n + (i & 3); }

struct Unit { int pm, pn, ko; };
struct Gemm { const bf16_t* A; const bf16_t* Bt; int M, N, K, ld; int pnsplit; long long bt2off; const bf16_t* A2; const bf16_t* Bt2; int nt1; };

struct StaticOrder {
    int nM, nN, nwg, G, c;
    __host__ __device__ void init(int M, int N, int G_, int c_) { nM = M / BM; nN = N / BM; nwg = nM * nN; G = G_; c = c_; }
    __host__ __device__ bool next(int i, Unit& u) const {
        const long L = (long)i * G + c; if (L >= nwg) return false;
        int wgid = (int)L; { const int q = nwg / NXCD, r = nwg % NXCD, xcd = wgid % NXCD, off = wgid / NXCD; wgid = (xcd < r ? xcd * (q + 1) : r * (q + 1) + (xcd - r) * q) + off; }
        const int nig = WGM * nN, gid = wgid / nig, fm = gid * WGM, gsz = (nM - fm) < WGM ? (nM - fm) : WGM;
        u.pm = fm + ((wgid % nig) % gsz); u.pn = (wgid % nig) / gsz; u.ko = 0; return true;
    }
    __device__ __forceinline__ void a_ready(const Unit&) const {}
    __device__ __forceinline__ void done(const Unit&) const {}
};

__device__ __forceinline__ unsigned cvt_pk_bf16(float lo, float hi) { unsigned r; asm volatile("v_cvt_pk_bf16_f32 %0, %1, %2" : "=v"(r) : "v"(lo), "v"(hi)); return r; }
typedef float f32x2 __attribute__((ext_vector_type(2)));
__device__ __forceinline__ float bf_lo(unsigned w) { return __uint_as_float(w << 16); }
__device__ __forceinline__ float bf_hi(unsigned w) { return __uint_as_float(w & 0xffff0000u); }
__device__ __forceinline__ float fsigmoid(float x) { return __builtin_amdgcn_rcpf(1.f + __builtin_amdgcn_exp2f(-1.4426950408889634f * x)); }
__device__ __forceinline__ u32x4 pack8(const f32x4 v0, const f32x4 v1) { u32x4 w; w.x = cvt_pk_bf16(v0[0], v0[1]); w.y = cvt_pk_bf16(v0[2], v0[3]); w.z = cvt_pk_bf16(v1[0], v1[1]); w.w = cvt_pk_bf16(v1[2], v1[3]); return w; }
typedef unsigned u32x2 __attribute__((ext_vector_type(2)));
__device__ __forceinline__ unsigned pk4_fp8(const f32x4 v) { int p = __builtin_amdgcn_cvt_pk_fp8_f32(v[0], v[1], 0, false); p = __builtin_amdgcn_cvt_pk_fp8_f32(v[2], v[3], p, true); return (unsigned)p; }
__device__ __forceinline__ void unpack8(const u32x4 w, f32x4& v0, f32x4& v1) { v0 = (f32x4){bf_lo(w.x), bf_hi(w.x), bf_lo(w.y), bf_hi(w.y)}; v1 = (f32x4){bf_lo(w.z), bf_hi(w.z), bf_lo(w.w), bf_hi(w.w)}; }
__device__ __forceinline__ float rstd_from_parts(const float* ssqp, int row) {
    const f32x4* p = (const f32x4*)(ssqp + (size_t)row * 16);
    const f32x4 a = p[0], b = p[1], c = p[2], d = p[3];
    const float s = (((a[0] + a[1]) + (a[2] + a[3])) + ((b[0] + b[1]) + (b[2] + b[3]))) + (((c[0] + c[1]) + (c[2] + c[3])) + ((d[0] + d[1]) + (d[2] + d[3])));
    return __builtin_amdgcn_rsqf(s * (1.0f / 1024.0f) + 1e-6f);
}
__device__ __forceinline__ void rstd8(const float* ssqp, int row0, int fr, int fq, float (&rsv)[8], float mul) {
    float mine[2];
#pragma unroll
    for (int j = 0; j < 2; ++j) { const int k = 2 * fq + j; mine[j] = rstd_from_parts(ssqp, row0 + (k >> 2) * HALF + (k & 3) * 16) * mul; }
#pragma unroll
    for (int k = 0; k < 8; ++k) rsv[k] = __shfl(mine[k & 1], fr + 16 * (k >> 1));
}
template <bool ADD> struct EpiGate {
    static constexpr bool PERM = true, AFTER_DRAIN = false;
    const bf16_t* G; int ldg; const bf16_t* T; bf16_t* O;
    __device__ __forceinline__ void operator()(const f32x4 (&acc)[2][2][4][2], const Unit& u, int wr, int wc, int fr, int fq) const {
        const int row0 = u.pm * BM + wr * 64 + fr, col0 = u.pn * BM + wc * 32 + 8 * fq;
#pragma unroll
        for (int am = 0; am < 8; am += 2) {
            u32x4 gw[2][2], tw[2][2];
#pragma unroll
            for (int k = 0; k < 2; ++k)
#pragma unroll
                for (int bj = 0; bj < 2; ++bj) { const int row = row0 + ((am + k) >> 2) * HALF + ((am + k) & 3) * 16, col = col0 + bj * HALF; gw[k][bj] = *(const u32x4*)(G + (size_t)row * ldg + col); if (ADD) tw[k][bj] = *(const u32x4*)(T + (size_t)row * 1024 + col); }
#pragma unroll
            for (int k = 0; k < 2; ++k)
#pragma unroll
                for (int bj = 0; bj < 2; ++bj) { const int ai = (am + k) >> 2, m = (am + k) & 3; const int row = row0 + ai * HALF + m * 16, col = col0 + bj * HALF;
                    f32x4 g0, g1; unpack8(gw[k][bj], g0, g1);
                    f32x4 v0 = acc[ai][bj][m][0] * g0, v1 = acc[ai][bj][m][1] * g1;
                    if (ADD) { f32x4 t0, t1; unpack8(tw[k][bj], t0, t1); v0 += t0; v1 += t1; }
                    *(u32x4*)(O + (size_t)row * 1024 + col) = pack8(v0, v1); } }
    }
};
struct EpiGate2 {
    static constexpr bool PERM = true, AFTER_DRAIN = false;
    const bf16_t* G; int ldg; bf16_t* O;
    __device__ __forceinline__ void mid(f32x4 (&acc)[2][2][4][2], const Unit& u, int wr, int wc, int fr, int fq) const {
        const int row0 = u.pm * BM + wr * 64 + fr, col0 = u.pn * BM + wc * 32 + 8 * fq;
#pragma unroll
        for (int am = 0; am < 8; am += 2) {
            u32x4 ga[2][2], gp[2][2];
#pragma unroll
            for (int k = 0; k < 2; ++k)
#pragma unroll
                for (int bj = 0; bj < 2; ++bj) { const int row = row0 + ((am + k) >> 2) * HALF + ((am + k) & 3) * 16, col = col0 + bj * HALF; ga[k][bj] = *(const u32x4*)(G + (size_t)row * ldg + col); gp[k][bj] = *(const u32x4*)(G + (size_t)row * ldg + 1024 + col); }
#pragma unroll
            for (int k = 0; k < 2; ++k)
#pragma unroll
                for (int bj = 0; bj < 2; ++bj) { const int ai = (am + k) >> 2, m = (am + k) & 3;
                    f32x4 a0, a1, p0, p1; unpack8(ga[k][bj], a0, a1); unpack8(gp[k][bj], p0, p1);
#pragma unroll
                    for (int i = 0; i < 4; ++i) { acc[ai][bj][m][0][i] *= a0[i] * __builtin_amdgcn_rcpf(__builtin_fmaxf(p0[i], 1e-30f)); acc[ai][bj][m][1][i] *= a1[i] * __builtin_amdgcn_rcpf(__builtin_fmaxf(p1[i], 1e-30f)); } } }
    }
    __device__ __forceinline__ void operator()(const f32x4 (&acc)[2][2][4][2], const Unit& u, int wr, int wc, int fr, int fq) const {
        const int row0 = u.pm * BM + wr * 64 + fr, col0 = u.pn * BM + wc * 32 + 8 * fq;
#pragma unroll
        for (int am = 0; am < 8; am += 2) {
            u32x4 gp[2][2];
#pragma unroll
            for (int k = 0; k < 2; ++k)
#pragma unroll
                for (int bj = 0; bj < 2; ++bj) { const int row = row0 + ((am + k) >> 2) * HALF + ((am + k) & 3) * 16, col = col0 + bj * HALF; gp[k][bj] = *(const u32x4*)(G + (size_t)row * ldg + 1024 + col); }
#pragma unroll
            for (int k = 0; k < 2; ++k)
#pragma unroll
                for (int bj = 0; bj < 2; ++bj) { const int ai = (am + k) >> 2, m = (am + k) & 3; const int row = row0 + ai * HALF + m * 16, col = col0 + bj * HALF;
                    f32x4 p0, p1; unpack8(gp[k][bj], p0, p1);
                    *(u32x4*)(O + (size_t)row * 1024 + col) = pack8(acc[ai][bj][m][0] * p0, acc[ai][bj][m][1] * p1); } }
    }
};
template <bool OB8> struct EpiResid {
    static constexpr bool PERM = true, AFTER_DRAIN = false;
    bf16_t* rb; unsigned char* o8; float* ssqp; float sc, so;
    __device__ __forceinline__ void operator()(const f32x4 (&acc)[2][2][4][2], const Unit& u, int wr, int wc, int fr, int fq) const {
        const int row0 = u.pm * BM + wr * 64 + fr, col0 = u.pn * BM + wc * 32 + 8 * fq;
#pragma unroll
        for (int am = 0; am < 8; am += 4) {
            u32x4 rv[4][2];
#pragma unroll
            for (int k = 0; k < 4; ++k)
#pragma unroll
                for (int bj = 0; bj < 2; ++bj) { const size_t off = (size_t)(row0 + ((am + k) >> 2) * HALF + ((am + k) & 3) * 16) * 1024 + col0 + bj * HALF; rv[k][bj] = *(const u32x4*)(rb + off); }
#pragma unroll
            for (int k = 0; k < 4; ++k) { const int ai = (am + k) >> 2, m = (am + k) & 3; const int row = row0 + ai * HALF + m * 16; float ss = 0.f;
#pragma unroll
                for (int bj = 0; bj < 2; ++bj) { const size_t off = (size_t)row * 1024 + col0 + bj * HALF;
                    f32x4 r0, r1; unpack8(rv[k][bj], r0, r1);
                    const f32x4 v0 = acc[ai][bj][m][0] * sc + r0, v1 = acc[ai][bj][m][1] * sc + r1;
                    *(u32x4*)(rb + off) = pack8(v0, v1);
                    if (OB8) { u32x2 w8; w8.x = pk4_fp8(v0 * so); w8.y = pk4_fp8(v1 * so); *(u32x2*)(o8 + off) = w8; }
                    ss += ((v0[0] * v0[0] + v0[1] * v0[1]) + (v0[2] * v0[2] + v0[3] * v0[3])) + ((v1[0] * v1[0] + v1[1] * v1[1]) + (v1[2] * v1[2] + v1[3] * v1[3])); }
                ss += __shfl_xor(ss, 16); ss += __shfl_xor(ss, 32);
                if (fq == 0) ssqp[(size_t)row * 16 + u.pn * 4 + wc] = ss; } }
    }
};
template <bool GROUPED> struct EpiSwiGLU {
    static constexpr bool PERM = true, AFTER_DRAIN = false;
    bf16_t* O; int ldo; int nct; const float* ssqp; const float* meta; float rsc, gsc;
    __device__ __forceinline__ void operator()(const f32x4 (&acc)[2][2][4][2], const Unit& u, int wr, int wc, int fr, int fq) const {
        const int row0 = u.pm * BM + wr * 64 + fr, col0 = (u.pn % nct) * HALF + wc * 32 + 8 * fq;
        float rsv[8], gtv[8];
#pragma unroll
        for (int k = 0; k < 8; ++k) { const int row = row0 + (k >> 2) * HALF + (k & 3) * 16;
            if (GROUPED) { const f32x2 mt = *(const f32x2*)(meta + (size_t)row * 4); rsv[k] = mt.x; gtv[k] = mt.y; } else gtv[k] = gsc; }
        if (!GROUPED) rstd8(ssqp, row0, fr, fq, rsv, rsc);
#pragma unroll
        for (int ai = 0; ai < 2; ++ai)
#pragma unroll
            for (int m = 0; m < 4; ++m) { const int row = row0 + ai * HALF + m * 16; const float rs = rsv[ai * 4 + m], gt = gtv[ai * 4 + m];
                f32x4 o[2];
#pragma unroll
                for (int n = 0; n < 2; ++n)
#pragma unroll
                    for (int i = 0; i < 4; ++i) { const float a1 = acc[ai][0][m][n][i] * rs, a3 = acc[ai][1][m][n][i] * rs; o[n][i] = a1 * fsigmoid(a1) * a3 * gt; }
                u32x2 w8; w8.x = pk4_fp8(o[0]); w8.y = pk4_fp8(o[1]); *(u32x2*)((unsigned char*)O + (size_t)row * ldo + col0) = w8; }
    }
};
struct EpiPlain {
    static constexpr bool PERM = true, AFTER_DRAIN = false;
    bf16_t* O; int ldo; int nct; float sc;
    __device__ __forceinline__ void operator()(const f32x4 (&acc)[2][2][4][2], const Unit& u, int wr, int wc, int fr, int fq) const {
        const int row0 = u.pm * BM + wr * 64 + fr, col0 = (u.pn % nct) * BM + wc * 32 + 8 * fq;
#pragma unroll
        for (int ai = 0; ai < 2; ++ai)
#pragma unroll
            for (int m = 0; m < 4; ++m) { bf16_t* rowp = O + (size_t)(row0 + ai * HALF + m * 16) * ldo + col0;
#pragma unroll
                for (int bj = 0; bj < 2; ++bj) *(u32x4*)(rowp + bj * HALF) = pack8(acc[ai][bj][m][0] * sc, acc[ai][bj][m][1] * sc); }
    }
};
struct GroupedOrder {
    int nct, G, c, nrt, t1, t2, t3, t4, t5, t6, t7, l0, l1, ksplit, kchunk;
    __device__ __forceinline__ bool next(int i, Unit& u) const {
        const int S = i * G + c; if (S >= (l1 - l0) * ksplit) return false;
        const int L = l0 + S / ksplit, kp = S % ksplit;
        const int rt = L / nct, ct = L % nct;
        const int e = (rt >= t1) + (rt >= t2) + (rt >= t3) + (rt >= t4) + (rt >= t5) + (rt >= t6) + (rt >= t7);
        u.pm = rt; u.pn = e * nct + ct; u.ko = kp * kchunk; return true;
    }
    __device__ __forceinline__ void a_ready(const Unit&) const {}
    __device__ __forceinline__ void done(const Unit&) const {}
};
struct EpiSlab {
    static constexpr bool PERM = true, AFTER_DRAIN = false;
    float* S; int nct, rt0, ksplit, kchunk; float sc;
    __device__ __forceinline__ void operator()(const f32x4 (&acc)[2][2][4][2], const Unit& u, int wr, int wc, int fr, int fq) const {
        float* T = S + ((size_t)((u.pm - rt0) * nct + (u.pn % nct)) * ksplit + u.ko / kchunk) * (BM * BM);
        const int r0 = wr * 64 + fr, c0 = wc * 32 + 8 * fq;
#pragma unroll
        for (int ai = 0; ai < 2; ++ai)
#pragma unroll
            for (int m = 0; m < 4; ++m) { float* rowp = T + (unsigned)((r0 + ai * HALF + m * 16) * BM + c0);
#pragma unroll
                for (int bj = 0; bj < 2; ++bj) { *(f32x4*)(rowp + bj * HALF) = acc[ai][bj][m][0] * sc; *(f32x4*)(rowp + bj * HALF + 4) = acc[ai][bj][m][1] * sc; } }
    }
};
typedef int i32x4 __attribute__((ext_vector_type(4)));
typedef int i32x8 __attribute__((ext_vector_type(8)));
__device__ __forceinline__ i32x8 cat8(const bf16x8 a, const bf16x8 b) { return __builtin_shufflevector(__builtin_bit_cast(i32x4, a), __builtin_bit_cast(i32x4, b), 0, 1, 2, 3, 4, 5, 6, 7); }
__device__ __forceinline__ bf16x8 half8(const i32x8 v, int k) { return k == 0 ? __builtin_bit_cast(bf16x8, __builtin_shufflevector(v, v, 0, 1, 2, 3)) : __builtin_bit_cast(bf16x8, __builtin_shufflevector(v, v, 4, 5, 6, 7)); }
template <class E, class = void> struct epi_has_mid { static constexpr bool value = false; };
template <class E> struct epi_has_mid<E, decltype((void)&E::mid)> { static constexpr bool value = true; };
template <class Epi, class Sched, bool ALIGN_EPI = false, bool SP2 = false, bool F8 = false>
__device__ __forceinline__ void gemm_phase(PG8_LAS unsigned char* lds, const Gemm g, const Sched& S, const Epi& E, const int wv  ) {
    int wv_ = wv; asm volatile("" : "+s"(wv_)); int tid_ = wv_ * 64 + mk_lane(); asm volatile("" : "+v"(tid_));
    const int tid = tid_, wid = wv_, lane = tid & 63, wr = wid >> 2, wc = wid & 3, fr = lane & 15, fq = lane >> 4;
    const int K = g.K, nt = K / BK;
    unsigned voffA[2], voffB[2];
#pragma unroll
    for (int i = 0; i < 2; ++i) { int R, C; stage_rc(tid * 16 + i * 8192, R, C); const int Rb = Epi::PERM ? ((R & ~31) + perm32(R & 31)) : R;
        voffA[i] = (unsigned)(R * g.ld + C) * 2u; voffB[i] = (unsigned)(Rb * g.ld + C) * 2u; }
    const size_t kstep = (size_t)(BK * 2);
    const size_t hstep = (size_t)HALF * g.ld * 2;
    const size_t tstep = 2 * hstep;
    const unsigned ldsw = (unsigned)wid * 1024u;
    const int aoff = lds_byte(wr * 64 + fr, fq * 8), boff = lds_byte(wc * 32 + fr, fq * 8);
#define PG8_SA(b, h) (((b) * 2 + (h)) * HTB)
#define PG8_SB(b, h) ((4 + (b) * 2 + (h)) * HTB)
#define PG8_STAGE(bufoff, gbase, voff) do { const char* _g = (const char*)(gbase); if constexpr (F8) asm volatile("" : "+s"(_g));   \
        _Pragma("unroll") for (int _i = 0; _i < 2; ++_i) { unsigned _v = (voff)[F8 ? 0 : _i]; if constexpr (F8) asm volatile("" : "+v"(_v));   \
        __builtin_amdgcn_global_load_lds((const unsigned*)(_g + (F8 ? (size_t)_i * 128 * g.ld : (size_t)0) + _v), (PG8_LAS unsigned*)(lds + (bufoff) + ldsw + _i * 8192), 16, 0, 0); } } while (0)
#define PG8_LDA(dst, b, h) do { _Pragma("unroll") for (int m = 0; m < 4; ++m) dst[m] = cat8(*(const PG8_LAS bf16x8*)(lds + PG8_SA(b, h) + aoff + m * 2048), *(const PG8_LAS bf16x8*)(lds + PG8_SA(b, h) + aoff + m * 2048 + 1024)); } while (0)
#define PG8_LDB(dst, b, h) do { _Pragma("unroll") for (int n = 0; n < 2; ++n) dst[n] = cat8(*(const PG8_LAS bf16x8*)(lds + PG8_SB(b, h) + boff + n * 2048), *(const PG8_LAS bf16x8*)(lds + PG8_SB(b, h) + boff + n * 2048 + 1024)); } while (0)
#define PG8_MMA(ai, bj, At, Bt) do { __builtin_amdgcn_s_setprio(1); _Pragma("unroll") for (int m = 0; m < 4; ++m) _Pragma("unroll") for (int n = 0; n < 2; ++n) _Pragma("unroll") for (int k = 0; k < 2; ++k) \
        acc[ai][bj][m][n] = __builtin_amdgcn_mfma_f32_16x16x32_bf16(half8(Bt[n], k), half8(At[m], k), acc[ai][bj][m][n], 0, 0, 0); __builtin_amdgcn_s_setprio(0); } while (0)
#define PG8_MMA8(ai, bj, At, Bt) do { __builtin_amdgcn_s_setprio(1); _Pragma("unroll") for (int m = 0; m < 4; ++m) _Pragma("unroll") for (int n = 0; n < 2; ++n) \
        acc[ai][bj][m][n] = __builtin_amdgcn_mfma_scale_f32_16x16x128_f8f6f4(Bt[n], At[m], acc[ai][bj][m][n], 0, 0, 0, 0x7f7f7f7f, 0, 0x7f7f7f7f); __builtin_amdgcn_s_setprio(0); } while (0)
#define PG8_MM(ai, bj, At, Bt) do { if constexpr (F8) PG8_MMA8(ai, bj, At, Bt); else PG8_MMA(ai, bj, At, Bt); } while (0)
#define PG8_WAIT_V(n) asm volatile("s_waitcnt vmcnt(" #n ")" ::: "memory")
#define PG8_WAIT_L(n) asm volatile("s_waitcnt lgkmcnt(" #n ")" ::: "memory")
#define PG8_BAR __builtin_amdgcn_s_barrier()
#define PG8_SCHED __builtin_amdgcn_sched_barrier(0)
    Unit cur, nxt; int ui = 0;
    if (!S.next(0, cur)) return;
    f32x4 acc[2][2][4][2];
#pragma unroll
    for (int a = 0; a < 2; ++a)
#pragma unroll
        for (int b = 0; b < 2; ++b)
#pragma unroll
            for (int m = 0; m < 4; ++m)
#pragma unroll
                for (int n = 0; n < 2; ++n) acc[a][b][m][n] = (f32x4){0.f, 0.f, 0.f, 0.f};
    i32x8 At[4], B0[2], B1[2];
    const char* cA = (const char*)g.A + (size_t)cur.pm * tstep + (size_t)cur.ko * 2; const char* cB = (const char*)g.Bt + (size_t)cur.pn * tstep + (size_t)cur.ko * 2 + (g.pnsplit > 0 && cur.pn >= g.pnsplit ? g.bt2off : 0ll);
    S.a_ready(cur);
    if constexpr (SP2) {
        PG8_STAGE(PG8_SB(0, 0), cB, voffB); PG8_STAGE(PG8_SB(0, 1), cB + hstep, voffB); PG8_STAGE(PG8_SA(0, 0), cA, voffA); PG8_STAGE(PG8_SA(0, 1), cA + hstep, voffA);
        if (wr == 1) PG8_BAR;
        PG8_WAIT_V(2); PG8_BAR;
        PG8_STAGE(PG8_SB(1, 0), cB + kstep, voffB); PG8_STAGE(PG8_SA(1, 0), cA + kstep, voffA); PG8_STAGE(PG8_SB(1, 1), cB + hstep + kstep, voffB);
        PG8_WAIT_V(6); PG8_BAR;
    } else {
        PG8_STAGE(PG8_SB(0, 0), cB, voffB); PG8_STAGE(PG8_SA(0, 0), cA, voffA); PG8_STAGE(PG8_SB(0, 1), cB + hstep, voffB); PG8_STAGE(PG8_SA(0, 1), cA + hstep, voffA);
        if (wr == 1) PG8_BAR;
        PG8_WAIT_V(4); PG8_BAR;
        PG8_STAGE(PG8_SB(1, 0), cB + kstep, voffB); PG8_STAGE(PG8_SA(1, 0), cA + kstep, voffA); PG8_STAGE(PG8_SB(1, 1), cB + hstep + kstep, voffB);
        PG8_WAIT_V(6); PG8_BAR;
    }
    const long long dA = g.nt1 > 0 ? (long long)((const char*)g.A2 - (const char*)g.A) - (long long)g.nt1 * (long long)kstep : 0ll, dB = g.nt1 > 0 ? (long long)((const char*)g.Bt2 - (const char*)g.Bt) - (long long)g.nt1 * (long long)kstep : 0ll;
    for (;;) {
        const bool has_next = S.next(ui + 1, nxt);
        const char* nA = has_next ? (const char*)g.A + (size_t)nxt.pm * tstep + (size_t)nxt.ko * 2 : cA; const char* nB = has_next ? (const char*)g.Bt + (size_t)nxt.pn * tstep + (size_t)nxt.ko * 2 + (g.pnsplit > 0 && nxt.pn >= g.pnsplit ? g.bt2off : 0ll) : cB;
#pragma unroll 1
        for (int t = 0; t < nt; t += 2) {
            const bool last = (t == nt - 2);
            const long long o1 = (g.nt1 > 0 && t + 1 >= g.nt1) ? 1ll : 0ll, o2 = (g.nt1 > 0 && t + 2 >= g.nt1) ? 1ll : 0ll;
            const char* a1 = cA + (size_t)(t + 1) * kstep + o1 * dA;
            const char* a2 = last ? nA : cA + (size_t)(t + 2) * kstep + o2 * dA; const char* b2 = last ? nB : cB + (size_t)(t + 2) * kstep + o2 * dB;
            if constexpr (epi_has_mid<Epi>::value) { if (g.nt1 > 0 && t == g.nt1) { const int t2_ = mk_lane(); E.mid(acc, cur, wr, wc, t2_ & 15, t2_ >> 4); } }
            const char* a3 = a2 + kstep; const char* b3 = b2 + kstep;
            if (last && has_next) S.a_ready(nxt);
            if constexpr (SP2) {
            PG8_LDB(B0, 0, 0); PG8_LDB(B1, 0, 1); PG8_SCHED; PG8_LDA(At, 0, 0); PG8_STAGE(PG8_SA(1, 1), a1 + hstep, voffA);
            PG8_WAIT_V(8); PG8_WAIT_L(0); PG8_BAR; PG8_MM(0, 0, At, B0); PG8_MM(0, 1, At, B1); PG8_BAR; PG8_SCHED;
            PG8_LDA(At, 0, 1); PG8_STAGE(PG8_SB(0, 0), b2, voffB); PG8_STAGE(PG8_SB(0, 1), b2 + hstep, voffB); PG8_STAGE(PG8_SA(0, 0), a2, voffA);
            PG8_WAIT_V(8); PG8_WAIT_L(0); PG8_BAR; PG8_MM(1, 0, At, B0); PG8_MM(1, 1, At, B1); PG8_BAR; PG8_SCHED;
            PG8_LDB(B0, 1, 0); PG8_LDB(B1, 1, 1); PG8_SCHED; PG8_LDA(At, 1, 0); PG8_STAGE(PG8_SA(0, 1), a2 + hstep, voffA);
            PG8_WAIT_V(8); PG8_WAIT_L(0); PG8_BAR; PG8_MM(0, 0, At, B0); PG8_MM(0, 1, At, B1); PG8_BAR; PG8_SCHED;
            PG8_LDA(At, 1, 1); PG8_STAGE(PG8_SB(1, 0), b3, voffB); PG8_STAGE(PG8_SB(1, 1), b3 + hstep, voffB); PG8_STAGE(PG8_SA(1, 0), a3, voffA);
            PG8_WAIT_V(8); PG8_WAIT_L(0); PG8_BAR; PG8_MM(1, 0, At, B0); PG8_MM(1, 1, At, B1); PG8_BAR; PG8_SCHED;
            } else {
            PG8_LDB(B0, 0, 0); PG8_SCHED; PG8_LDA(At, 0, 0); PG8_STAGE(PG8_SA(1, 1), a1 + hstep, voffA);
            PG8_WAIT_L(8); PG8_BAR; PG8_WAIT_L(0); PG8_MM(0, 0, At, B0); PG8_BAR; PG8_SCHED;
            PG8_LDB(B1, 0, 1); PG8_STAGE(PG8_SB(0, 0), b2, voffB);
            PG8_BAR; PG8_WAIT_L(0); PG8_MM(0, 1, At, B1); PG8_BAR;
            PG8_LDA(At, 0, 1); PG8_STAGE(PG8_SA(0, 0), a2, voffA);
            PG8_BAR; PG8_WAIT_L(0); PG8_MM(1, 0, At, B0); PG8_BAR; PG8_SCHED;
            PG8_STAGE(PG8_SB(0, 1), b2 + hstep, voffB);
            PG8_WAIT_V(6); PG8_BAR; PG8_MM(1, 1, At, B1); PG8_BAR;
            PG8_LDB(B0, 1, 0); PG8_SCHED; PG8_LDA(At, 1, 0); PG8_STAGE(PG8_SA(0, 1), a2 + hstep, voffA);
            PG8_WAIT_L(8); PG8_BAR; PG8_WAIT_L(0); PG8_MM(0, 0, At, B0); PG8_BAR; PG8_SCHED;
            PG8_LDB(B1, 1, 1); PG8_STAGE(PG8_SB(1, 0), b3, voffB);
            PG8_BAR; PG8_WAIT_L(0); PG8_MM(0, 1, At, B1); PG8_BAR;
            PG8_LDA(At, 1, 1); PG8_STAGE(PG8_SA(1, 0), a3, voffA);
            PG8_BAR; PG8_WAIT_L(0); PG8_MM(1, 0, At, B0); PG8_BAR; PG8_SCHED;
            PG8_STAGE(PG8_SB(1, 1), b3 + hstep, voffB);
            PG8_WAIT_V(6); PG8_BAR; PG8_MM(1, 1, At, B1); PG8_BAR;
            }
        }
        if constexpr (ALIGN_EPI) { if (wr == 0) PG8_BAR; }
        if constexpr (!Epi::AFTER_DRAIN) { int fr_ = fr, fq_ = fq; if constexpr (F8 || epi_has_mid<Epi>::value) { int t2_ = (int)__builtin_amdgcn_mbcnt_hi(~0u, __builtin_amdgcn_mbcnt_lo(~0u, 0u)); asm volatile("" : "+v"(t2_)); fr_ = t2_ & 15; fq_ = t2_ >> 4; }   E(acc, cur, wr, wc, fr_, fq_); S.done(cur); }
        if (!has_next) break;
#pragma unroll
        for (int a = 0; a < 2; ++a)
#pragma unroll
            for (int b = 0; b < 2; ++b)
#pragma unroll
                for (int m = 0; m < 4; ++m)
#pragma unroll
                    for (int n = 0; n < 2; ++n) acc[a][b][m][n] = (f32x4){0.f, 0.f, 0.f, 0.f};
        cur = nxt; cA = nA; cB = nB; ++ui;
        if constexpr (ALIGN_EPI) { if (wr == 1) PG8_BAR; }
    }
    PG8_WAIT_V(0);
    if constexpr (!ALIGN_EPI) { if (wr == 0) PG8_BAR; }
    PG8_BAR;
    if constexpr (Epi::AFTER_DRAIN) { E.fused(acc, cur, wr, wc, fr, fq, lds, wid, lane); S.done(cur); }
#undef PG8_SA
#undef PG8_SB
#undef PG8_STAGE
#undef PG8_LDA
#undef PG8_LDB
#undef PG8_MMA
#undef PG8_MMA8
#undef PG8_MM
#undef PG8_WAIT_V
#undef PG8_WAIT_L
#undef PG8_BAR
#undef PG8_SCHED
}
}
#include <hip/hip_bf16.h>
#include <cmath>
namespace attn_body {
using bf16=__hip_bfloat16;
using bf16x8=__attribute__((ext_vector_type(8)))short;
using s16x4=__attribute__((ext_vector_type(4)))short;
using f32x16=__attribute__((ext_vector_type(16)))float;
using u32x4=__attribute__((ext_vector_type(4)))unsigned;
constexpr int BATCH=2,NHEAD=8,SEQ=8192,D=64,DM=NHEAD*D;
constexpr int NW=8,QBLK=32,QB=QBLK*NW,KVBLK=64,NQB=SEQ/QB;
constexpr int ATTN_PITCH=DM, ATTN_UNIT_ROWS=QB;
__device__ __forceinline__ int crow(int r,int hi){return (r&3)+8*(r>>2)+4*hi;}
#define SBAR() __builtin_amdgcn_sched_barrier(0)
typedef const __attribute__((address_space(4))) unsigned long long* cmask_ptr;
__device__ __forceinline__ float msel(unsigned long long m,float if_set,float if_clear){float r;asm("v_cndmask_b32_e64 %0, %1, %2, %3":"=v"(r):"v"(if_clear),"v"(if_set),"s"(m));return r;}
typedef unsigned long long u64x8 __attribute__((ext_vector_type(8)));
__device__ __forceinline__ void mload16(u64x8&a,u64x8&b,unsigned long long base,int t){
  const __attribute__((address_space(4))) u64x8* p=(const __attribute__((address_space(4))) u64x8*)(base+(unsigned long long)t*256ull);
  a=p[0];b=p[1];
}
__device__ __forceinline__ void mkc16(f32x16&c,const u64x8&a,const u64x8&b,float negmh,float ninf){
  #pragma unroll
  for(int r=0;r<8;++r){c[r]=msel(a[r],negmh,ninf);c[8+r]=msel(b[r],negmh,ninf);}
}

constexpr int NSLOT=3, SLOTB=8192;
constexpr int LDS_K=0, LDS_V=NSLOT*SLOTB, LDS_WS=2*NSLOT*SLOTB, LDS_OST=LDS_WS+NW*64*4, LDS_BYTES=LDS_OST+NW*4096;
constexpr float C2=0.125f*1.4426950408889634f;
__device__ __forceinline__ void glds16(const void*gsrc,unsigned lds_dst){unsigned keep;
  asm volatile("s_mov_b32 %0, m0\n\ts_mov_b32 m0, %2\n\ts_nop 0\n\tglobal_load_lds_dwordx4 %1, off\n\ts_mov_b32 m0, %0":"=&s"(keep):"v"(gsrc),"s"(lds_dst):"memory");}
__device__ __forceinline__ float max3f(float a,float b,float c){float r;asm("v_max3_f32 %0, %1, %2, %3":"=v"(r):"v"(a),"v"(b),"v"(c));return r;}
__device__ __forceinline__ float max2f(float a,float b){float r;asm("v_max_f32_e32 %0, %1, %2":"=v"(r):"v"(a),"v"(b));return r;}
__device__ __forceinline__ float fadd_s(float a,float b){float r;asm("v_add_f32_e32 %0, %1, %2":"=v"(r):"v"(a),"v"(b));return r;}
__device__ __forceinline__ float fsub_s(float a,float b){float r;asm("v_sub_f32_e32 %0, %1, %2":"=v"(r):"v"(a),"v"(b));return r;}
typedef float f32x2_t __attribute__((ext_vector_type(2))); typedef __bf16 bf16x2_t __attribute__((ext_vector_type(2)));
__device__ __forceinline__ unsigned cvtpk_s(float lo,float hi){f32x2_t v={lo,hi};bf16x2_t b=__builtin_convertvector(v,bf16x2_t);return __builtin_bit_cast(unsigned,b);}
#define WAIT_BAR(N) do{ asm volatile("s_waitcnt vmcnt(" #N ") lgkmcnt(0)\n\ts_barrier":::"memory"); __builtin_amdgcn_s_waitcnt(0xC07F); }while(0)

__device__ __forceinline__ void qkt(f32x16&p0,f32x16&p1,const char*Kslot,const bf16x8*qr,int r32,int hi){
  const char*kb=Kslot+hi*1024+r32*16;
  #pragma unroll
  for(int d0=0;d0<4;++d0){
    const bf16x8 b0=*reinterpret_cast<const bf16x8*>(kb+d0*2048);
    const bf16x8 b1=*reinterpret_cast<const bf16x8*>(kb+d0*2048+512);
    p0=__builtin_amdgcn_mfma_f32_32x32x16_bf16(b0,qr[d0],p0,0,0,0);p1=__builtin_amdgcn_mfma_f32_32x32x16_bf16(b1,qr[d0],p1,0,0,0);}
}
typedef __attribute__((address_space(3))) const char* lds_cptr;
typedef short v4i16_t __attribute__((ext_vector_type(4)));
__device__ __forceinline__ void kload8(bf16x8*kf,lds_cptr kp){
  kf[0]=*(const __attribute__((address_space(3))) bf16x8*)(kp);      kf[1]=*(const __attribute__((address_space(3))) bf16x8*)(kp+512);
  kf[2]=*(const __attribute__((address_space(3))) bf16x8*)(kp+2048); kf[3]=*(const __attribute__((address_space(3))) bf16x8*)(kp+2560);
  kf[4]=*(const __attribute__((address_space(3))) bf16x8*)(kp+4096); kf[5]=*(const __attribute__((address_space(3))) bf16x8*)(kp+4608);
  kf[6]=*(const __attribute__((address_space(3))) bf16x8*)(kp+6144); kf[7]=*(const __attribute__((address_space(3))) bf16x8*)(kp+6656);
}
__device__ __forceinline__ void kload2(bf16x8*kf,lds_cptr kp,int j){ kf[2*j]=*(const __attribute__((address_space(3))) bf16x8*)(kp+j*2048); kf[2*j+1]=*(const __attribute__((address_space(3))) bf16x8*)(kp+j*2048+512); }
__device__ __forceinline__ s16x4 vtr(lds_cptr p){ return __builtin_bit_cast(s16x4,__builtin_amdgcn_ds_read_tr16_b64_v4i16((__attribute__((address_space(3))) v4i16_t*)p)); }
__device__ __forceinline__ float rowmax(const f32x16&p0,const f32x16&p1){
  float a=max3f(p0[0],p0[1],p1[0]),b=max3f(p0[2],p0[3],p1[1]);a=max3f(a,p1[2],p1[3]);
  #pragma unroll
  for(int r=4;r<16;r+=4){a=max3f(a,p0[r],p0[r+1]);b=max3f(b,p0[r+2],p0[r+3]);a=max3f(a,p1[r],p1[r+1]);b=max3f(b,p1[r+2],p1[r+3]);}
  const float m=max2f(a,b);
  auto rr=__builtin_amdgcn_permlane32_swap(__float_as_uint(m),__float_as_uint(m),false,false);
  return max2f(__uint_as_float(rr[0]),__uint_as_float(rr[1]));
}
__device__ __forceinline__ void pv(f32x16*o,int vb,bf16x8 pa0,bf16x8 pa1,bf16x8 pa2,bf16x8 pa3){
  #pragma unroll
  for(int d0=0;d0<2;++d0){s16x4 lo[4],hi[4];
    #pragma unroll
    for(int ks=0;ks<4;++ks){
      asm volatile("ds_read_b64_tr_b16 %0,%1 offset:%c2":"=&v"(lo[ks]):"v"(vb),"i"(d0*4096+ks*1024):"memory");
      asm volatile("ds_read_b64_tr_b16 %0,%1 offset:%c2":"=&v"(hi[ks]):"v"(vb),"i"(d0*4096+ks*1024+512):"memory");}
    asm volatile("s_waitcnt lgkmcnt(0)":::"memory");SBAR();
    #define PK(k) (bf16x8){lo[k][0],lo[k][1],lo[k][2],lo[k][3],hi[k][0],hi[k][1],hi[k][2],hi[k][3]}
    o[d0]=__builtin_amdgcn_mfma_f32_32x32x16_bf16(pa0,PK(0),o[d0],0,0,0);
    o[d0]=__builtin_amdgcn_mfma_f32_32x32x16_bf16(pa1,PK(1),o[d0],0,0,0);
    o[d0]=__builtin_amdgcn_mfma_f32_32x32x16_bf16(pa2,PK(2),o[d0],0,0,0);
    o[d0]=__builtin_amdgcn_mfma_f32_32x32x16_bf16(pa3,PK(3),o[d0],0,0,0);
    #undef PK
  }
}

#ifndef ATTN_STORE16
#define ATTN_STORE16(p,v) (*(u32x4*)(p)=(v))
#endif
template<int THRL> __device__ __forceinline__ void attn_unit(int b,int h,int qb,const bf16*Q,const bf16*__restrict__ K,const bf16*__restrict__ V,bf16*O,const unsigned long long*MASK,char*shm,const int wv){
  int wv_=wv; asm volatile("":"+s"(wv_)); int tid_=wv_*64+mk_lane(); asm volatile("":"+v"(tid_)); const int tid=tid_,lane=tid&63,r32=lane&31,hi=lane>>5; const int wid=wv_;
  const long rowbase=(long)b*SEQ; const int q0=qb*QB;
  const bf16*Qw=Q+(rowbase+q0+wid*QBLK)*DM+h*D;
  const bf16*Kh=K+rowbase*DM+h*D,*Vh=V+rowbase*DM+h*D;
  const unsigned lds0=(unsigned)(uintptr_t)shm;
  float*wsf=(float*)(shm+LDS_WS)+wid*64;
  const bf16*ksrc=Kh+(long)lane*DM+wid*8;
  const bf16*vsrc=Vh+(long)(16*(wid&3)+(lane>>2))*DM+(wid>>2)*32+(lane&3)*8;
  const unsigned kdst=lds0+LDS_K+wid*1024, vdst=lds0+LDS_V+wid*1024;
  #define DMA_K(t,slot) glds16(ksrc+(long)(t)*KVBLK*DM,(unsigned)__builtin_amdgcn_readfirstlane(kdst+(slot)))
  #define DMA_V(t,slot) glds16(vsrc+(long)(t)*KVBLK*DM,(unsigned)__builtin_amdgcn_readfirstlane(vdst+(slot)))
  const int vb0=(int)(lds0+LDS_V)+((lane>>4)&1)*32+(lane&3)*8+(4*hi+((lane&15)>>2))*64;
  const char*Kbase=shm+LDS_K; bf16x8 kf[8];
  const lds_cptr shm3=(lds_cptr)shm; const lds_cptr kp0=shm3+LDS_K+hi*1024+r32*16; const lds_cptr vp0=shm3+LDS_V+((lane>>4)&1)*32+(lane&3)*8+(4*hi+((lane&15)>>2))*64;
  const int NT=(q0+QB)/KVBLK;
  DMA_K(0,0);DMA_V(0,0);DMA_K(1,SLOTB);
  bf16x8 qr[4];
  #pragma unroll
  for(int d0=0;d0<4;++d0)qr[d0]=*reinterpret_cast<const bf16x8*>(&Qw[(long)r32*DM+d0*16+hi*8]);
  float mhat=0.f,l_reg=0.f,negmh=0.f;f32x16 o[2];o[0]=f32x16{};o[1]=f32x16{};float NINF=-INFINITY;asm volatile("":"+v"(NINF));
  unsigned long long mbase=(unsigned long long)(uintptr_t)(MASK+((size_t)((b*256+qb*8+wid)*128))*32);asm volatile("":"+s"(mbase));
  bool resc=false;
  #define RESC() do{ if(resc){ asm volatile("s_waitcnt lgkmcnt(0)":::"memory"); \
      _Pragma("unroll") for(int d_=0;d_<2;++d_) _Pragma("unroll") for(int r=0;r<16;++r)o[d_][r]*=wsf[crow(r,hi)]; } }while(0)
  f32x16 pA0,pA1,pB0,pB1;
  int sl_prev=0,sl_cur=0,sl_next=SLOTB;
  #define ROT() do{sl_prev=sl_cur;sl_cur=sl_next;sl_next=(sl_next==(NSLOT-1)*SLOTB)?0:sl_next+SLOTB;}while(0)
  DMA_K(2,2*SLOTB);
  WAIT_BAR(3);
  u64x8 mA0,mA1,mB0,mB1;
  mload16(mA0,mA1,mbase,0);mload16(mB0,mB1,mbase+128ull,0);
  mkc16(pA0,mA0,mA1,negmh,NINF);mkc16(pA1,mB0,mB1,negmh,NINF);SBAR();
  mload16(mA0,mA1,mbase,1);mload16(mB0,mB1,mbase+128ull,1);SBAR();
  qkt(pA0,pA1,Kbase,qr,r32,hi);asm volatile("s_nop 15\n\ts_nop 7":"+v"(pA0),"+v"(pA1));
  { const float rm=rowmax(pA0,pA1);
    if(__any(rm>(float)THRL)){ const float dl=__builtin_fmaxf(rm,0.f); mhat+=dl; negmh=-mhat;
      _Pragma("unroll") for(int r=0;r<16;++r){pA0[r]-=dl;pA1[r]-=dl;} } }
  _Pragma("unroll") for(int r=0;r<16;++r){pA0[r]=__builtin_amdgcn_exp2f(pA0[r]);pA1[r]=__builtin_amdgcn_exp2f(pA1[r]);}
  WAIT_BAR(0);
  DMA_K(3,0);DMA_V(1,SLOTB);
  ROT();
  kload8(kf,kp0+sl_cur);
  WAIT_BAR(2);
  s16x4 vlo[8],vhi[8]; u32x4 pw0,pw1,pw2,pw3;
  #define PKW(P,B) cvtpk_s(P[B],P[B+1])
  #define PAF(k) __builtin_bit_cast(bf16x8,pw##k)
  #define VFR(i) (bf16x8){vlo[i][0],vlo[i][1],vlo[i][2],vlo[i][3],vhi[i][0],vhi[i][1],vhi[i][2],vhi[i][3]}
  #define PIN(x) asm volatile("":"+v"(x))
  #define MX3(a,b,c) __builtin_fmaxf(__builtin_fmaxf((a),(b)),(c))
  #define GAPA(MF,A0,A1,A2,A3,W0,W1,PW) do{ MF; sacc+=A0; sacc+=A1; sacc+=A2; sacc+=A3; PIN(sacc); W0; W1; PIN(PW); SBAR(); }while(0)
  #define EX(v) __builtin_amdgcn_exp2f(v)
  #define GAPB(MF,X,B) do{ MF; X[B]=EX(X[B]); X[B+1]=EX(X[B+1]); X[B+2]=EX(X[B+2]); X[B+3]=EX(X[B+3]); PIN(X); SBAR(); }while(0)
  #define VRD(i) do{ vlo[i]=vtr(vp_+(((i)>>2)*4096+((i)&3)*1024)); vhi[i]=vtr(vp_+(((i)>>2)*4096+((i)&3)*1024+512)); }while(0)
  #define KRD(G,j) do{ if(G){ kload2(kf,kp0+sl_next,j); SBAR(); } }while(0)
  #define STEP(C0,C1,P0,P1,t,GK,GV,GL) do{ SBAR(); \
    mkc16(C0,mA0,mA1,negmh,NINF); SBAR(); \
    const lds_cptr vp_=vp0+sl_prev; \
    VRD(0); SBAR(); float sacc=(P0[0]+P0[1]); \
    GAPA(C0=__builtin_amdgcn_mfma_f32_32x32x16_bf16(kf[0],qr[0],C0,0,0,0), P0[2],P0[3],P0[4],P0[5],     pw0[0]=PKW(P0,0), pw0[1]=PKW(P0,2), pw0); \
    mkc16(C1,mB0,mB1,negmh,NINF); SBAR(); { const int tn_=((t)+1<NT)?(t)+1:(t); mload16(mA0,mA1,mbase,tn_); mload16(mB0,mB1,mbase+128ull,tn_); } SBAR();     \
    VRD(4); SBAR(); GAPA(C1=__builtin_amdgcn_mfma_f32_32x32x16_bf16(kf[1],qr[0],C1,0,0,0), P0[6],P0[7],P0[8],P0[9],     pw0[2]=PKW(P0,4), pw0[3]=PKW(P0,6), pw0); \
    VRD(1); SBAR(); GAPA(C0=__builtin_amdgcn_mfma_f32_32x32x16_bf16(kf[2],qr[1],C0,0,0,0),   P0[10],P0[11],P0[12],P0[13], pw1[0]=PKW(P0,8), pw1[1]=PKW(P0,10), pw1); \
    VRD(5); SBAR(); GAPA(C1=__builtin_amdgcn_mfma_f32_32x32x16_bf16(kf[3],qr[1],C1,0,0,0),   P0[14],P0[15],P1[0],P1[1],   pw1[2]=PKW(P0,12),pw1[3]=PKW(P0,14), pw1); \
    VRD(2); SBAR(); GAPA(C0=__builtin_amdgcn_mfma_f32_32x32x16_bf16(kf[4],qr[2],C0,0,0,0),   P1[2],P1[3],P1[4],P1[5],     pw2[0]=PKW(P1,0), pw2[1]=PKW(P1,2), pw2); \
    VRD(6); SBAR(); GAPA(C1=__builtin_amdgcn_mfma_f32_32x32x16_bf16(kf[5],qr[2],C1,0,0,0),   P1[6],P1[7],P1[8],P1[9],     pw2[2]=PKW(P1,4), pw2[3]=PKW(P1,6), pw2); \
    VRD(3); SBAR(); GAPA(C0=__builtin_amdgcn_mfma_f32_32x32x16_bf16(kf[6],qr[3],C0,0,0,0),   P1[10],P1[11],P1[12],P1[13], pw3[0]=PKW(P1,8), pw3[1]=PKW(P1,10), pw3); \
    VRD(7); SBAR(); GAPA(C1=__builtin_amdgcn_mfma_f32_32x32x16_bf16(kf[7],qr[3],C1,0,0,0),   P1[14],P1[15],0.f,0.f,       pw3[2]=PKW(P1,12),pw3[3]=PKW(P1,14), pw3); \
    l_reg+=sacc; \
    if(GK){DMA_K((t)+3,sl_cur);} if(GV){DMA_V((t)+1,sl_next);} \
    { float a=MX3(C0[0],C0[1],C1[0]),b=MX3(C0[2],C0[3],C1[1]); a=MX3(a,C1[2],C1[3]); \
      _Pragma("unroll") for(int r=4;r<16;r+=4){a=MX3(a,C0[r],C0[r+1]);b=MX3(b,C0[r+2],C0[r+3]);a=MX3(a,C1[r],C1[r+1]);b=MX3(b,C1[r+2],C1[r+3]);} \
      float rm=__builtin_fmaxf(a,b); { auto rr=__builtin_amdgcn_permlane32_swap(__float_as_uint(rm),__float_as_uint(rm),false,false); rm=__builtin_fmaxf(__uint_as_float(rr[0]),__uint_as_float(rr[1])); } \
      resc=false; \
      if(__builtin_expect(__any(rm>(float)THRL),0)){ const float dl=__builtin_fmaxf(rm,0.f); mhat+=dl; \
        _Pragma("unroll") for(int r=0;r<16;++r){C0[r]-=dl;C1[r]-=dl;} \
        negmh=-mhat; \
        const float f=__builtin_amdgcn_exp2f(-dl); l_reg*=f; if(hi==0)wsf[r32]=f; resc=true; } } \
    SBAR(); \
    GAPB(o[0]=__builtin_amdgcn_mfma_f32_32x32x16_bf16(PAF(0),VFR(0),o[0],0,0,0), C0,0); \
    GAPB(o[1]=__builtin_amdgcn_mfma_f32_32x32x16_bf16(PAF(0),VFR(4),o[1],0,0,0), C0,4); \
    KRD(GL,0); GAPB(o[0]=__builtin_amdgcn_mfma_f32_32x32x16_bf16(PAF(1),VFR(1),o[0],0,0,0), C0,8); \
    KRD(GL,1); GAPB(o[1]=__builtin_amdgcn_mfma_f32_32x32x16_bf16(PAF(1),VFR(5),o[1],0,0,0), C0,12); \
    KRD(GL,2); GAPB(o[0]=__builtin_amdgcn_mfma_f32_32x32x16_bf16(PAF(2),VFR(2),o[0],0,0,0), C1,0); \
    KRD(GL,3); GAPB(o[1]=__builtin_amdgcn_mfma_f32_32x32x16_bf16(PAF(2),VFR(6),o[1],0,0,0), C1,4); \
    GAPB(o[0]=__builtin_amdgcn_mfma_f32_32x32x16_bf16(PAF(3),VFR(3),o[0],0,0,0), C1,8); \
    GAPB(o[1]=__builtin_amdgcn_mfma_f32_32x32x16_bf16(PAF(3),VFR(7),o[1],0,0,0), C1,12); \
    }while(0)
  int t=1;
  for(;t+5<NT;t+=2){
    STEP(pB0,pB1,pA0,pA1,t,true,true,true);     WAIT_BAR(2); RESC(); ROT();
    STEP(pA0,pA1,pB0,pB1,t+1,true,true,true);   WAIT_BAR(2); RESC(); ROT();
  }
  #define ENDW(tt) do{ if((tt)+3<NT){WAIT_BAR(2);} else if((tt)+2<NT){WAIT_BAR(1);} else {WAIT_BAR(0);} }while(0)
  for(;t+1<NT;t+=2){
    STEP(pB0,pB1,pA0,pA1,t,(t+3<NT),(t+1<NT),(t+1<NT));       ENDW(t);   RESC(); ROT();
    STEP(pA0,pA1,pB0,pB1,t+1,(t+4<NT),(t+2<NT),(t+2<NT));     ENDW(t+1); RESC(); ROT();
  }
  STEP(pB0,pB1,pA0,pA1,NT-1,false,false,false); RESC();
  { float sacc=pB0[0]+pB0[1]; _Pragma("unroll") for(int r=2;r<16;++r)sacc+=pB0[r]; _Pragma("unroll") for(int r=0;r<16;++r)sacc+=pB1[r]; l_reg+=sacc;
    pw0=(u32x4){PKW(pB0,0),PKW(pB0,2),PKW(pB0,4),PKW(pB0,6)};pw1=(u32x4){PKW(pB0,8),PKW(pB0,10),PKW(pB0,12),PKW(pB0,14)};pw2=(u32x4){PKW(pB1,0),PKW(pB1,2),PKW(pB1,4),PKW(pB1,6)};pw3=(u32x4){PKW(pB1,8),PKW(pB1,10),PKW(pB1,12),PKW(pB1,14)};
    SBAR(); pv(o,vb0+sl_cur,PAF(0),PAF(1),PAF(2),PAF(3)); }
  #undef PKW
  #undef PAF
  #undef VFR
  #undef PIN
  #undef MX3
  #undef GAPA
  #undef GAPB
  #undef EX
  #undef VRD
  #undef KRD
  #undef STEP
  #undef ENDW
  {auto rr=__builtin_amdgcn_permlane32_swap(__float_as_uint(l_reg),__float_as_uint(l_reg),false,false);l_reg=__uint_as_float(rr[0])+__uint_as_float(rr[1]);}
  if(hi==0)wsf[32+r32]=l_reg;asm volatile("s_waitcnt lgkmcnt(0)":::"memory");
  float rli[16];
  #pragma unroll
  for(int r=0;r<16;++r)rli[r]=__builtin_amdgcn_rcpf(wsf[32+crow(r,hi)]);
  bf16*Ow=O+(rowbase+q0+wid*QBLK)*DM+h*D;
  { bf16*stg=(bf16*)(shm+LDS_OST)+wid*2048;
    #pragma unroll
    for(int r=0;r<16;++r){const int orow=crow(r,hi);
      #pragma unroll
      for(int d0=0;d0<2;++d0)stg[orow*64+d0*32+r32]=__float2bfloat16(o[d0][r]*rli[r]);}
    asm volatile("s_waitcnt lgkmcnt(0)":::"memory");
    #pragma unroll
    for(int i=0;i<4;++i){const int row=i*8+(lane>>3),ch=lane&7; const u32x4 v=*(const u32x4*)(stg+row*64+ch*8); ATTN_STORE16(Ow+(long)row*DM+ch*8,v);} }
  asm volatile("s_waitcnt lgkmcnt(0)\n\ts_barrier":::"memory");
  #undef DMA_K
  #undef DMA_V
  #undef RESC
  #undef ROT
}
constexpr int ATTN_LDS_BYTES=LDS_BYTES;
struct AttnTensors { const bf16* Q; const bf16* K; const bf16* V; bf16* O; const unsigned long long* MASK; };
struct AttnUnit { int bh; int qb; };
struct StaticOrder {
  int vcu,G;
  __device__ __forceinline__ explicit StaticOrder(int grid,int block):vcu((grid%8==0)?(block%8)*(grid/8)+block/8:block),G(grid){}
  __device__ __forceinline__ bool next(int i,AttnUnit&u)const{ const int idx=vcu+i*G; if(idx>=512)return false; const int j=idx&255,s=j&15; u.bh=j>>4; u.qb=(idx<256)?s:31-s; return true; }
  __device__ __forceinline__ void a_ready(const AttnUnit&)const{}
  __device__ __forceinline__ void done(const AttnUnit&)const{}
};
template<class Sched,int THRL=8> __device__ __forceinline__ void attn_phase(char*lds,const AttnTensors&T,const Sched&S,const int wv){
  AttnUnit u;
  for(int i=0;S.next(i,u);++i){ S.a_ready(u); attn_unit<THRL>(u.bh/NHEAD,u.bh%NHEAD,u.qb,T.Q,T.K,T.V,T.O,T.MASK,lds,wv); S.done(u); }
}
#undef SBAR
#undef WAIT_BAR
}
constexpr int NWAVES = 8;
#ifndef MK_PER_PHASE
#define MK_PER_PHASE 0
#endif
constexpr int NPH = 18;

constexpr int BATCH = 2, T = 8192, D = 1024, M = BATCH * T;
constexpr int INW = 4392, INP = 4608;
constexpr int FF = 2816, FFE = 3584, NE = 8;
constexpr int TOPK = 256;
constexpr int MROWS = 34816;
constexpr float EPS = 1e-6f;

constexpr size_t MiB = 1u << 20;
constexpr size_t WS_CTL = 0, CTL_ZERO_BYTES = 1 * MiB;
constexpr size_t WS_TAB16 = 1 * MiB, WS_TAB8 = 1 * MiB + 512 * 1024;
constexpr size_t WS_GAINS = 1 * MiB + 768 * 1024;
constexpr size_t WS_SSQP = 2 * MiB;
constexpr size_t WS_ROUTE = 3 * MiB, WS_POS = 3 * MiB + 256 * 1024;
constexpr size_t WS_GCNT = 3 * MiB + 512 * 1024;
constexpr size_t WS_META = 4 * MiB;
constexpr size_t WS_WIN = 6 * MiB, WS_PA = 24 * MiB, WS_WEFF = 26 * MiB, WS_WOUT = 28 * MiB, WS_W13 = 32 * MiB, WS_W2 = 43 * MiB;
constexpr size_t WS_XB = 52 * MiB;
constexpr size_t WS_U = 84 * MiB, WS_SG = 100 * MiB;
constexpr size_t WS_HB = 84 * MiB;
constexpr size_t WS_Q = 228 * MiB, WS_K = 244 * MiB, WS_V = 260 * MiB, WS_QI = 276 * MiB  , WS_KI = 285 * MiB, WS_WI = 286 * MiB, WS_DIFF = 287 * MiB;
constexpr size_t WS_MASK = 303 * MiB;
constexpr size_t WS_T1 = 335 * MiB, WS_MB = 367 * MiB;
constexpr size_t WS_X8 = WS_T1;
constexpr size_t WS_AO = 399 * MiB;
constexpr size_t WS_SLAB = 84 * MiB;
constexpr size_t DO_W2E = 0, DO_W13E = 28 * MiB;
constexpr int W13E_SPLIT = 5;
constexpr size_t WS_W13E = 84 * MiB, WS_W2E = 140 * MiB, WS_AP = 174 * MiB, WS_Y = 208 * MiB, WS_HE = 280 * MiB, WS_END = 480 * MiB;
static_assert(WS_XB + (size_t)M * D * 2 <= WS_W13E && WS_SLAB + (size_t)32 * 7 * 65536 * 4 <= WS_W2E && WS_W13E + (size_t)NE * 2 * FFE * D <= WS_W2E && WS_W2E + (size_t)NE * D * FFE <= WS_AP && WS_AP + (size_t)MROWS * D <= WS_Y && WS_Y + (size_t)MROWS * D * 2 <= WS_HE && WS_HE + (size_t)MROWS * FFE <= WS_END, "MoE map");
static_assert(WS_SG + (size_t)M * 2048 * 2 <= WS_Q && WS_MB + (size_t)M * D * 2 <= WS_END && WS_W2 + (size_t)D * FF * 2 <= WS_XB && WS_HB + (size_t)M * FF * 2 <= WS_Q, "layer map");
constexpr int CW_BAR = 4096;
constexpr int CW_CNT = 16384;
constexpr int CW_CUR = 16384 + 64 * 8;
constexpr int CW_WQ = 16384 + 64 * 16;

constexpr int RING_OFF = 0, RING_BYTES = 131072;
constexpr int LDSCTL_OFF = 151808, MISC_OFF = LDSCTL_OFF + 320;
constexpr int SEL_OFF = 152576;
constexpr int LDS_BYTES = 163840;
static_assert(MISC_OFF + 128 <= SEL_OFF && SEL_OFF + 4096 <= LDS_BYTES, "LDS map");

#define GAS __attribute__((address_space(1)))
#define LAS __attribute__((address_space(3)))
typedef unsigned short bf16;
typedef unsigned v4u __attribute__((ext_vector_type(4)));
typedef float f32x4 __attribute__((ext_vector_type(4)));
typedef short bf16x8 __attribute__((ext_vector_type(8)));
typedef GAS unsigned gu32;
typedef GAS unsigned long long gu64;
#define RLX_AGENT __ATOMIC_RELAXED, __HIP_MEMORY_SCOPE_AGENT
#define LDS_WAIT() asm volatile("s_waitcnt lgkmcnt(0)" ::: "memory")
#define VM_WAIT() asm volatile("s_waitcnt vmcnt(0)" ::: "memory")
__device__ __forceinline__ unsigned long long rt() { return __builtin_amdgcn_s_memrealtime(); }
__device__ __forceinline__ unsigned f2bf(float f) { unsigned u = __builtin_bit_cast(unsigned, f); return (u + 0x7fffu + ((u >> 16) & 1u)) >> 16; }
__device__ __forceinline__ unsigned pk2(float lo, float hi) { return pg8::cvt_pk_bf16(lo, hi); }

#define XB_TMO      128
#define XB_XCNT(j)  (256  + 64 * (j))
#define XB_XSUB(j)  (1280 + 64 * (j))
#define XB_XGEN(j)  (2304 + 64 * (j))
#define XB_TOP      3328
#define XB_TOPGEN   3392
#define XCD_BAR_WORDS 3456
#define XB_SPIN_CAP (1u << 18)

__device__ __forceinline__ unsigned xb_ld(unsigned* p)              { return __hip_atomic_load(p, __ATOMIC_RELAXED, __HIP_MEMORY_SCOPE_AGENT); }
__device__ __forceinline__ unsigned xb_add(unsigned* p, unsigned v) { return __hip_atomic_fetch_add(p, v, __ATOMIC_RELAXED, __HIP_MEMORY_SCOPE_AGENT); }
__device__ __forceinline__ unsigned xb_xcc_id() { return (unsigned)__builtin_amdgcn_s_getreg((3 << 11) | 20) & 0xFu; }
#define XB_SPIN(cond, bar) do { unsigned _sp = 0; while (cond) { __builtin_amdgcn_s_sleep(1); \
    if ((++_sp & 255u) == 0u) { if (xb_ld(&(bar)[XB_TMO])) break; if (_sp > XB_SPIN_CAP) { atomicAdd(&(bar)[XB_TMO], 1u); break; } } } } while (0)

struct XcdBarrier {
    unsigned* bar; unsigned x; int wv;
    volatile LAS unsigned* st;
};

__device__ __forceinline__ XcdBarrier xcd_barrier_post(unsigned* bar, volatile LAS unsigned* st, int wv) {
    XcdBarrier b; b.bar = bar; b.x = xb_xcc_id(); b.st = st; b.wv = wv;
    if (wv == 0 && mk_lane() == 0) (void)xb_add(&bar[XB_XCNT(b.x)], 1u);
    return b;
}
__device__ __forceinline__ void xcd_barrier_complete(unsigned* bar, unsigned x, unsigned& nloc, unsigned& nx) {
    const unsigned G = gridDim.x * gridDim.y * gridDim.z;
    unsigned sum, cnt, mine, sp = 0u;
    for (;;) {
        sum = 0u; cnt = 0u; mine = 0u;
#pragma unroll
        for (unsigned j = 0; j < 16; ++j) { const unsigned c = xb_ld(&bar[XB_XCNT(j)]); sum += c; cnt += (c > 0u) ? 1u : 0u; mine = (j == x) ? c : mine; }
        if (sum == G) break;
        __builtin_amdgcn_s_sleep(1);
        if ((++sp & 255u) == 0u) { if (xb_ld(&bar[XB_TMO])) break; if (sp > XB_SPIN_CAP) { atomicAdd(&bar[XB_TMO], 1u); break; } }
    }
    nloc = mine > 0u ? mine : 1u; nx = cnt > 0u ? cnt : 1u;
}

__device__ __forceinline__ void xcd_barrier(const XcdBarrier& b) {
    asm volatile("s_waitcnt vmcnt(0)" ::: "memory");
    __syncthreads();
    if (b.wv == 0 && mk_lane() == 0) {
        unsigned* bar = b.bar;
        __builtin_amdgcn_s_waitcnt(0);
        unsigned nloc = b.st[0], nx = b.st[1];
        if (nloc == 0u) { xcd_barrier_complete(bar, b.x, nloc, nx); b.st[0] = nloc; b.st[1] = nx; }
        const unsigned old = xb_add(&bar[XB_XSUB(b.x)], 1u);
        const unsigned gen = old / nloc;
        if (old + 1u == (gen + 1u) * nloc) {
            __builtin_amdgcn_fence(__ATOMIC_RELEASE, "agent");
            asm volatile("s_waitcnt vmcnt(0)" ::: "memory");
            const unsigned og = xb_add(&bar[XB_TOP], 1u);
            const unsigned tg = og / nx;
            if (og + 1u == (tg + 1u) * nx) xb_add(&bar[XB_TOPGEN], 1u);
            else XB_SPIN(xb_ld(&bar[XB_TOPGEN]) == tg, bar);
            __builtin_amdgcn_fence(__ATOMIC_ACQUIRE, "agent");
            xb_add(&bar[XB_XGEN(b.x)], 1u);
            asm volatile("s_waitcnt vmcnt(0)" ::: "memory");
        } else {
            XB_SPIN(xb_ld(&bar[XB_XGEN(b.x)]) == gen, bar);
            __builtin_amdgcn_fence(__ATOMIC_ACQUIRE, "agent");
            asm volatile("s_waitcnt vmcnt(0)" ::: "memory");
        }
    }
    __syncthreads();
}

namespace pg8 {
struct EpiInProj {
    static constexpr bool PERM = true, AFTER_DRAIN = false;
    unsigned char* ws; const float* gains; float c2;
    __device__ __forceinline__ void operator()(const f32x4 (&acc)[2][2][4][2], const Unit& u, int wr, int wc, int fr, int fq) const {
        const int row0 = u.pm * BM + wr * 64 + fr, pn = u.pn; const float* ssqp = (const float*)(ws + WS_SSQP);
        float rsv[8];
#pragma unroll
        for (int k = 0; k < 8; ++k) rsv[k] = 0.f;
        rstd8(ssqp, row0, fr, fq, rsv, 1.f);
        if (pn < 4) {
            const bool isq = pn < 2; const int head = 4 * (pn & 1) + wc; const float* g = gains + (isq ? 0 : 64); const f32x2* t16 = (const f32x2*)(ws + WS_TAB16);
            const int db0 = fq == 0 ? 0 : 8 * fq + 8, db1 = fq == 0 ? 8 : 8 * fq + 32;
            const f32x4 g00 = *(const f32x4*)(g + db0), g01 = *(const f32x4*)(g + db0 + 4), g10 = *(const f32x4*)(g + db1), g11 = *(const f32x4*)(g + db1 + 4);
            bf16_t* dst = (bf16_t*)(ws + (isq ? WS_Q : WS_K)) + head * 64; const float sc = isq ? c2 : 1.f;
#pragma unroll
            for (int ai = 0; ai < 2; ++ai)
#pragma unroll
                for (int m = 0; m < 4; ++m) { const int row = row0 + ai * HALF + m * 16; const float rs = rsv[ai * 4 + m];
                    f32x4 a0 = acc[ai][0][m][0] * rs, a1 = acc[ai][0][m][1] * rs, b0 = acc[ai][1][m][0] * rs, b1 = acc[ai][1][m][1] * rs;
                    float ss = ((a0[0] * a0[0] + a0[1] * a0[1]) + (a0[2] * a0[2] + a0[3] * a0[3])) + ((a1[0] * a1[0] + a1[1] * a1[1]) + (a1[2] * a1[2] + a1[3] * a1[3]))
                             + ((b0[0] * b0[0] + b0[1] * b0[1]) + (b0[2] * b0[2] + b0[3] * b0[3])) + ((b1[0] * b1[0] + b1[1] * b1[1]) + (b1[2] * b1[2] + b1[3] * b1[3]));
                    ss += __shfl_xor(ss, 16); ss += __shfl_xor(ss, 32);
                    const float rn = __builtin_amdgcn_rsqf(ss * (1.f / 64.f) + 1e-6f);
                    a0 = a0 * rn * g00; a1 = a1 * rn * g01; b0 = b0 * rn * g10; b1 = b1 * rn * g11;
                    if (fq == 0) { const f32x2* cs = t16 + (size_t)(row & 8191) * 8;
#pragma unroll
                        for (int j = 0; j < 4; ++j) { const f32x2 c0 = cs[j], c1 = cs[4 + j]; const float x1 = a0[j], x2 = b0[j], y1 = a1[j], y2 = b1[j];
                            a0[j] = x1 * c0.x - x2 * c0.y; b0[j] = x2 * c0.x + x1 * c0.y; a1[j] = y1 * c1.x - y2 * c1.y; b1[j] = y2 * c1.x + y1 * c1.y; } }
                    *(u32x4*)(dst + (size_t)row * 512 + db0) = pack8(a0 * sc, a1 * sc); *(u32x4*)(dst + (size_t)row * 512 + db1) = pack8(b0 * sc, b1 * sc); }
        } else if (pn == 6 || pn == 7) {
            const int col8 = wc * 32 + 8 * fq; const f32x2* t8 = (const f32x2*)(ws + WS_TAB8); bf16_t* QI = (bf16_t*)(ws + WS_QI); bf16_t* KI = (bf16_t*)(ws + WS_KI); float* WI = (float*)(ws + WS_WI);
#pragma unroll
            for (int ai = 0; ai < 2; ++ai)
#pragma unroll
                for (int m = 0; m < 4; ++m) { const int row = row0 + ai * HALF + m * 16; const float rs = rsv[ai * 4 + m]; const f32x2* cs = t8 + (size_t)(row & 8191) * 4;
#pragma unroll
                    for (int bj = 0; bj < 2; ++bj) { f32x4 a0 = acc[ai][bj][m][0] * rs, a1 = acc[ai][bj][m][1] * rs;
                        if (pn == 6 || (bj == 0 && wc == 0)) {
                            if (fq == 0) {
#pragma unroll
                                for (int j = 0; j < 4; ++j) { const f32x2 c = cs[j]; const float x1 = a0[j], x2 = a1[j]; a0[j] = x1 * c.x - x2 * c.y; a1[j] = x2 * c.x + x1 * c.y; } }
                            if (pn == 6) *(u32x4*)(QI + (size_t)row * 288 + bj * HALF + col8) = pack8(a0, a1); else *(u32x4*)(KI + (size_t)row * 32 + 8 * fq) = pack8(a0, a1); }
                        else if (bj == 0 && wc == 1 && fq == 0) { *(f32x4*)(WI + (size_t)row * 8) = a0 * 0.03125f; *(f32x4*)(WI + (size_t)row * 8 + 4) = a1 * 0.03125f; } } }
        } else {
            const bool sg = pn >= 10; const int ld = sg ? 2048 : 512, colt = (pn < 6 ? pn - 4 : pn < 10 ? pn - 8 : pn - 10) * BM;
            bf16_t* dst = (bf16_t*)(ws + (pn < 6 ? WS_V : pn < 10 ? WS_U : WS_SG));
            const int col0 = colt + wc * 32 + 8 * fq;
#pragma unroll
            for (int ai = 0; ai < 2; ++ai)
#pragma unroll
                for (int m = 0; m < 4; ++m) { const int row = row0 + ai * HALF + m * 16; const float rs = rsv[ai * 4 + m];
#pragma unroll
                    for (int bj = 0; bj < 2; ++bj) { f32x4 a0 = acc[ai][bj][m][0] * rs, a1 = acc[ai][bj][m][1] * rs;
                        if (sg) {
#pragma unroll
                            for (int i = 0; i < 4; ++i) { a0[i] = fsigmoid(a0[i]); a1[i] = fsigmoid(a1[i]); } }
                        *(u32x4*)(dst + (size_t)row * ld + col0 + bj * HALF) = pack8(a0, a1); } }
        }
    }
};
}
struct Frame {
    LAS unsigned char* lds;
    volatile LAS unsigned* MISC;
    gu32* ctl;
    int tid, lane, wave;
    int vcu, G;
    unsigned char* ws;
    float* out;
};
__device__ __forceinline__ float wave_sum(float v) {
#pragma unroll
    for (int o = 1; o < 64; o <<= 1) v += __shfl_xor(v, o);
    return v;
}
__device__ __forceinline__ float bfl(unsigned w) { return __uint_as_float(w << 16); }
__device__ __forceinline__ float bfh(unsigned w) { return __uint_as_float(w & 0xffff0000u); }
__device__ __forceinline__ void unpk8(const v4u w, float (&v)[8]) { v[0] = bfl(w.x); v[1] = bfh(w.x); v[2] = bfl(w.y); v[3] = bfh(w.y); v[4] = bfl(w.z); v[5] = bfh(w.z); v[6] = bfl(w.w); v[7] = bfh(w.w); }
__device__ __forceinline__ v4u pk8(const float (&v)[8]) { v4u o; o.x = pk2(v[0], v[1]); o.y = pk2(v[2], v[3]); o.z = pk2(v[4], v[5]); o.w = pk2(v[6], v[7]); return o; }

struct RowMap { int mode, a;
    __device__ __forceinline__ int operator()(int n) const {
        if (mode == 0) return a + n;
        if (mode == 2) return 256 * (n >> 7) + (n & 127) + a;
        if (n >= 1832) return n + 216;
        if (n >= 1024) return n;
        const int h = (n & 511) >> 6, d = n & 63, wc = h & 3, base = (n & ~511) + 256 * (h >> 2);
        return base + (d < 8 ? 32 * wc + d : d < 16 ? 128 + 32 * wc + d - 8 : d < 40 ? 32 * wc + d - 8 : 128 + 32 * wc + d - 32); } };
constexpr float MOE_SX = 8.f, MOE_SW1 = 64.f, MOE_SH = 8.f, MOE_SW2 = 128.f;
struct TrS { const float* W; bf16* WT; const float* gain; float scale; int K, N, k0, n0, f8; RowMap mp; };
__device__ __forceinline__ void tr32_load(const TrS& t, f32x4 (&v)[8], float (&gv)[8], int lane) {
    const int nq = t.n0 + 4 * (lane & 7), kr = lane >> 3; const bool okn = nq < t.N;
    const float* gp = t.gain ? t.gain + t.k0 : t.W; const float gsc = t.f8 ? t.scale : 1.f;
#pragma unroll
    for (int i = 0; i < 8; ++i) { const float gl = gp[8 * i + kr]; gv[i] = (t.gain ? gl : 1.f) * gsc; }
#pragma unroll
    for (int i = 0; i < 8; ++i) v[i] = okn ? __builtin_nontemporal_load((const GAS f32x4*)(t.W + (size_t)(t.k0 + 8 * i + kr) * t.N + nq)) : (f32x4){0.f, 0.f, 0.f, 0.f};
}
__device__ __forceinline__ void tr32_store(const TrS& t, const f32x4 (&v)[8], const float (&gv)[8], LAS float* scr, int lane) {
    const int kr = lane >> 3;
#pragma unroll
    for (int i = 0; i < 8; ++i) { const int kk = 8 * i + kr; const float g = gv[i]; LAS float* d = scr + kk * 33 + 4 * (lane & 7);
        d[0] = v[i].x * g; d[1] = v[i].y * g; d[2] = v[i].z * g; d[3] = v[i].w * g; }
    LDS_WAIT(); asm volatile("" ::: "memory");
    const int c = lane & 7;
#pragma unroll
    for (int j = 0; j < 4; ++j) { const int n = (lane >> 3) + 8 * j;
        if (t.n0 + n < t.N) { const LAS float* s = scr + (8 * c) * 33 + n;
            if (t.f8) { pg8::u32x2 o; o.x = pg8::pk4_fp8((f32x4){s[0 * 33], s[1 * 33], s[2 * 33], s[3 * 33]}); o.y = pg8::pk4_fp8((f32x4){s[4 * 33], s[5 * 33], s[6 * 33], s[7 * 33]});
                *(GAS pg8::u32x2*)((unsigned char*)t.WT + (size_t)t.mp(t.n0 + n) * t.K + t.k0 + 8 * c) = o; }
            else { v4u o; o.x = pk2(s[0 * 33], s[1 * 33]); o.y = pk2(s[2 * 33], s[3 * 33]); o.z = pk2(s[4 * 33], s[5 * 33]); o.w = pk2(s[6 * 33], s[7 * 33]);
                *(GAS v4u*)(t.WT + (size_t)t.mp(t.n0 + n) * t.K + t.k0 + 8 * c) = o; } } }
    LDS_WAIT(); asm volatile("" ::: "memory");
}
struct TrItem { const float* W; unsigned char* WT; const float* gain; float scale; int K, N, k0, n0; RowMap mp; };
__device__ __forceinline__ void tr64_load(const TrItem& t, f32x4 (&v)[16], float (&gv)[16], int lane) {
    const int nq = t.n0 + 4 * (lane & 15), kr = lane >> 4;
    const float* gp = t.gain ? t.gain + t.k0 : t.W;
#pragma unroll
    for (int i = 0; i < 16; ++i) { const float gl = gp[4 * i + kr]; gv[i] = (t.gain ? gl : 1.f) * t.scale; }
#pragma unroll
    for (int i = 0; i < 16; ++i) v[i] = __builtin_nontemporal_load((const GAS f32x4*)(t.W + (size_t)(t.k0 + 4 * i + kr) * t.N + nq));
}
__device__ __forceinline__ void tr64_store(const TrItem& t, const f32x4 (&v)[16], const float (&gv)[16], LAS float* scr, int lane) {
    const int kr = lane >> 4;
#pragma unroll
    for (int i = 0; i < 16; ++i) { const int kk = 4 * i + kr; const float g = gv[i]; LAS float* d = scr + kk * 65 + 4 * (lane & 15);
        d[0] = v[i].x * g; d[1] = v[i].y * g; d[2] = v[i].z * g; d[3] = v[i].w * g; }
    LDS_WAIT(); asm volatile("" ::: "memory");
    const int c = lane & 7;
#pragma unroll
    for (int j = 0; j < 8; ++j) { const int n = (lane >> 3) + 8 * j; const LAS float* s = scr + (8 * c) * 65 + n;
        pg8::u32x2 o; o.x = pg8::pk4_fp8((f32x4){s[0 * 65], s[1 * 65], s[2 * 65], s[3 * 65]}); o.y = pg8::pk4_fp8((f32x4){s[4 * 65], s[5 * 65], s[6 * 65], s[7 * 65]});
        __builtin_nontemporal_store(o, (GAS pg8::u32x2*)(t.WT + (size_t)t.mp(t.n0 + n) * t.K + t.k0 + 8 * c)); }
    LDS_WAIT(); asm volatile("" ::: "memory");
}
__device__ __forceinline__ float inv16(int i) { return i == 0 ? 1.0f : i == 1 ? 0.1939227432012558f : i == 2 ? 0.03760603070259094f : i == 3 ? 0.007292664609849453f : i == 4 ? 0.0014142135623842478f : i == 5 ? 0.00027424818836152554f : i == 6 ? 5.3182957344688475e-05f : 1.0313385246263351e-05f; }
__device__ __forceinline__ float2 cs_of(float ang) {
    const double a = (double)ang, k = __builtin_rint(a * 0.15915494309189535), r = a - k * 6.283185307179586;
    const float rr = (float)(r * 0.15915494309189535);
    return make_float2(__builtin_amdgcn_cosf(rr), __builtin_amdgcn_sinf(rr));
}

__device__ __forceinline__ void p0_prologue(Frame& F, const float* const* in) {
    LAS float* scr = (LAS float*)(F.lds + RING_OFF + F.wave * 16384);
    int lane_ = F.lane; asm volatile("" : "+v"(lane_)); const int gw = F.vcu * NWAVES + F.wave, NGW = F.G * NWAVES, lane = lane_;
    const float* x = in[0];
    constexpr int I_WIN = 16 * 138, I_PA = 8 * 32, I_WO = 16 * 32, I_W1 = 16 * 88, I_W2 = 44 * 32;
    constexpr int I_L = I_WIN + I_PA + I_WO, NIT = 2 * I_L + 2 * I_W1 + I_W2;
    auto item = [&](int it) -> TrS { TrS t; int r = it; t.scale = 1.f; t.f8 = 0; t.gain = nullptr; t.mp = RowMap{0, 0};
        if (r < 2 * I_L) { const int L = r / I_L; r -= L * I_L;
            if (r < I_WIN) { t.W = in[2] + (size_t)L * D * INW; t.K = D; t.N = INW; t.WT = (bf16*)(F.ws + WS_WIN) + (size_t)L * INP * D; t.gain = in[1] + L * D; t.mp = RowMap{1, 0}; }
            else if (r < I_WIN + I_PA) { r -= I_WIN; t.W = in[7] + (size_t)L * 512 * D; t.K = 512; t.N = D; t.WT = (bf16*)(F.ws + WS_PA) + (size_t)L * D * 512; }
            else { r -= I_WIN + I_PA; t.W = in[9] + (size_t)L * D * D; t.K = D; t.N = D; t.WT = (bf16*)(F.ws + WS_WOUT) + (size_t)L * D * D; } }
        else { r -= 2 * I_L; t.f8 = 1;
            if (r < 2 * I_W1) { const bool third = r >= I_W1; if (third) r -= I_W1; t.W = third ? in[12] : in[11]; t.K = D; t.N = FF; t.WT = (bf16*)(F.ws + WS_W13); t.gain = in[10]; t.mp = RowMap{2, third ? 128 : 0}; t.scale = MOE_SW1; }
            else { r -= 2 * I_W1; t.W = in[13]; t.K = FF; t.N = D; t.WT = (bf16*)(F.ws + WS_W2); t.scale = MOE_SW2; } }
        const int nblk = (t.N + 31) / 32; t.k0 = 64 * (r / nblk); t.n0 = 32 * (r % nblk); return t; };
    if (gw < NIT) { int it = gw; TrS a = item(it), b = a; f32x4 v[8], vn[8]; float gv[8], gn[8]; tr32_load(a, v, gv, lane);
        for (;;) {
            { const int nx = it + NGW; const bool more = nx < NIT; if (more) { b = item(nx); tr32_load(b, vn, gn, lane); } tr32_store(a, v, gv, scr, lane); if (!more) break; it = nx; }
            { const int nx = it + NGW; const bool more = nx < NIT; if (more) { a = item(nx); tr32_load(a, v, gv, lane); } tr32_store(b, vn, gn, scr, lane); if (!more) break; it = nx; } } }
    for (int it = gw; it < 2 * 216; it += NGW) { const int L = it / 216, rr = 1832 + it % 216; GAS v4u* o = (GAS v4u*)((bf16*)(F.ws + WS_WIN) + ((size_t)L * INP + rr) * D) + lane; o[0] = (v4u){0u, 0u, 0u, 0u}; o[64] = (v4u){0u, 0u, 0u, 0u}; }
    for (int it = gw; it < 2 * 4 * 16 * 8; it += NGW) {
        const int cc = it & 7, nb = (it >> 3) & 15, g = (it >> 7) & 3, L = it >> 9; const int n = nb * 64 + lane, c0 = cc * 16;
        const float* wp = in[5] + ((size_t)(L * 4 + g) * 128 + c0) * 128; const float* ps = in[6] + L * 512 + g * 128; const float* pb = in[8] + ((size_t)L * 512 + g * 128) * D + n;
        float acc[16];
#pragma unroll
        for (int c = 0; c < 16; ++c) acc[c] = 0.f;
        { const GAS f32x4* wsrc = (const GAS f32x4*)wp + lane; const GAS f32x4* psv = (const GAS f32x4*)ps;
#pragma unroll
          for (int i = 0; i < 8; ++i) { const int idx = i * 64 + lane; *(LAS f32x4*)(scr + 4 * idx) = wsrc[64 * i] * psv[idx & 31]; } }
        LDS_WAIT(); asm volatile("" ::: "memory");
        for (int d0 = 0; d0 < 128; d0 += 32) {
            float v[32];
#pragma unroll
            for (int dd = 0; dd < 32; ++dd) v[dd] = pb[(size_t)(d0 + dd) * D];
#pragma unroll
            for (int c = 0; c < 16; ++c) {
#pragma unroll
                for (int q4 = 0; q4 < 8; ++q4) { const f32x4 a4 = *(const LAS f32x4*)(scr + c * 128 + d0 + 4 * q4);
                    acc[c] += (a4.x * v[4 * q4] + a4.y * v[4 * q4 + 1]) + (a4.z * v[4 * q4 + 2] + a4.w * v[4 * q4 + 3]); } } }
        LDS_WAIT(); asm volatile("" ::: "memory");
        GAS v4u* o = (GAS v4u*)((bf16*)(F.ws + WS_WEFF) + ((size_t)L * D + n) * 512 + g * 128 + c0);
        v4u o0, o1; o0.x = pk2(acc[0], acc[1]); o0.y = pk2(acc[2], acc[3]); o0.z = pk2(acc[4], acc[5]); o0.w = pk2(acc[6], acc[7]); o1.x = pk2(acc[8], acc[9]); o1.y = pk2(acc[10], acc[11]); o1.z = pk2(acc[12], acc[13]); o1.w = pk2(acc[14], acc[15]);
        o[0] = o0; o[1] = o1;
    }
    if (gw == 0) { for (int i = lane; i < 256; i += 64) { const int L = i >> 7, j = i & 127; ((float*)(F.ws + WS_GAINS))[i] = j < 64 ? in[3][L * 64 + j] : in[4][L * 64 + j - 64]; } }
    { float2* t16 = (float2*)(F.ws + WS_TAB16); float2* t8 = (float2*)(F.ws + WS_TAB8);
      for (int i = gw * 64 + lane; i < T * 12; i += NGW * 64) { const int t = i / 12, j = i % 12;
          if (j < 8) t16[t * 8 + j] = cs_of((float)t * inv16(j)); else t8[t * 4 + (j - 8)] = cs_of((float)t * inv16(2 * (j - 8))); } }
    for (int m = gw; m < M; m += 4 * NGW) {
        f32x4 va[4][4]; int mr[4];
#pragma unroll
        for (int k = 0; k < 4; ++k) { mr[k] = m + k * NGW < M ? m + k * NGW : m; const GAS f32x4* xa = (const GAS f32x4*)(x + (size_t)mr[k] * D) + lane;
#pragma unroll
            for (int j = 0; j < 4; ++j) va[k][j] = xa[64 * j]; }
#pragma unroll
        for (int k = 0; k < 4; ++k) { float sa = 0.f;
#pragma unroll
            for (int j = 0; j < 4; ++j) sa += (va[k][j].x * va[k][j].x + va[k][j].y * va[k][j].y) + (va[k][j].z * va[k][j].z + va[k][j].w * va[k][j].w);
            sa = wave_sum(sa);
            GAS unsigned long long* oa = (GAS unsigned long long*)((bf16*)(F.ws + WS_XB) + (size_t)mr[k] * D) + lane;
#pragma unroll
            for (int j = 0; j < 4; ++j) oa[64 * j] = (unsigned long long)pk2(va[k][j].x, va[k][j].y) | ((unsigned long long)pk2(va[k][j].z, va[k][j].w) << 32);
            if (lane < 16) ((float*)(F.ws + WS_SSQP))[(size_t)mr[k] * 16 + lane] = lane == 0 ? sa : 0.f; }
    }
}

__device__ __forceinline__ void diff_rows(Frame& F) {
    int lane_ = F.lane; asm volatile("" : "+v"(lane_)); const int gw = F.vcu * NWAVES + F.wave, NGW = F.G * NWAVES, l = lane_;
    const bf16* U = (const bf16*)(F.ws + WS_U) + 8 * l; const int w = 2 << (l >> 4);
    for (int blk = gw; blk < M / 8; blk += NGW) {
        const int r0 = blk * 8, t0 = r0 & (T - 1);
        v4u pi[16], pc[8], po[8];
#pragma unroll
        for (int j = 1; j <= 16; ++j) { const bool ok = j <= w && t0 >= j; pi[j - 1] = *(const GAS v4u*)(U + (size_t)(ok ? r0 - j : r0) * 512); if (!ok) pi[j - 1] = (v4u){0u, 0u, 0u, 0u}; }
#pragma unroll
        for (int i = 0; i < 8; ++i) { pc[i] = *(const GAS v4u*)(U + (size_t)(r0 + i) * 512); const bool ok = t0 + i >= w; po[i] = *(const GAS v4u*)(U + (size_t)(ok ? r0 + i - w : r0) * 512); if (!ok) po[i] = (v4u){0u, 0u, 0u, 0u}; }
        float S[8];
#pragma unroll
        for (int c = 0; c < 8; ++c) S[c] = 0.f;
#pragma unroll
        for (int j = 0; j < 16; ++j) { float a[8]; unpk8(pi[j], a);
#pragma unroll
            for (int c = 0; c < 8; ++c) S[c] += a[c]; }
#pragma unroll
        for (int i = 0; i < 8; ++i) { float cu[8], ol[8], o[8]; unpk8(pc[i], cu); unpk8(po[i], ol); const int t = t0 + i; const float inv = 1.f / (float)((t + 1) < w ? (t + 1) : w);
#pragma unroll
            for (int c = 0; c < 8; ++c) { S[c] += cu[c] - ol[c]; o[c] = S[c] * inv - cu[c]; }
            *(GAS v4u*)((bf16*)(F.ws + WS_DIFF) + (size_t)(r0 + i) * 512 + 8 * l) = pk8(o); }
    }
}

namespace topk {
typedef float f32x16 __attribute__((ext_vector_type(16)));
constexpr int HROW = 1025;
constexpr int ST_OFF = 32 * HROW * 4;
constexpr int BQ_OFF = ST_OFF + 512, BQ_PITCH = 624;
static_assert(BQ_OFF + 32 * BQ_PITCH <= LDSCTL_OFF && BQ_OFF % 16 == 0, "top-k LDS map");
constexpr int CAND = 1024;
__device__ __forceinline__ unsigned okey(float s) { const unsigned u = __float_as_uint(s); return u ^ ((unsigned)((int)u >> 31) | 0x80000000u); }
__device__ __forceinline__ int crow(int r, int hi) { return (r & 3) + 8 * (r >> 2) + 4 * hi; }
template <int NB, bool PACKED> __device__ __forceinline__ void scan_row(const LAS unsigned* hrow, unsigned k, int lane, LAS unsigned* pref, LAS unsigned* krem, LAS unsigned* nbin, int shift, unsigned add) {
    constexpr int WPL = PACKED ? NB / 128 : NB / 64;
    unsigned wv[WPL], c = 0;
#pragma unroll
    for (int i = 0; i < WPL; ++i) { wv[i] = hrow[lane * WPL + i]; c += PACKED ? (wv[i] & 0xffffu) + (wv[i] >> 16) : wv[i]; }
    unsigned incl = c;
#pragma unroll
    for (int o = 1; o < 64; o <<= 1) { const unsigned tt = __shfl_down(incl, o); if (lane + o < 64) incl += tt; }
    const unsigned above = incl - c;
    if (above < k && k <= incl) {
        unsigned cum = above, bin = 0, kr = 1, nb = 1; bool found = false;
#pragma unroll
        for (int i = WPL - 1; i >= 0; --i) {
            if (PACKED) {
                unsigned h = wv[i] >> 16; if (!found && cum + h >= k) { found = true; bin = (unsigned)(lane * WPL + i) * 2u + 1u; kr = k - cum; nb = h; } cum += h;
                h = wv[i] & 0xffffu;       if (!found && cum + h >= k) { found = true; bin = (unsigned)(lane * WPL + i) * 2u;      kr = k - cum; nb = h; } cum += h;
            } else { const unsigned h = wv[i]; if (!found && cum + h >= k) { found = true; bin = (unsigned)(lane * WPL + i); kr = k - cum; nb = h; } cum += h; } }
        *pref = ((*pref << shift) | bin) + add; *krem = kr; *nbin = nb;
    }
}
#define TOPK_VALID(r) (!DIAG || (((r) & 3) + 8 * ((r) >> 2)) <= lim2_)
#define TOPK_LIM() const int lim2_ = qabs - tile * 64 - 32 * p - 4 * hi
template <bool DIAG, bool ALL> __device__ __forceinline__ void hist_gen(const float (&sv)[16], int p, int tile, int qabs, int hi, LAS unsigned* hrow, unsigned pref, int sh, int bsh, unsigned bmask) { TOPK_LIM();
#pragma unroll
    for (int r = 0; r < 16; ++r) { const unsigned key = okey(sv[r]);
        if (TOPK_VALID(r) && (ALL || (key >> sh) == pref)) {
            if (ALL) { unsigned ad, inc;
                asm("v_bfe_u32 %0, %2, 22, 10\n\tv_bfe_u32 %1, %2, 21, 1\n\tv_lshl_add_u32 %0, %0, 2, %3\n\tv_mad_u32_u24 %1, %1, %4, 1" : "=&v"(ad), "=&v"(inc) : "v"(key), "v"((unsigned)(uintptr_t)hrow), "s"(0xffffu));
                __hip_atomic_fetch_add((LAS unsigned*)(uintptr_t)ad, inc, __ATOMIC_RELAXED, __HIP_MEMORY_SCOPE_WORKGROUP); }
            else { const unsigned bin = (key >> bsh) & bmask; __hip_atomic_fetch_add(hrow + (bin >> 1), 1u << (16 * (bin & 1u)), __ATOMIC_RELAXED, __HIP_MEMORY_SCOPE_WORKGROUP); } } }
}
template <bool DIAG> __device__ __forceinline__ void cand_half(const float (&sv)[16], int p, int tile, int qabs, int hi, LAS unsigned* lrow, LAS unsigned* lc, unsigned pref, int sh) { TOPK_LIM();
    unsigned m = 0u;
#pragma unroll
    for (int r = 0; r < 16; ++r) { if (TOPK_VALID(r) && (okey(sv[r]) >> sh) == pref) m |= 1u << r; }
    if (m) { unsigned at = __hip_atomic_fetch_add(lc, (unsigned)__popc(m), __ATOMIC_RELAXED, __HIP_MEMORY_SCOPE_WORKGROUP);
#pragma unroll
        for (int r = 0; r < 16; ++r) if (m & (1u << r)) { if (at < (unsigned)CAND) lrow[at] = okey(sv[r]); ++at; } }
}
#define TOPK_CMP8(OP) asm volatile(OP " %0, %8, %16\n\t" OP " %1, %9, %16\n\t" OP " %2, %10, %16\n\t" OP " %3, %11, %16\n\t" OP " %4, %12, %16\n\t" OP " %5, %13, %16\n\t" OP " %6, %14, %16\n\t" OP " %7, %15, %16" \
        : "=s"(c[0]), "=s"(c[1]), "=s"(c[2]), "=s"(c[3]), "=s"(c[4]), "=s"(c[5]), "=s"(c[6]), "=s"(c[7]) : "v"(x[0]), "v"(x[1]), "v"(x[2]), "v"(x[3]), "v"(x[4]), "v"(x[5]), "v"(x[6]), "v"(x[7]), "v"(thr))
template <bool DIAG, int FAST> __device__ __forceinline__ void mask_half(const float (&sv)[16], int p, int tile, int qabs, int hi, unsigned thr, unsigned& mlo, unsigned& mhi) { TOPK_LIM();
#pragma unroll
    for (int r0 = 0; r0 < 16; r0 += 8) {
        unsigned x[8]; unsigned long long c[8];
#pragma unroll
        for (int i = 0; i < 8; ++i) { const int r = r0 + i; x[i] = FAST == 1 ? __float_as_uint(sv[r]) : okey(sv[r]);
            if (DIAG) { if (!TOPK_VALID(r)) x[i] = FAST == 1 ? 0x80000000u : 0u; } }
        if (FAST == 1) TOPK_CMP8("v_cmp_ge_i32_e64"); else if (FAST == 2) TOPK_CMP8("v_cmp_gt_u32_e64"); else TOPK_CMP8("v_cmp_ge_u32_e64");
#pragma unroll
        for (int i = 0; i < 8; ++i) { const unsigned lo = (unsigned)c[i], hi2 = (unsigned)(c[i] >> 32);
            if (p == 0) { asm volatile("v_writelane_b32 %0, %1, %2" : "+v"(mlo) : "s"(lo), "i"(r0 + i)); asm volatile("v_writelane_b32 %0, %1, %2" : "+v"(mhi) : "s"(hi2), "i"(r0 + i)); }
            else { asm volatile("v_writelane_b32 %0, %1, %2" : "+v"(mlo) : "s"(lo), "i"(16 + r0 + i)); asm volatile("v_writelane_b32 %0, %1, %2" : "+v"(mhi) : "s"(hi2), "i"(16 + r0 + i)); } }
    }
}
#undef TOPK_CMP8
__device__ __forceinline__ void mask_store(int p, int lane, unsigned long long* mt, unsigned& mlo, unsigned& mhi) { if (p == 1) { if (lane < 32) mt[lane] = ((unsigned long long)mhi << 32) | mlo; mlo = 0u; mhi = 0u; } }
__device__ __forceinline__ unsigned select_row(const LAS unsigned* list, unsigned n, unsigned krem, unsigned pref, int sh, int lane, LAS unsigned* bins) {
    while (sh > 0) {
        const int db = sh < 7 ? sh : 7, nsh = sh - db; const unsigned dm = (1u << db) - 1u;
        bins[2 * lane] = 0u; bins[2 * lane + 1] = 0u;
        asm volatile("s_waitcnt lgkmcnt(0)" ::: "memory");
#pragma unroll
        for (int j = 0; j < 16; ++j) if ((unsigned)(lane + 64 * j) < n) { const unsigned kj = list[lane + 64 * j]; if ((kj >> sh) == pref) __hip_atomic_fetch_add(bins + ((kj >> nsh) & dm), 1u, __ATOMIC_RELAXED, __HIP_MEMORY_SCOPE_WORKGROUP); }
        asm volatile("s_waitcnt lgkmcnt(0)" ::: "memory");
        const unsigned b0 = bins[2 * lane], b1 = bins[2 * lane + 1], c = b0 + b1;
        unsigned incl = c;
#pragma unroll
        for (int o = 1; o < 64; o <<= 1) { const unsigned tt = __shfl_down(incl, o); if (lane + o < 64) incl += tt; }
        const unsigned above = incl - c; const bool mine = above < krem && krem <= incl;
        const unsigned dig = (above + b1 >= krem) ? (unsigned)(2 * lane + 1) : (unsigned)(2 * lane), kr = (above + b1 >= krem) ? krem - above : krem - above - b1;
        const unsigned long long mb = __ballot(mine); const int src = mb ? (int)__builtin_ctzll(mb) : 0;
        pref = (pref << db) | (unsigned)__builtin_amdgcn_readlane((int)dig, src); krem = (unsigned)__builtin_amdgcn_readlane((int)kr, src); sh = nsh;
    }
    return pref;
}
template <bool DIAG> __device__ __forceinline__ void cand_pos_half(const float (&sv)[16], int p, int tile, int qabs, int hi, LAS unsigned* lrow, LAS unsigned* lc, unsigned last) { TOPK_LIM();
    unsigned m = 0u;
#pragma unroll
    for (int r = 0; r < 16; ++r) { if (TOPK_VALID(r) && (last - okey(sv[r])) < 0x200000u) m |= 1u << r; }
    unsigned at = 0u; if (m) at = __hip_atomic_fetch_add(lc, (unsigned)__popc(m), __ATOMIC_RELAXED, __HIP_MEMORY_SCOPE_WORKGROUP);
    const unsigned pb = 8191u - (unsigned)(tile * 64 + 32 * p + 4 * hi);
    while (__any(m != 0u)) {
        const unsigned r = (unsigned)__builtin_ctz(m | 0x10000u);
#define TOPK_SEL(o, b, x, y) float o; { float e0_ = (x), e1_ = (y); asm volatile("" : "+v"(e0_), "+v"(e1_)); o = (r & (b)) ? e1_ : e0_; }
        TOPK_SEL(a0, 1u, sv[0], sv[1]) TOPK_SEL(a1, 1u, sv[2], sv[3]) TOPK_SEL(a2, 1u, sv[4], sv[5]) TOPK_SEL(a3, 1u, sv[6], sv[7]) TOPK_SEL(a4, 1u, sv[8], sv[9]) TOPK_SEL(a5, 1u, sv[10], sv[11]) TOPK_SEL(a6, 1u, sv[12], sv[13]) TOPK_SEL(a7, 1u, sv[14], sv[15])
        TOPK_SEL(b0, 2u, a0, a1) TOPK_SEL(b1, 2u, a2, a3) TOPK_SEL(b2, 2u, a4, a5) TOPK_SEL(b3, 2u, a6, a7)
        TOPK_SEL(c0, 4u, b0, b1) TOPK_SEL(c1, 4u, b2, b3)
        TOPK_SEL(d0, 8u, c0, c1)
#undef TOPK_SEL
        const unsigned key = okey(d0);
        if (m != 0u) { if (at < (unsigned)CAND) lrow[at] = (((key & 0x1fffffu) >> 2) << 13) | (pb - ((r & 3u) + 8u * ((r >> 2) & 3u))); ++at; }
        m &= m - 1u;
    }
}
__device__ __forceinline__ unsigned select_packed(const LAS unsigned* list, unsigned n, unsigned krem, int lane, LAS unsigned* bins) {
    unsigned pref = 0u; int sh = 32;
    while (sh > 0) {
        const int db = sh == 32 ? 5 : (sh < 7 ? sh : 7), nsh = sh - db; const unsigned dm = (1u << db) - 1u;
        bins[2 * lane] = 0u; bins[2 * lane + 1] = 0u;
        asm volatile("s_waitcnt lgkmcnt(0)" ::: "memory");
#pragma unroll
        for (int j = 0; j < 16; ++j) if ((unsigned)(lane + 64 * j) < n) { const unsigned kj = list[lane + 64 * j]; if (sh == 32 || (kj >> sh) == pref) __hip_atomic_fetch_add(bins + ((kj >> nsh) & dm), 1u, __ATOMIC_RELAXED, __HIP_MEMORY_SCOPE_WORKGROUP); }
        asm volatile("s_waitcnt lgkmcnt(0)" ::: "memory");
        const unsigned b0 = bins[2 * lane], b1 = bins[2 * lane + 1], c = b0 + b1;
        unsigned incl = c;
#pragma unroll
        for (int o = 1; o < 64; o <<= 1) { const unsigned tt = __shfl_down(incl, o); if (lane + o < 64) incl += tt; }
        const unsigned above = incl - c; const bool mine = above < krem && krem <= incl; const bool odd = above + b1 >= krem;
        const unsigned dig = odd ? (unsigned)(2 * lane + 1) : (unsigned)(2 * lane), kr = odd ? krem - above : krem - above - b1, nb = odd ? b1 : b0;
        const unsigned long long mb = __ballot(mine); const int src = mb ? (int)__builtin_ctzll(mb) : 0;
        pref = (pref << db) | (unsigned)__builtin_amdgcn_readlane((int)dig, src); krem = (unsigned)__builtin_amdgcn_readlane((int)kr, src); sh = nsh;
        if ((unsigned)__builtin_amdgcn_readlane((int)nb, src) == krem) break;
    }
    return sh > 0 ? pref << sh : pref;
}
}
#undef TOPK_VALID
#undef TOPK_LIM
__device__ __forceinline__ void topk_phase(Frame& F, int L) {
    using namespace topk;
    int tid_ = F.tid; asm volatile("" : "+v"(tid_)); const int tid = tid_, lane = tid & 63, r32 = lane & 31, hi = lane >> 5, wid = F.wave;
    LAS unsigned* hist = (LAS unsigned*)(F.lds + RING_OFF);
    LAS unsigned* pref = (LAS unsigned*)(F.lds + RING_OFF + ST_OFF); LAS unsigned* krem = pref + 32; LAS unsigned* nbin = pref + 64; LAS unsigned* lcnt = pref + 96;
    const bf16* QI = (const bf16*)(F.ws + WS_QI); const bf16* KI = (const bf16*)(F.ws + WS_KI); const float* WI = (const float*)(F.ws + WS_WI);
    unsigned long long* MASK = (unsigned long long*)(F.ws + WS_MASK + (size_t)L * 16 * MiB);
    for (int ui = F.vcu; ui < 512; ui += F.G) {
        const int jj = ui & 255, b = jj >> 7, j32 = ui < 256 ? (jj & 127) : 255 - (jj & 127);
        const int q0 = j32 * 32, ntile = (j32 >> 1) + 1, qabs = q0 + r32; const size_t brow = (size_t)b * T;
        for (int i = tid; i < 32 * 34; i += NWAVES * 64) { const int rw = i / 34, ch = i % 34;
            *(LAS v4u*)(F.lds + RING_OFF + BQ_OFF + rw * BQ_PITCH + (ch < 32 ? ch * 16 : 576 + (ch - 32) * 16)) = ch < 32 ? *(const v4u*)(QI + (brow + q0 + rw) * 288 + ch * 8) : *(const v4u*)(WI + (brow + q0 + rw) * 8 + (ch - 32) * 4); }
        __syncthreads();
        for (int i = tid; i < 32 * 16; i += NWAVES * 64) { const int rw = i >> 4, dp = i & 15; const LAS unsigned char* rb = F.lds + RING_OFF + BQ_OFF + rw * BQ_PITCH;
            float s0 = 0.f, s1 = 0.f;
#pragma unroll
            for (int h = 0; h < 8; ++h) { const unsigned qq = *(const LAS unsigned*)(rb + 64 * h + 4 * dp); const float wv_ = *(const LAS float*)(rb + 576 + 4 * h); s0 += bfl(qq) * wv_; s1 += bfh(qq) * wv_; }
            *(LAS unsigned*)(rb + 512 + 4 * dp) = pk2(s0, s1); }
        const LAS unsigned char* bqp = F.lds + RING_OFF + BQ_OFF + r32 * BQ_PITCH + hi * 16;
#define TOPK_BQ(h, ks) (*(const LAS pg8::bf16x8*)(bqp + 64 * (h) + 32 * (ks)))
        if (tid < 32) { pref[tid] = 0u; krem[tid] = (unsigned)((q0 + tid + 1) < TOPK ? (q0 + tid + 1) : TOPK); nbin[tid] = 0xffffffffu; lcnt[tid] = 0u; }
        LAS unsigned* hrow = hist + r32 * HROW; LAS unsigned* lrow = hist + r32 * CAND;
#define TOPK_MF(A, B, C) __builtin_amdgcn_mfma_f32_32x32x16_bf16(A, B, C, 0, 0, 0)
#define TOPK_KP(tl) (KI + (brow + (size_t)(tl) * 64 + r32) * 32 + hi * 8)
        const unsigned bqa = (unsigned)(uintptr_t)bqp, wqa = bqa - (unsigned)hi * 16u + 576u;
#define TOPK_LDB(B0, B1, h) do { asm volatile("ds_read_b128 %0, %2 offset:%3\n\tds_read_b128 %1, %2 offset:%4" : "=&v"(B0), "=&v"(B1) : "v"(bqa), "i"(64 * (h)), "i"(64 * (h) + 32)); } while (0)
#define TOPK_LDW(W, h) do { asm volatile("ds_read_b32 %0, %1 offset:%2" : "=&v"(W) : "v"(wqa), "i"(4 * (h))); } while (0)
#define TOPK_LWAIT(B0, B1) asm volatile("s_waitcnt lgkmcnt(0)" : "+v"(B0), "+v"(B1))
#define TOPK_SCORES() \
        float sA[16], sB[16]; { pg8::bf16x8 bl0, bl1, bb0[2], bb1[2]; float wv[2]; TOPK_LDB(bl0, bl1, 8); TOPK_LDB(bb0[0], bb1[0], 0); TOPK_LDB(bb0[1], bb1[1], 1); TOPK_LDW(wv[0], 0); TOPK_LDW(wv[1], 1); \
            TOPK_LWAIT(bl0, bl1); TOPK_LWAIT(bb0[0], bb1[0]); \
            f32x16 l0 = TOPK_MF(a00, bl0, f32x16{}), l1 = TOPK_MF(a10, bl0, f32x16{}); l0 = TOPK_MF(a01, bl1, l0); l1 = TOPK_MF(a11, bl1, l1); \
            f32x16 dA = TOPK_MF(a00, bb0[0], f32x16{}), dB = TOPK_MF(a10, bb0[0], f32x16{}); dA = TOPK_MF(a01, bb1[0], dA); dB = TOPK_MF(a11, bb1[0], dB); \
            asm volatile("s_nop 15" : "+v"(l0), "+v"(l1), "+v"(dA), "+v"(dB));     \
            _Pragma("unroll") for (int r = 0; r < 16; ++r) { sA[r] = l0[r]; sB[r] = l1[r]; } \
            _Pragma("unroll") for (int h = 0; h < 8; ++h) { f32x16 dn = f32x16{}; \
                if (h < 7) { TOPK_LWAIT(bb0[(h + 1) & 1], bb1[(h + 1) & 1]); dn = TOPK_MF(a00, bb0[(h + 1) & 1], f32x16{}); asm volatile("" : "+v"(dn)); }     \
                _Pragma("unroll") for (int r = 0; r < 8; ++r) asm volatile("v_fma_f32 %0, |%1|, %2, %0" : "+v"(sA[r]) : "v"(dA[r]), "v"(wv[h & 1])); \
                if (h < 7) { dn = TOPK_MF(a01, bb1[(h + 1) & 1], dn); asm volatile("" : "+v"(dn)); } \
                _Pragma("unroll") for (int r = 8; r < 16; ++r) asm volatile("v_fma_f32 %0, |%1|, %2, %0" : "+v"(sA[r]) : "v"(dA[r]), "v"(wv[h & 1])); \
                asm volatile("" : "+v"(a00), "+v"(a01));     \
                dA = dn; \
                if (h < 7) { dn = TOPK_MF(a10, bb0[(h + 1) & 1], f32x16{}); asm volatile("" : "+v"(dn)); } \
                _Pragma("unroll") for (int r = 0; r < 8; ++r) asm volatile("v_fma_f32 %0, |%1|, %2, %0" : "+v"(sB[r]) : "v"(dB[r]), "v"(wv[h & 1])); \
                if (h < 7) { dn = TOPK_MF(a11, bb1[(h + 1) & 1], dn); asm volatile("" : "+v"(dn)); \
                    if (h < 6) TOPK_LDB(bb0[h & 1], bb1[h & 1], (h + 2) & 7); }     \
                _Pragma("unroll") for (int r = 8; r < 16; ++r) asm volatile("v_fma_f32 %0, |%1|, %2, %0" : "+v"(sB[r]) : "v"(dB[r]), "v"(wv[h & 1])); \
                asm volatile("" : "+v"(a10), "+v"(a11)); \
                dB = dn; if (h < 6) TOPK_LDW(wv[h & 1], (h + 2) & 7); } }
#define TOPK_LOOP(BODY_N, BODY_D) do { int tile = wid; if (tile < ntile) { const bf16* kp_ = TOPK_KP(tile); \
            pg8::bf16x8 a00 = *(const pg8::bf16x8*)kp_, a01 = *(const pg8::bf16x8*)(kp_ + 16), a10 = *(const pg8::bf16x8*)(kp_ + 1024), a11 = *(const pg8::bf16x8*)(kp_ + 1024 + 16); \
            for (;;) { const bool more = tile + NWAVES < ntile; \
                TOPK_SCORES(); \
                if (more) { const bf16* kn_ = TOPK_KP(tile + NWAVES); a00 = *(const pg8::bf16x8*)kn_; a01 = *(const pg8::bf16x8*)(kn_ + 16); a10 = *(const pg8::bf16x8*)(kn_ + 1024); a11 = *(const pg8::bf16x8*)(kn_ + 1024 + 16); }     \
                if (tile == ntile - 1) { { const float (&sv)[16] = sA; const int p = 0; BODY_D; } { const float (&sv)[16] = sB; const int p = 1; BODY_D; } } \
                else { { const float (&sv)[16] = sA; const int p = 0; BODY_N; } { const float (&sv)[16] = sB; const int p = 1; BODY_N; } } \
                if (!more) break; tile += NWAVES; } } } while (0)
#define TOPK_ZERO() do { for (int i = tid; i < 32 * HROW; i += NWAVES * 64) hist[i] = 0u; } while (0)
#define TOPK_SCAN(NB, PACKED, SHIFT, ADD) do { for (int rr = 0; rr < 4; ++rr) { const int row = wid * 4 + rr; scan_row<NB, PACKED>(hist + row * HROW, krem[row], lane, pref + row, krem + row, nbin + row, SHIFT, ADD); } } while (0)
        int sh = 21;
        bool fused = false;
        unsigned long long* mq = MASK + ((size_t)(b * 256 + j32) * 128) * 32; const int nt_att = 4 * (j32 >> 3) + 4;
#define TOPK_MSTORE() mask_store(p, lane, mq + (size_t)tile * 32, mlo, mhi)
        {
        TOPK_ZERO(); __syncthreads();
        TOPK_LOOP((hist_gen<false, true>(sv, p, tile, qabs, hi, hrow, 0u, 0, 21, 2047u)), (hist_gen<true, true>(sv, p, tile, qabs, hi, hrow, 0u, 0, 21, 2047u)));
        __syncthreads();
        TOPK_SCAN(2048, true, 11, 0u);
        __syncthreads();
        bool big = __any(nbin[r32] > (unsigned)CAND);
        fused = !big;
        if (big) {
            TOPK_ZERO(); __syncthreads();
            { const unsigned pf = pref[r32]; TOPK_LOOP((hist_gen<false, false>(sv, p, tile, qabs, hi, hrow, pf, 21, 10, 2047u)), (hist_gen<true, false>(sv, p, tile, qabs, hi, hrow, pf, 21, 10, 2047u))); }
            __syncthreads();
            TOPK_SCAN(2048, true, 11, 0u);
            __syncthreads();
            sh = 10; big = __any(nbin[r32] > (unsigned)CAND);
            if (big) {
                TOPK_ZERO(); __syncthreads();
                { const unsigned pf = pref[r32]; TOPK_LOOP((hist_gen<false, false>(sv, p, tile, qabs, hi, hrow, pf, 10, 0, 1023u)), (hist_gen<true, false>(sv, p, tile, qabs, hi, hrow, pf, 10, 0, 1023u))); }
                __syncthreads();
                TOPK_SCAN(1024, true, 10, 0u);
                __syncthreads();
                sh = 0;
            }
        }
        }
        if (fused) {
            { const unsigned tb = (pref[r32] << 21) | 0x1fffffu; LAS unsigned* lc = lcnt + r32; unsigned mlo = 0u, mhi = 0u;
              TOPK_LOOP((cand_pos_half<false>(sv, p, tile, qabs, hi, lrow, lc, tb), mask_half<false, 2>(sv, p, tile, qabs, hi, tb, mlo, mhi), TOPK_MSTORE()),
                        (cand_pos_half<true>(sv, p, tile, qabs, hi, lrow, lc, tb), mask_half<true, 2>(sv, p, tile, qabs, hi, tb, mlo, mhi), TOPK_MSTORE())); }
            __syncthreads();
            for (int rr = 0; rr < 4; ++rr) { const int row = wid * 4 + rr; const unsigned n = lcnt[row] < (unsigned)CAND ? lcnt[row] : (unsigned)CAND; const LAS unsigned* lst = hist + row * CAND;
                const unsigned thr = select_packed(lst, n, krem[row], lane, (LAS unsigned*)(F.lds + SEL_OFF) + wid * 128);
                for (int j = 0; j < 16; ++j) { const unsigned idx = (unsigned)(lane + 64 * j); if (idx < n) { const unsigned e = lst[idx];
                    if (e >= thr) { const unsigned pos = 8191u - (e & 8191u), c = pos & 31u, wd = (pos >> 6) * 32u + ((pos >> 5) & 1u) * 16u + (c & 3u) + 4u * (c >> 3);
                        __hip_atomic_fetch_or((unsigned*)mq + 2u * wd + ((c >> 2) & 1u), 1u << row, __ATOMIC_RELAXED, __HIP_MEMORY_SCOPE_WORKGROUP); } } } }
        } else {
        if (sh > 0) {
            { const unsigned pf = pref[r32]; LAS unsigned* lc = lcnt + r32; TOPK_LOOP(cand_half<false>(sv, p, tile, qabs, hi, lrow, lc, pf, sh), cand_half<true>(sv, p, tile, qabs, hi, lrow, lc, pf, sh)); }
            __syncthreads();
            for (int rr = 0; rr < 4; ++rr) { const int row = wid * 4 + rr; const unsigned n = lcnt[row] < (unsigned)CAND ? lcnt[row] : (unsigned)CAND;
                const unsigned thr = select_row(hist + row * CAND, n, krem[row], pref[row], sh, lane, (LAS unsigned*)(F.lds + SEL_OFF) + wid * 128);
                if (lane == 0) pref[row] = thr; }
            __syncthreads();
        }
        { const unsigned thr = pref[r32];
          unsigned mlo = 0u, mhi = 0u;
          if (!__any(thr < 0x80000000u)) { const unsigned tb = thr & 0x7fffffffu;
              TOPK_LOOP((mask_half<false, true>(sv, p, tile, qabs, hi, tb, mlo, mhi), TOPK_MSTORE()), (mask_half<true, true>(sv, p, tile, qabs, hi, tb, mlo, mhi), TOPK_MSTORE())); }
          else { TOPK_LOOP((mask_half<false, false>(sv, p, tile, qabs, hi, thr, mlo, mhi), TOPK_MSTORE()), (mask_half<true, false>(sv, p, tile, qabs, hi, thr, mlo, mhi), TOPK_MSTORE())); }
          }
        }
        for (int tile = ntile + wid; tile < nt_att; tile += NWAVES) if (lane < 32) mq[(size_t)tile * 32 + lane] = 0ull;
        __syncthreads();
#undef TOPK_MSTORE
#undef TOPK_SCAN
#undef TOPK_LOOP
#undef TOPK_SCORES
#undef TOPK_KP
#undef TOPK_LDB
#undef TOPK_LDW
#undef TOPK_LWAIT
#undef TOPK_MF
#undef TOPK_BQ
#undef TOPK_ZERO
    }
}

__device__ __forceinline__ void route_phase(Frame& F, const float* gain, const float* wr) {
    const int lane = F.lane;
    volatile LAS unsigned* lcnt = F.MISC + 16;
    f32x4 wga[4][4], wgb[4][4];
#pragma unroll
    for (int j = 0; j < 4; ++j) { const int c0 = 8 * lane + 512 * (j >> 1) + 4 * (j & 1); const f32x4 g4 = *(const f32x4*)(gain + c0);
#pragma unroll
        for (int i = 0; i < 4; ++i) { wga[j][i] = *(const f32x4*)(wr + (size_t)(c0 + i) * 8) * g4[i]; wgb[j][i] = *(const f32x4*)(wr + (size_t)(c0 + i) * 8 + 4) * g4[i]; } }
    for (int grp = blockIdx.x; grp < M / 64; grp += F.G) {
#pragma unroll 2
    for (int ti = 0; ti < 8; ++ti) { const int m = grp * 64 + F.wave * 8 + ti;
        const GAS v4u* xr = (const GAS v4u*)((const bf16*)(F.ws + WS_XB) + (size_t)m * D) + lane; f32x4 v[4]; float s = 0.f;
#pragma unroll
        for (int jj = 0; jj < 2; ++jj) { const v4u w = xr[64 * jj]; v[2 * jj] = (f32x4){bfl(w.x), bfh(w.x), bfl(w.y), bfh(w.y)}; v[2 * jj + 1] = (f32x4){bfl(w.z), bfh(w.z), bfl(w.w), bfh(w.w)}; }
#pragma unroll
        for (int j = 0; j < 4; ++j) s += (v[j].x * v[j].x + v[j].y * v[j].y) + (v[j].z * v[j].z + v[j].w * v[j].w);
        const float rstd = __builtin_amdgcn_rsqf(wave_sum(s) * (1.f / D) + EPS);
        float lg[8];
#pragma unroll
        for (int e = 0; e < 8; ++e) lg[e] = 0.f;
#pragma unroll
        for (int j = 0; j < 4; ++j) {
#pragma unroll
            for (int i = 0; i < 4; ++i) { const float h = v[j][i]; const f32x4 wa = wga[j][i], wb = wgb[j][i];
                lg[0] += h * wa.x; lg[1] += h * wa.y; lg[2] += h * wa.z; lg[3] += h * wa.w; lg[4] += h * wb.x; lg[5] += h * wb.y; lg[6] += h * wb.z; lg[7] += h * wb.w; } }
#pragma unroll
        for (int e = 0; e < 8; ++e) lg[e] = lg[e];
        {
            float a4[4], a2[2], a1;
            { const bool up = (lane & 32) != 0;
#pragma unroll
              for (int i = 0; i < 4; ++i) { const float keep = up ? lg[4 + i] : lg[i], send = up ? lg[i] : lg[4 + i]; a4[i] = keep + __shfl_xor(send, 32); } }
            { const bool up = (lane & 16) != 0;
#pragma unroll
              for (int i = 0; i < 2; ++i) { const float keep = up ? a4[2 + i] : a4[i], send = up ? a4[i] : a4[2 + i]; a2[i] = keep + __shfl_xor(send, 16); } }
            { const bool up = (lane & 8) != 0; const float keep = up ? a2[1] : a2[0], send = up ? a2[0] : a2[1]; a1 = keep + __shfl_xor(send, 8); }
            a1 += __shfl_xor(a1, 4); a1 += __shfl_xor(a1, 2); a1 += __shfl_xor(a1, 1);
#pragma unroll
            for (int e = 0; e < 8; ++e) lg[e] = __int_as_float(__builtin_amdgcn_readlane(__float_as_int(a1), 32 * (e >> 2) + 16 * ((e >> 1) & 1) + 8 * (e & 1))) * rstd;
        }
        int e0 = 0; float l0 = lg[0];
#pragma unroll
        for (int e = 1; e < 8; ++e) if (lg[e] > l0) { l0 = lg[e]; e0 = e; }
        int e1 = -1; float l1 = -INFINITY;
#pragma unroll
        for (int e = 0; e < 8; ++e) if (e != e0 && lg[e] > l1) { l1 = lg[e]; e1 = e; }
        const float g1 = 1.f / (1.f + __expf(l0 - l1)), g0 = 1.f - g1;
        if (lane == 0) { *(GAS f32x4*)((float*)(F.ws + WS_ROUTE) + (size_t)m * 4) = (f32x4){__uint_as_float((unsigned)e0 | ((unsigned)e1 << 8)), g0, g1, rstd};
            __hip_atomic_fetch_add((LAS unsigned*)lcnt + e0, 1u, __ATOMIC_RELAXED, __HIP_MEMORY_SCOPE_WORKGROUP); __hip_atomic_fetch_add((LAS unsigned*)lcnt + e1, 1u, __ATOMIC_RELAXED, __HIP_MEMORY_SCOPE_WORKGROUP); }
    }
    __syncthreads();
    if (F.tid < 8) { const unsigned c = lcnt[F.tid]; ((int*)(F.ws + WS_GCNT))[grp * 8 + F.tid] = (int)c; __hip_atomic_fetch_add(F.ctl + CW_CNT + 64 * F.tid, c, RLX_AGENT); lcnt[F.tid] = 0u; }
    __syncthreads();
    }
}
constexpr int MOE_I_UP = 16 * 56, MOE_I_DN = 56 * 16, MOE_NIT = NE * (2 * MOE_I_UP + MOE_I_DN), MOE_EARLY = NE * MOE_I_DN + W13E_SPLIT * 2 * MOE_I_UP;
constexpr int MOE_K_INPROJ = 3, MOE_K_UP = 1;
__device__ __forceinline__ TrItem moe_item(Frame& F, int it, const float* gain, const float* w1, const float* w3, const float* w2) {
    TrItem t; int r;
    if (it < NE * MOE_I_DN) { const int e = it / MOE_I_DN; r = it - e * MOE_I_DN; t.W = w2 + (size_t)e * FFE * D; t.WT = (unsigned char*)F.out + DO_W2E + (size_t)e * D * FFE; t.gain = nullptr; t.scale = MOE_SW2; t.K = FFE; t.N = D; t.mp = RowMap{0, 0}; }
    else { const int i2 = it - NE * MOE_I_DN, e = i2 / (2 * MOE_I_UP); r = i2 - e * 2 * MOE_I_UP; const bool third = r >= MOE_I_UP; if (third) r -= MOE_I_UP;
        t.W = (third ? w3 : w1) + (size_t)e * D * FFE; t.WT = (e < W13E_SPLIT ? (unsigned char*)F.out + DO_W13E : F.ws + WS_W13E) + (size_t)e * 2 * FFE * D; t.gain = gain; t.scale = MOE_SW1; t.K = D; t.N = FFE; t.mp = RowMap{2, third ? 128 : 0}; }
    const int nblk = t.N / 64; t.k0 = 64 * (r / nblk); t.n0 = 64 * (r % nblk); return t;
}
__device__ __forceinline__ void moe_weights_range(Frame& F, const float* gain, const float* w1, const float* w3, const float* w2, int first, int stride, int count, int limit) {
    LAS float* scr = (LAS float*)(F.lds + RING_OFF + F.wave * 16896);
    const int lane = F.lane;
    int it = first; if (count <= 0 || it >= limit) return;
    TrItem cur = moe_item(F, it, gain, w1, w3, w2); f32x4 v[16]; float gv[16]; tr64_load(cur, v, gv, lane);
    for (int k = 1;; ++k) { const int nx = it + stride; const bool more = k < count && nx < limit;
        TrItem nxt = cur; f32x4 vn[16]; float gn[16];
        if (more) { nxt = moe_item(F, nx, gain, w1, w3, w2); tr64_load(nxt, vn, gn, lane); }
        tr64_store(cur, v, gv, scr, lane);
        if (!more) break;
        it = nx; cur = nxt;
#pragma unroll
        for (int i = 0; i < 16; ++i) { v[i] = vn[i]; gv[i] = gn[i]; } }
}
__device__ __forceinline__ int moe_tail_idle(int G, int nwg) { const int rem = nwg % G; return rem > 0 ? G - rem : 0; }
__device__ __forceinline__ int moe_tail_base(int G, int t) {
    const int n0 = moe_tail_idle(G, (M / 256) * (INP / 256)) * 8 * MOE_K_INPROJ, n2 = moe_tail_idle(G, (M / 256) * (2 * FF / 256)) * 8 * MOE_K_UP;
    const int b = t == 0 ? 0 : t == 1 ? n0 : t == 2 ? 2 * n0 : 2 * n0 + n2; return b < MOE_EARLY ? b : MOE_EARLY; }
__device__ __forceinline__ void moe_tail_work(Frame& F, const float* const* in, int t, int nwg, int kper) {
    const int rem = nwg % F.G, idle = moe_tail_idle(F.G, nwg); if (idle == 0 || (int)blockIdx.x < rem) return;
    asm volatile("s_waitcnt vmcnt(0)" ::: "memory"); __syncthreads();
    const int base = moe_tail_base(F.G, t), lim = moe_tail_base(F.G, t + 1);
    moe_weights_range(F, in[10] + D, in[15], in[16], in[17], base + ((int)blockIdx.x - rem) * 8 + F.wave, idle * 8, kper, lim);
}
struct MoeSeg { int t1, t2, t3, t4, t5, t6, t7, nrt; };
__device__ __forceinline__ MoeSeg moe_segments(Frame& F) {
    unsigned c[8];
#pragma unroll
    for (int e = 0; e < 8; ++e) c[e] = (unsigned)__builtin_amdgcn_readfirstlane((int)__hip_atomic_load(F.ctl + CW_CNT + 64 * e, RLX_AGENT));
    MoeSeg s; int a = 0;
    a += (c[0] + 255) >> 8; s.t1 = a; a += (c[1] + 255) >> 8; s.t2 = a; a += (c[2] + 255) >> 8; s.t3 = a; a += (c[3] + 255) >> 8; s.t4 = a;
    a += (c[4] + 255) >> 8; s.t5 = a; a += (c[5] + 255) >> 8; s.t6 = a; a += (c[6] + 255) >> 8; s.t7 = a; a += (c[7] + 255) >> 8; s.nrt = a;
    return s;
}
__device__ __forceinline__ void gather_phase(Frame& F) {
    const MoeSeg sg = moe_segments(F);
    LAS int* earr = (LAS int*)(F.lds + RING_OFF);
    LAS int* parr = earr + 128;
    LAS int* tot = parr + 128;
    LAS int* base = tot + 8;
    const float* ROUTE = (const float*)(F.ws + WS_ROUTE); int* POS = (int*)(F.ws + WS_POS); float* META = (float*)(F.ws + WS_META); unsigned char* AP = F.ws + WS_AP;
    for (int e = blockIdx.x; e < 8; e += F.G) {
        const int cnt = (int)__hip_atomic_load(F.ctl + CW_CNT + 64 * e, RLX_AGENT);
        const int toff = e == 0 ? 0 : e == 1 ? sg.t1 : e == 2 ? sg.t2 : e == 3 ? sg.t3 : e == 4 ? sg.t4 : e == 5 ? sg.t5 : e == 6 ? sg.t6 : sg.t7;
        const int r0 = toff * 256 + cnt, r1 = toff * 256 + ((cnt + 255) & ~255);
        for (int r = r0 + F.wave; r < r1; r += NWAVES) { GAS unsigned long long* o8 = (GAS unsigned long long*)(AP + (size_t)r * D) + F.lane;
#pragma unroll
            for (int j = 0; j < 2; ++j) o8[64 * j] = 0ull;
            if (F.lane == 0) *(f32x4*)(META + (size_t)r * 4) = (f32x4){0.f, 0.f, 0.f, 0.f}; } }
    for (int grp = blockIdx.x; grp < M / 64; grp += F.G) {
        const int p = F.tid, tok = grp * 64 + (p >> 1), slot = p & 1; int e = 0;
        if (p < 128) { const unsigned ee = __float_as_uint(ROUTE[(size_t)tok * 4]); e = slot == 0 ? (int)(ee & 0xffu) : (int)((ee >> 8) & 0xffu); earr[p] = e; }
        __syncthreads();
        if (p < 8) { tot[p] = 0; base[p] = 0; }
        __syncthreads();
        for (int i = p; i < grp * 8; i += NWAVES * 64) __hip_atomic_fetch_add(base + (i & 7), ((const int*)(F.ws + WS_GCNT))[i], __ATOMIC_RELAXED, __HIP_MEMORY_SCOPE_WORKGROUP);
        __syncthreads();
        if (p < 128) { int rank = 0; for (int j = 0; j < p; ++j) rank += (earr[j] == e);
            const int toff = e == 0 ? 0 : e == 1 ? sg.t1 : e == 2 ? sg.t2 : e == 3 ? sg.t3 : e == 4 ? sg.t4 : e == 5 ? sg.t5 : e == 6 ? sg.t6 : sg.t7;
            const int pos = toff * 256 + base[e] + rank; parr[p] = pos; POS[(size_t)tok * 2 + slot] = pos;
            const f32x4 rt4 = *(const f32x4*)(ROUTE + (size_t)tok * 4); *(f32x4*)(META + (size_t)pos * 4) = (f32x4){rt4.w * (1.f / (MOE_SX * MOE_SW1)), (slot == 0 ? rt4.y : rt4.z) * MOE_SH, 0.f, 0.f}; }
        __syncthreads();
        { const int c4 = p & 255, tsub = p >> 8;
#pragma unroll 1
          for (int it = 0; it < 32; it += 8) { unsigned long long v[8];
#pragma unroll
              for (int k = 0; k < 8; ++k) v[k] = *((const GAS unsigned long long*)((const bf16*)(F.ws + WS_XB) + (size_t)(grp * 64 + 2 * (it + k) + tsub) * D) + c4);
#pragma unroll
              for (int k = 0; k < 8; ++k) { const int tl = 2 * (it + k) + tsub; const unsigned a = (unsigned)v[k], b = (unsigned)(v[k] >> 32); const unsigned w = pg8::pk4_fp8((f32x4){bfl(a), bfh(a), bfl(b), bfh(b)} * MOE_SX);
                  *((GAS unsigned*)(AP + (size_t)parr[2 * tl] * D) + c4) = w; *((GAS unsigned*)(AP + (size_t)parr[2 * tl + 1] * D) + c4) = w; } } }
        __syncthreads();
    }
}
__device__ __forceinline__ f32x4 moe_row4(Frame& F, int pos, int col) {
    if (pos < 128 * 256) { const unsigned long long a = *((const GAS unsigned long long*)((const bf16*)(F.ws + WS_Y) + (size_t)pos * D + col));
        return (f32x4){bfl((unsigned)a), bfh((unsigned)a), bfl((unsigned)(a >> 32)), bfh((unsigned)(a >> 32))}; }
    const float* sl = (const float*)(F.ws + WS_SLAB) + ((size_t)(((pos >> 8) - 128) * 4 + (col >> 8)) * 7) * 65536 + (size_t)(pos & 255) * 256 + (col & 255);
    f32x4 v = *(const GAS f32x4*)sl;
#pragma unroll
    for (int k = 1; k < 7; ++k) v += *(const GAS f32x4*)(sl + (size_t)k * 65536);
    return v;
}
__device__ __forceinline__ void fin_phase(Frame& F) {
    const int gw = F.vcu * NWAVES + F.wave, NGW = F.G * NWAVES, lane = F.lane;
    const int* POS = (const int*)(F.ws + WS_POS);
    for (int m = gw; m < M; m += NGW) {
        const int2 pa = *(const int2*)(POS + (size_t)m * 2);
        GAS f32x4* xa = (GAS f32x4*)(F.out + (size_t)m * D) + lane;
        f32x4 va[4];
#pragma unroll
        for (int j = 0; j < 4; ++j) { const unsigned long long w = *((const GAS unsigned long long*)((const bf16*)(F.ws + WS_XB) + (size_t)m * D + 256 * j) + lane); va[j] = (f32x4){bfl((unsigned)w), bfh((unsigned)w), bfl((unsigned)(w >> 32)), bfh((unsigned)(w >> 32))}; }
        if (pa.x < 128 * 256 && pa.y < 128 * 256) {
            unsigned long long ya[4], yb[4];
#pragma unroll
            for (int j = 0; j < 4; ++j) { ya[j] = *((const GAS unsigned long long*)((const bf16*)(F.ws + WS_Y) + (size_t)pa.x * D + 256 * j) + lane); yb[j] = *((const GAS unsigned long long*)((const bf16*)(F.ws + WS_Y) + (size_t)pa.y * D + 256 * j) + lane); }
#pragma unroll
            for (int j = 0; j < 4; ++j) { const unsigned long long a = ya[j], b = yb[j];
                va[j].x += bfl((unsigned)a) + bfl((unsigned)b); va[j].y += bfh((unsigned)a) + bfh((unsigned)b); va[j].z += bfl((unsigned)(a >> 32)) + bfl((unsigned)(b >> 32)); va[j].w += bfh((unsigned)(a >> 32)) + bfh((unsigned)(b >> 32)); }
        } else {
#pragma unroll
            for (int j = 0; j < 4; ++j) { const int col = 4 * lane + 256 * j; va[j] = va[j] + (moe_row4(F, pa.x, col) + moe_row4(F, pa.y, col)); }
        }
#pragma unroll
        for (int j = 0; j < 4; ++j) xa[64 * j] = va[j];
    }
}

#ifndef GSP2
#define GSP2 true
#endif
struct Args { const float* in[18]; float* out; unsigned char* ws; int ph_lo, ph_hi; };
__global__ void __launch_bounds__(NWAVES * 64, 2) mk_fwd(Args args) {
    extern __shared__ __attribute__((aligned(16))) unsigned char lds[];
    Frame F;
    F.lds = (LAS unsigned char*)lds;
    F.MISC = (volatile LAS unsigned*)(F.lds + MISC_OFF);
    const int wave0 = __builtin_amdgcn_readfirstlane((int)threadIdx.x >> 6);
    F.wave = wave0; F.lane = mk_lane(); F.tid = wave0 * 64 + F.lane;
    F.G = gridDim.x; { const int bx = blockIdx.x; F.vcu = (F.G % 8 == 0) ? (bx % 8) * (F.G / 8) + bx / 8 : bx; }
    F.ws = args.ws; F.out = args.out; F.ctl = (gu32*)(args.ws + WS_CTL);
    for (int u = F.tid; u < (LDS_BYTES - LDSCTL_OFF) / 4; u += NWAVES * 64) ((LAS unsigned*)(F.lds + LDSCTL_OFF))[u] = 0u;
    __syncthreads();
    XcdBarrier bar; bar.bar = (unsigned*)(F.ctl + CW_BAR); bar.x = 0; bar.st = nullptr; bar.wv = wave0;
    if (!MK_PER_PHASE) bar = xcd_barrier_post((unsigned*)(F.ctl + CW_BAR), F.MISC + 8, wave0);
    const int lo = args.ph_lo, hi = args.ph_hi;
#define IN(k) (!MK_PER_PHASE || (lo <= (k) && (k) < hi))
#define FRESH() do { int l_ = mk_lane(), w_ = wave0; unsigned char* ws_ = args.ws; asm volatile("" : "+v"(l_)); asm volatile("" : "+s"(w_)); asm volatile("" : "+s"(ws_)); F.lane = l_; F.tid = w_ * 64 + l_; F.wave = w_; F.ws = ws_; } while (0)
#define SEAM(k) do { if (!MK_PER_PHASE && IN(k) && IN((k) + 1)) xcd_barrier(bar); } while (0)
    const float* const* in = args.in;
    bf16* XB = (bf16*)(F.ws + WS_XB); float* SSQP = (float*)(F.ws + WS_SSQP);

    if (IN(0)) { FRESH(); p0_prologue(F, in); } SEAM(0);

    for (int L = 0; L < 2; ++L) {
        const int pb = 1 + 7 * L;
        if (IN(pb)) { FRESH(); pg8::Gemm g{XB, (const bf16*)(F.ws + WS_WIN) + (size_t)L * INP * D, M, INP, D, D}; pg8::StaticOrder S; S.init(M, INP, F.G, (int)blockIdx.x);
            pg8::EpiInProj E{F.ws, (const float*)(F.ws + WS_GAINS) + L * 128, attn_body::C2};
            pg8::gemm_phase<pg8::EpiInProj, pg8::StaticOrder, true, GSP2>(F.lds + RING_OFF, g, S, E, F.wave);
            FRESH(); moe_tail_work(F, in, L, (M / 256) * (INP / 256), MOE_K_INPROJ); }
        SEAM(pb);
        if (IN(pb + 1)) { FRESH(); diff_rows(F); topk_phase(F, L); }
        SEAM(pb + 1);
        if (IN(pb + 2)) { FRESH();
            const attn_body::AttnTensors AT{(const attn_body::bf16*)(F.ws + WS_Q), (const attn_body::bf16*)(F.ws + WS_K), (const attn_body::bf16*)(F.ws + WS_V), (attn_body::bf16*)(F.ws + WS_AO), (const unsigned long long*)(F.ws + WS_MASK + (size_t)L * 16 * MiB)};
            const attn_body::StaticOrder S((int)F.G, (int)blockIdx.x);
            attn_body::attn_phase<attn_body::StaticOrder>((char*)lds + RING_OFF, AT, S, F.wave); }
        SEAM(pb + 2);
        if (IN(pb + 3)) { FRESH();
            pg8::Gemm g{(const bf16*)(F.ws + WS_AO), (const bf16*)(F.ws + WS_PA) + (size_t)L * D * 512, M, D, 1024, 512, 0, 0ll, (const bf16*)(F.ws + WS_DIFF), (const bf16*)(F.ws + WS_WEFF) + (size_t)L * D * 512, 8};
            pg8::StaticOrder S; S.init(M, D, F.G, (int)blockIdx.x);
            pg8::EpiGate2 E{(const bf16*)(F.ws + WS_SG), 2048, (bf16*)(F.ws + WS_MB)};
            pg8::gemm_phase<pg8::EpiGate2, pg8::StaticOrder, true, GSP2>(F.lds + RING_OFF, g, S, E, F.wave); }
        SEAM(pb + 3);
        if (IN(pb + 4)) { FRESH(); pg8::Gemm g{(const bf16*)(F.ws + WS_MB), (const bf16*)(F.ws + WS_WOUT) + (size_t)L * D * D, M, D, D, D}; pg8::StaticOrder S; S.init(M, D, F.G, (int)blockIdx.x);
            if (L == 0) { pg8::EpiResid<true> E{XB, F.ws + WS_X8, SSQP, 1.f, MOE_SX};
                pg8::gemm_phase<pg8::EpiResid<true>, pg8::StaticOrder, true, GSP2>(F.lds + RING_OFF, g, S, E, F.wave); }
            else { pg8::EpiResid<false> E{XB, nullptr, SSQP, 1.f, 1.f};
                pg8::gemm_phase<pg8::EpiResid<false>, pg8::StaticOrder, true, GSP2>(F.lds + RING_OFF, g, S, E, F.wave); } }
        SEAM(pb + 4);
        if (L == 0) {
            if (IN(6)) { FRESH(); pg8::Gemm g{(const bf16*)(F.ws + WS_X8), (const bf16*)(F.ws + WS_W13), M, 2 * FF, D / 2, D / 2}; pg8::StaticOrder S; S.init(M, 2 * FF, F.G, (int)blockIdx.x);
                pg8::EpiSwiGLU<false> E{(bf16*)(F.ws + WS_HB), FF, 2 * FF / 256, SSQP, nullptr, 1.f / (MOE_SX * MOE_SW1), MOE_SH};
                pg8::gemm_phase<pg8::EpiSwiGLU<false>, pg8::StaticOrder, true, GSP2, true>(F.lds + RING_OFF, g, S, E, F.wave);
                FRESH(); moe_tail_work(F, in, 2, (M / 256) * (2 * FF / 256), MOE_K_UP); }
            SEAM(6);
            if (IN(7)) { FRESH(); pg8::Gemm g{(const bf16*)(F.ws + WS_HB), (const bf16*)(F.ws + WS_W2), M, D, FF / 2, FF / 2}; pg8::StaticOrder S; S.init(M, D, F.G, (int)blockIdx.x);
                pg8::EpiResid<false> E{XB, nullptr, SSQP, 1.f / (MOE_SH * MOE_SW2), 1.f};
                pg8::gemm_phase<pg8::EpiResid<false>, pg8::StaticOrder, true, GSP2, true>(F.lds + RING_OFF, g, S, E, F.wave); }
            SEAM(7);
        }
    }
    if (IN(13)) { FRESH(); moe_weights_range(F, in[10] + D, in[15], in[16], in[17], moe_tail_base(F.G, 3) + F.vcu * NWAVES + F.wave, F.G * NWAVES, 1 << 30, MOE_NIT); route_phase(F, in[10] + D, in[14]); }
    SEAM(13);
    if (IN(14)) { FRESH(); gather_phase(F); }
    SEAM(14);
    if (IN(15)) { FRESH(); const MoeSeg sg = moe_segments(F);
        pg8::Gemm g{(const bf16*)(F.ws + WS_AP), (const bf16*)((unsigned char*)F.out + DO_W13E), MROWS, NE * 2 * FFE, D / 2, D / 2, W13E_SPLIT * (2 * FFE / 256), (long long)((F.ws + WS_W13E) - ((unsigned char*)F.out + DO_W13E))};
        pg8::GroupedOrder S{2 * FFE / 256, F.G, (int)blockIdx.x, sg.nrt, sg.t1, sg.t2, sg.t3, sg.t4, sg.t5, sg.t6, sg.t7, 0, sg.nrt * (2 * FFE / 256), 1, 0};
        pg8::EpiSwiGLU<true> E{(bf16*)(F.ws + WS_HE), FFE, 2 * FFE / 256, nullptr, (const float*)(F.ws + WS_META)};
        pg8::gemm_phase<pg8::EpiSwiGLU<true>, pg8::GroupedOrder, true, GSP2, true>(F.lds + RING_OFF, g, S, E, F.wave); }
    SEAM(15);
    if (IN(16)) { FRESH(); const MoeSeg sg = moe_segments(F);
        { pg8::Gemm g{(const bf16*)(F.ws + WS_HE), (const bf16*)((unsigned char*)F.out + DO_W2E), MROWS, NE * D, FFE / 2, FFE / 2};
          pg8::GroupedOrder S{D / 256, F.G, (int)blockIdx.x, sg.nrt, sg.t1, sg.t2, sg.t3, sg.t4, sg.t5, sg.t6, sg.t7, 0, 128 * (D / 256), 1, 0};
          pg8::EpiPlain E{(bf16*)(F.ws + WS_Y), D, D / 256, 1.f / (MOE_SH * MOE_SW2)};
          pg8::gemm_phase<pg8::EpiPlain, pg8::GroupedOrder, true, GSP2, true>(F.lds + RING_OFF, g, S, E, F.wave); }
        { pg8::Gemm g{(const bf16*)(F.ws + WS_HE), (const bf16*)((unsigned char*)F.out + DO_W2E), MROWS, NE * D, FFE / 14, FFE / 2};
          pg8::GroupedOrder S{D / 256, F.G, (int)blockIdx.x, sg.nrt, sg.t1, sg.t2, sg.t3, sg.t4, sg.t5, sg.t6, sg.t7, 128 * (D / 256), sg.nrt * (D / 256), 7, FFE / 14};
          pg8::EpiSlab E{(float*)(F.ws + WS_SLAB), D / 256, 128, 7, FFE / 14, 1.f / (MOE_SH * MOE_SW2)};
          pg8::gemm_phase<pg8::EpiSlab, pg8::GroupedOrder, true, GSP2, true>(F.lds + RING_OFF, g, S, E, F.wave); }
        }
    SEAM(16);
    if (IN(17)) { FRESH(); fin_phase(F); }
#undef IN
#undef SEAM
}

extern "C" void kernel_launch(void* const* d_in, const int* in_sizes, int n_in, void* d_out, int out_size, void* d_ws, size_t ws_size, hipStream_t stream) {
    static int grid = 0;
    if (grid == 0) {
        if (n_in != 18 || in_sizes[0] != M * D || out_size != M * D || ws_size < WS_END) { fprintf(stderr, "kernel_launch: unexpected shapes or workspace (n_in %d, ws %zu < %zu); nothing launched\n", n_in, ws_size, (size_t)WS_END); grid = -1; return; }
        int dev = 0, cus = 0, per_cu = 0;
        if (hipGetDevice(&dev) != hipSuccess || hipDeviceGetAttribute(&cus, hipDeviceAttributeMultiprocessorCount, dev) != hipSuccess) { grid = -1; return; }
        if (hipFuncSetAttribute((const void*)mk_fwd, hipFuncAttributeMaxDynamicSharedMemorySize, LDS_BYTES) != hipSuccess) { fprintf(stderr, "kernel_launch: hipFuncSetAttribute failed\n"); grid = -1; return; }
        if (hipOccupancyMaxActiveBlocksPerMultiprocessor(&per_cu, (const void*)mk_fwd, NWAVES * 64, LDS_BYTES) != hipSuccess || per_cu < 1) fprintf(stderr, "kernel_launch: occupancy query reports %d\n", per_cu);
        (void)hipGetLastError();
        grid = cus;
    }
    if (grid < 0) return;
    if (hipMemsetAsync((char*)d_ws + WS_CTL, 0, CTL_ZERO_BYTES, stream) != hipSuccess) return;
    Args a{};
    for (int i = 0; i < 18; ++i) a.in[i] = (const float*)d_in[i];
    a.out = (float*)d_out; a.ws = (unsigned char*)d_ws;
#if MK_PER_PHASE
    for (int ph = 0; ph < NPH; ++ph) { a.ph_lo = ph; a.ph_hi = ph + 1; hipLaunchKernelGGL(mk_fwd, dim3(grid), dim3(NWAVES * 64), LDS_BYTES, stream, a); }
#else
    a.ph_lo = 0; a.ph_hi = NPH; hipLaunchKernelGGL(mk_fwd, dim3(grid), dim3(NWAVES * 64), LDS_BYTES, stream, a);
#endif
}
```

```cpp
#define MK_PER_PHASE 0
#include <hip/hip_runtime.h>
#include <cstdio>
#include <cstdint>
__device__ __forceinline__ int mk_lane() { int l; asm volatile("v_mbcnt_lo_u32_b32 %0, -1, 0\n\tv_mbcnt_hi_u32_b32 %0, -1, %0" : "=v"(l)); return l; }
namespace pg8 {
#define PG8_LAS __attribute__((address_space(3)))
typedef unsigned short bf16_t;
typedef short bf16x8 __attribute__((ext_vector_type(8)));
typedef float f32x4 __attribute__((ext_vector_type(4)));
typedef unsigned u32x4 __attribute__((ext_vector_type(4)));
constexpr int BM = 256, BK = 64, HALF = 128, HTB = HALF * BK * 2  , STAGE_BYTES = 8 * HTB, NXCD = 8, WGM = 8;

__host__ __device__ __forceinline__ int lds_byte(int r, int c) { const int st = (r >> 4) * 2 + (c >> 5), rr = r & 15, cc = c & 31, ob = rr * 64 + cc * 2; return st * 1024 + (ob ^ (((ob >> 9) & 1) << 5)); }
__host__ __device__ __forceinline__ void stage_rc(int b, int& R, int& C) { const int st = b / 1024, sb = b % 1024, swz = sb ^ (((sb >> 9) & 1) << 5); R = (st >> 1) * 16 + swz / 64; C = (st & 1) * 32 + (swz % 64) / 2; }
__host__ __device__ __forceinline__ int perm32(int rho) { const int n = rho >> 4, i = rho & 15; return 8 * (i >> 2) + 4 * n + (i & 3); }

struct Unit { int pm, pn, ko; };
struct Gemm { const bf16_t* A; const bf16_t* Bt; int M, N, K, ld; int pnsplit; long long bt2off; const bf16_t* A2; const bf16_t* Bt2; int nt1; };

struct StaticOrder {
    int nM, nN, nwg, G, c;
    __host__ __device__ void init(int M, int N, int G_, int c_) { nM = M / BM; nN = N / BM; nwg = nM * nN; G = G_; c = c_; }
    __host__ __device__ bool next(int i, Unit& u) const {
        const long L = (long)i * G + c; if (L >= nwg) return false;
        int wgid = (int)L; { const int q = nwg / NXCD, r = nwg % NXCD, xcd = wgid % NXCD, off = wgid / NXCD; wgid = (xcd < r ? xcd * (q + 1) : r * (q + 1) + (xcd - r) * q) + off; }
        const int nig = WGM * nN, gid = wgid / nig, fm = gid * WGM, gsz = (nM - fm) < WGM ? (nM - fm) : WGM;
        u.pm = fm + ((wgid % nig) % gsz); u.pn = (wgid % nig) / gsz; u.ko = 0; return true;
    }
    __device__ __forceinline__ void a_ready(const Unit&) const {}
    __device__ __forceinline__ void done(const Unit&) const {}
};

__device__ __forceinline__ unsigned cvt_pk_bf16(float lo, float hi) { unsigned r; asm volatile("v_cvt_pk_bf16_f32 %0, %1, %2" : "=v"(r) : "v"(lo), "v"(hi)); return r; }
typedef float f32x2 __attribute__((ext_vector_type(2)));
__device__ __forceinline__ float bf_lo(unsigned w) { return __uint_as_float(w << 16); }
__device__ __forceinline__ float bf_hi(unsigned w) { return __uint_as_float(w & 0xffff0000u); }
__device__ __forceinline__ float fsigmoid(float x) { return __builtin_amdgcn_rcpf(1.f + __builtin_amdgcn_exp2f(-1.4426950408889634f * x)); }
__device__ __forceinline__ u32x4 pack8(const f32x4 v0, const f32x4 v1) { u32x4 w; w.x = cvt_pk_bf16(v0[0], v0[1]); w.y = cvt_pk_bf16(v0[2], v0[3]); w.z = cvt_pk_bf16(v1[0], v1[1]); w.w = cvt_pk_bf16(v1[2], v1[3]); return w; }
typedef unsigned u32x2 __attribute__((ext_vector_type(2)));
__device__ __forceinline__ unsigned pk4_fp8(const f32x4 v) { int p = __builtin_amdgcn_cvt_pk_fp8_f32(v[0], v[1], 0, false); p = __builtin_amdgcn_cvt_pk_fp8_f32(v[2], v[3], p, true); return (unsigned)p; }
__device__ __forceinline__ void unpack8(const u32x4 w, f32x4& v0, f32x4& v1) { v0 = (f32x4){bf_lo(w.x), bf_hi(w.x), bf_lo(w.y), bf_hi(w.y)}; v1 = (f32x4){bf_lo(w.z), bf_hi(w.z), bf_lo(w.w), bf_hi(w.w)}; }
__device__ __forceinline__ float rstd_from_parts(const float* ssqp, int row) {
    const f32x4* p = (const f32x4*)(ssqp + (size_t)row * 16);
    const f32x4 a = p[0], b = p[1], c = p[2], d = p[3];
    const float s = (((a[0] + a[1]) + (a[2] + a[3])) + ((b[0] + b[1]) + (b[2] + b[3]))) + (((c[0] + c[1]) + (c[2] + c[3])) + ((d[0] + d[1]) + (d[2] + d[3])));
    return __builtin_amdgcn_rsqf(s * (1.0f / 1024.0f) + 1e-6f);
}
__device__ __forceinline__ void rstd8(const float* ssqp, int row0, int fr, int fq, float (&rsv)[8], float mul) {
    float mine[2];
#pragma unroll
    for (int j = 0; j < 2; ++j) { const int k = 2 * fq + j; mine[j] = rstd_from_parts(ssqp, row0 + (k >> 2) * HALF + (k & 3) * 16) * mul; }
#pragma unroll
    for (int k = 0; k < 8; ++k) rsv[k] = __shfl(mine[k & 1], fr + 16 * (k >> 1));
}
template <bool ADD> struct EpiGate {
    static constexpr bool PERM = true, AFTER_DRAIN = false;
    const bf16_t* G; int ldg; const bf16_t* T; bf16_t* O;
    __device__ __forceinline__ void operator()(const f32x4 (&acc)[2][2][4][2], const Unit& u, int wr, int wc, int fr, int fq) const {
        const int row0 = u.pm * BM + wr * 64 + fr, col0 = u.pn * BM + wc * 32 + 8 * fq;
#pragma unroll
        for (int am = 0; am < 8; am += 2) {
            u32x4 gw[2][2], tw[2][2];
#pragma unroll
            for (int k = 0; k < 2; ++k)
#pragma unroll
                for (int bj = 0; bj < 2; ++bj) { const int row = row0 + ((am + k) >> 2) * HALF + ((am + k) & 3) * 16, col = col0 + bj * HALF; gw[k][bj] = *(const u32x4*)(G + (size_t)row * ldg + col); if (ADD) tw[k][bj] = *(const u32x4*)(T + (size_t)row * 1024 + col); }
#pragma unroll
            for (int k = 0; k < 2; ++k)
#pragma unroll
                for (int bj = 0; bj < 2; ++bj) { const int ai = (am + k) >> 2, m = (am + k) & 3; const int row = row0 + ai * HALF + m * 16, col = col0 + bj * HALF;
                    f32x4 g0, g1; unpack8(gw[k][bj], g0, g1);
                    f32x4 v0 = acc[ai][bj][m][0] * g0, v1 = acc[ai][bj][m][1] * g1;
                    if (ADD) { f32x4 t0, t1; unpack8(tw[k][bj], t0, t1); v0 += t0; v1 += t1; }
                    *(u32x4*)(O + (size_t)row * 1024 + col) = pack8(v0, v1); } }
    }
};
struct EpiGate2 {
    static constexpr bool PERM = true, AFTER_DRAIN = false;
    const bf16_t* G; int ldg; bf16_t* O;
    __device__ __forceinline__ void mid(f32x4 (&acc)[2][2][4][2], const Unit& u, int wr, int wc, int fr, int fq) const {
        const int row0 = u.pm * BM + wr * 64 + fr, col0 = u.pn * BM + wc * 32 + 8 * fq;
#pragma unroll
        for (int am = 0; am < 8; am += 2) {
            u32x4 ga[2][2], gp[2][2];
#pragma unroll
            for (int k = 0; k < 2; ++k)
#pragma unroll
                for (int bj = 0; bj < 2; ++bj) { const int row = row0 + ((am + k) >> 2) * HALF + ((am + k) & 3) * 16, col = col0 + bj * HALF; ga[k][bj] = *(const u32x4*)(G + (size_t)row * ldg + col); gp[k][bj] = *(const u32x4*)(G + (size_t)row * ldg + 1024 + col); }
#pragma unroll
            for (int k = 0; k < 2; ++k)
#pragma unroll
                for (int bj = 0; bj < 2; ++bj) { const int ai = (am + k) >> 2, m = (am + k) & 3;
                    f32x4 a0, a1, p0, p1; unpack8(ga[k][bj], a0, a1); unpack8(gp[k][bj], p0, p1);
#pragma unroll
                    for (int i = 0; i < 4; ++i) { acc[ai][bj][m][0][i] *= a0[i] * __builtin_amdgcn_rcpf(__builtin_fmaxf(p0[i], 1e-30f)); acc[ai][bj][m][1][i] *= a1[i] * __builtin_amdgcn_rcpf(__builtin_fmaxf(p1[i], 1e-30f)); } } }
    }
    __device__ __forceinline__ void operator()(const f32x4 (&acc)[2][2][4][2], const Unit& u, int wr, int wc, int fr, int fq) const {
        const int row0 = u.pm * BM + wr * 64 + fr, col0 = u.pn * BM + wc * 32 + 8 * fq;
#pragma unroll
        for (int am = 0; am < 8; am += 2) {
            u32x4 gp[2][2];
#pragma unroll
            for (int k = 0; k < 2; ++k)
#pragma unroll
                for (int bj = 0; bj < 2; ++bj) { const int row = row0 + ((am + k) >> 2) * HALF + ((am + k) & 3) * 16, col = col0 + bj * HALF; gp[k][bj] = *(const u32x4*)(G + (size_t)row * ldg + 1024 + col); }
#pragma unroll
            for (int k = 0; k < 2; ++k)
#pragma unroll
                for (int bj = 0; bj < 2; ++bj) { const int ai = (am + k) >> 2, m = (am + k) & 3; const int row = row0 + ai * HALF + m * 16, col = col0 + bj * HALF;
                    f32x4 p0, p1; unpack8(gp[k][bj], p0, p1);
                    *(u32x4*)(O + (size_t)row * 1024 + col) = pack8(acc[ai][bj][m][0] * p0, acc[ai][bj][m][1] * p1); } }
    }
};
template <bool OB8> struct EpiResid {
    static constexpr bool PERM = true, AFTER_DRAIN = false;
    bf16_t* rb; unsigned char* o8; float* ssqp; float sc, so;
    __device__ __forceinline__ void operator()(const f32x4 (&acc)[2][2][4][2], const Unit& u, int wr, int wc, int fr, int fq) const {
        const int row0 = u.pm * BM + wr * 64 + fr, col0 = u.pn * BM + wc * 32 + 8 * fq;
#pragma unroll
        for (int am = 0; am < 8; am += 4) {
            u32x4 rv[4][2];
#pragma unroll
            for (int k = 0; k < 4; ++k)
#pragma unroll
                for (int bj = 0; bj < 2; ++bj) { const size_t off = (size_t)(row0 + ((am + k) >> 2) * HALF + ((am + k) & 3) * 16) * 1024 + col0 + bj * HALF; rv[k][bj] = *(const u32x4*)(rb + off); }
#pragma unroll
            for (int k = 0; k < 4; ++k) { const int ai = (am + k) >> 2, m = (am + k) & 3; const int row = row0 + ai * HALF + m * 16; float ss = 0.f;
#pragma unroll
                for (int bj = 0; bj < 2; ++bj) { const size_t off = (size_t)row * 1024 + col0 + bj * HALF;
                    f32x4 r0, r1; unpack8(rv[k][bj], r0, r1);
                    const f32x4 v0 = acc[ai][bj][m][0] * sc + r0, v1 = acc[ai][bj][m][1] * sc + r1;
                    *(u32x4*)(rb + off) = pack8(v0, v1);
                    if (OB8) { u32x2 w8; w8.x = pk4_fp8(v0 * so); w8.y = pk4_fp8(v1 * so); *(u32x2*)(o8 + off) = w8; }
                    ss += ((v0[0] * v0[0] + v0[1] * v0[1]) + (v0[2] * v0[2] + v0[3] * v0[3])) + ((v1[0] * v1[0] + v1[1] * v1[1]) + (v1[2] * v1[2] + v1[3] * v1[3])); }
                ss += __shfl_xor(ss, 16); ss += __shfl_xor(ss, 32);
                if (fq == 0) ssqp[(size_t)row * 16 + u.pn * 4 + wc] = ss; } }
    }
};
template <bool GROUPED> struct EpiSwiGLU {
    static constexpr bool PERM = true, AFTER_DRAIN = false;
    bf16_t* O; int ldo; int nct; const float* ssqp; const float* meta; float rsc, gsc;
    __device__ __forceinline__ void operator()(const f32x4 (&acc)[2][2][4][2], const Unit& u, int wr, int wc, int fr, int fq) const {
        const int row0 = u.pm * BM + wr * 64 + fr, col0 = (u.pn % nct) * HALF + wc * 32 + 8 * fq;
        float rsv[8], gtv[8];
#pragma unroll
        for (int k = 0; k < 8; ++k) { const int row = row0 + (k >> 2) * HALF + (k & 3) * 16;
            if (GROUPED) { const f32x2 mt = *(const f32x2*)(meta + (size_t)row * 4); rsv[k] = mt.x; gtv[k] = mt.y; } else gtv[k] = gsc; }
        if (!GROUPED) rstd8(ssqp, row0, fr, fq, rsv, rsc);
#pragma unroll
        for (int ai = 0; ai < 2; ++ai)
#pragma unroll
            for (int m = 0; m < 4; ++m) { const int row = row0 + ai * HALF + m * 16; const float rs = rsv[ai * 4 + m], gt = gtv[ai * 4 + m];
                f32x4 o[2];
#pragma unroll
                for (int n = 0; n < 2; ++n)
#pragma unroll
                    for (int i = 0; i < 4; ++i) { const float a1 = acc[ai][0][m][n][i] * rs, a3 = acc[ai][1][m][n][i] * rs; o[n][i] = a1 * fsigmoid(a1) * a3 * gt; }
                u32x2 w8; w8.x = pk4_fp8(o[0]); w8.y = pk4_fp8(o[1]); *(u32x2*)((unsigned char*)O + (size_t)row * ldo + col0) = w8; }
    }
};
struct EpiPlain {
    static constexpr bool PERM = true, AFTER_DRAIN = false;
    bf16_t* O; int ldo; int nct; float sc;
    __device__ __forceinline__ void operator()(const f32x4 (&acc)[2][2][4][2], const Unit& u, int wr, int wc, int fr, int fq) const {
        const int row0 = u.pm * BM + wr * 64 + fr, col0 = (u.pn % nct) * BM + wc * 32 + 8 * fq;
#pragma unroll
        for (int ai = 0; ai < 2; ++ai)
#pragma unroll
            for (int m = 0; m < 4; ++m) { bf16_t* rowp = O + (size_t)(row0 + ai * HALF + m * 16) * ldo + col0;
#pragma unroll
                for (int bj = 0; bj < 2; ++bj) *(u32x4*)(rowp + bj * HALF) = pack8(acc[ai][bj][m][0] * sc, acc[ai][bj][m][1] * sc); }
    }
};
struct GroupedOrder {
    int nct, G, c, nrt, t1, t2, t3, t4, t5, t6, t7, l0, l1, ksplit, kchunk;
    __device__ __forceinline__ bool next(int i, Unit& u) const {
        const int S = i * G + c; if (S >= (l1 - l0) * ksplit) return false;
        const int L = l0 + S / ksplit, kp = S % ksplit;
        const int rt = L / nct, ct = L % nct;
        const int e = (rt >= t1) + (rt >= t2) + (rt >= t3) + (rt >= t4) + (rt >= t5) + (rt >= t6) + (rt >= t7);
        u.pm = rt; u.pn = e * nct + ct; u.ko = kp * kchunk; return true;
    }
    __device__ __forceinline__ void a_ready(const Unit&) const {}
    __device__ __forceinline__ void done(const Unit&) const {}
};
struct EpiSlab {
    static constexpr bool PERM = true, AFTER_DRAIN = false;
    float* S; int nct, rt0, ksplit, kchunk; float sc;
    __device__ __forceinline__ void operator()(const f32x4 (&acc)[2][2][4][2], const Unit& u, int wr, int wc, int fr, int fq) const {
        float* T = S + ((size_t)((u.pm - rt0) * nct + (u.pn % nct)) * ksplit + u.ko / kchunk) * (BM * BM);
        const int r0 = wr * 64 + fr, c0 = wc * 32 + 8 * fq;
#pragma unroll
        for (int ai = 0; ai < 2; ++ai)
#pragma unroll
            for (int m = 0; m < 4; ++m) { float* rowp = T + (unsigned)((r0 + ai * HALF + m * 16) * BM + c0);
#pragma unroll
                for (int bj = 0; bj < 2; ++bj) { *(f32x4*)(rowp + bj * HALF) = acc[ai][bj][m][0] * sc; *(f32x4*)(rowp + bj * HALF + 4) = acc[ai][bj][m][1] * sc; } }
    }
};
typedef int i32x4 __attribute__((ext_vector_type(4)));
typedef int i32x8 __attribute__((ext_vector_type(8)));
__device__ __forceinline__ i32x8 cat8(const bf16x8 a, const bf16x8 b) { return __builtin_shufflevector(__builtin_bit_cast(i32x4, a), __builtin_bit_cast(i32x4, b), 0, 1, 2, 3, 4, 5, 6, 7); }
__device__ __forceinline__ bf16x8 half8(const i32x8 v, int k) { return k == 0 ? __builtin_bit_cast(bf16x8, __builtin_shufflevector(v, v, 0, 1, 2, 3)) : __builtin_bit_cast(bf16x8, __builtin_shufflevector(v, v, 4, 5, 6, 7)); }
template <class E, class = void> struct epi_has_mid { static constexpr bool value = false; };
template <class E> struct epi_has_mid<E, decltype((void)&E::mid)> { static constexpr bool value = true; };
template <class Epi, class Sched, bool ALIGN_EPI = false, bool SP2 = false, bool F8 = false>
__device__ __forceinline__ void gemm_phase(PG8_LAS unsigned char* lds, const Gemm g, const Sched& S, const Epi& E, const int wv  ) {
    int wv_ = wv; asm volatile("" : "+s"(wv_)); int tid_ = wv_ * 64 + mk_lane(); asm volatile("" : "+v"(tid_));
    const int tid = tid_, wid = wv_, lane = tid & 63, wr = wid >> 2, wc = wid & 3, fr = lane & 15, fq = lane >> 4;
    const int K = g.K, nt = K / BK;
    unsigned voffA[2], voffB[2];
#pragma unroll
    for (int i = 0; i < 2; ++i) { int R, C; stage_rc(tid * 16 + i * 8192, R, C); const int Rb = Epi::PERM ? ((R & ~31) + perm32(R & 31)) : R;
        voffA[i] = (unsigned)(R * g.ld + C) * 2u; voffB[i] = (unsigned)(Rb * g.ld + C) * 2u; }
    const size_t kstep = (size_t)(BK * 2);
    const size_t hstep = (size_t)HALF * g.ld * 2;
    const size_t tstep = 2 * hstep;
    const unsigned ldsw = (unsigned)wid * 1024u;
    const int aoff = lds_byte(wr * 64 + fr, fq * 8), boff = lds_byte(wc * 32 + fr, fq * 8);
#define PG8_SA(b, h) (((b) * 2 + (h)) * HTB)
#define PG8_SB(b, h) ((4 + (b) * 2 + (h)) * HTB)
#define PG8_STAGE(bufoff, gbase, voff) do { const char* _g = (const char*)(gbase); if constexpr (F8) asm volatile("" : "+s"(_g));   \
        _Pragma("unroll") for (int _i = 0; _i < 2; ++_i) { unsigned _v = (voff)[F8 ? 0 : _i]; if constexpr (F8) asm volatile("" : "+v"(_v));   \
        __builtin_amdgcn_global_load_lds((const unsigned*)(_g + (F8 ? (size_t)_i * 128 * g.ld : (size_t)0) + _v), (PG8_LAS unsigned*)(lds + (bufoff) + ldsw + _i * 8192), 16, 0, 0); } } while (0)
#define PG8_LDA(dst, b, h) do { _Pragma("unroll") for (int m = 0; m < 4; ++m) dst[m] = cat8(*(const PG8_LAS bf16x8*)(lds + PG8_SA(b, h) + aoff + m * 2048), *(const PG8_LAS bf16x8*)(lds + PG8_SA(b, h) + aoff + m * 2048 + 1024)); } while (0)
#define PG8_LDB(dst, b, h) do { _Pragma("unroll") for (int n = 0; n < 2; ++n) dst[n] = cat8(*(const PG8_LAS bf16x8*)(lds + PG8_SB(b, h) + boff + n * 2048), *(const PG8_LAS bf16x8*)(lds + PG8_SB(b, h) + boff + n * 2048 + 1024)); } while (0)
#define PG8_MMA(ai, bj, At, Bt) do { __builtin_amdgcn_s_setprio(1); _Pragma("unroll") for (int m = 0; m < 4; ++m) _Pragma("unroll") for (int n = 0; n < 2; ++n) _Pragma("unroll") for (int k = 0; k < 2; ++k) \
        acc[ai][bj][m][n] = __builtin_amdgcn_mfma_f32_16x16x32_bf16(half8(Bt[n], k), half8(At[m], k), acc[ai][bj][m][n], 0, 0, 0); __builtin_amdgcn_s_setprio(0); } while (0)
#define PG8_MMA8(ai, bj, At, Bt) do { __builtin_amdgcn_s_setprio(1); _Pragma("unroll") for (int m = 0; m < 4; ++m) _Pragma("unroll") for (int n = 0; n < 2; ++n) \
        acc[ai][bj][m][n] = __builtin_amdgcn_mfma_scale_f32_16x16x128_f8f6f4(Bt[n], At[m], acc[ai][bj][m][n], 0, 0, 0, 0x7f7f7f7f, 0, 0x7f7f7f7f); __builtin_amdgcn_s_setprio(0); } while (0)
#define PG8_MM(ai, bj, At, Bt) do { if constexpr (F8) PG8_MMA8(ai, bj, At, Bt); else PG8_MMA(ai, bj, At, Bt); } while (0)
#define PG8_WAIT_V(n) asm volatile("s_waitcnt vmcnt(" #n ")" ::: "memory")
#define PG8_WAIT_L(n) asm volatile("s_waitcnt lgkmcnt(" #n ")" ::: "memory")
#define PG8_BAR __builtin_amdgcn_s_barrier()
#define PG8_SCHED __builtin_amdgcn_sched_barrier(0)
    Unit cur, nxt; int ui = 0;
    if (!S.next(0, cur)) return;
    f32x4 acc[2][2][4][2];
#pragma unroll
    for (int a = 0; a < 2; ++a)
#pragma unroll
        for (int b = 0; b < 2; ++b)
#pragma unroll
            for (int m = 0; m < 4; ++m)
#pragma unroll
                for (int n = 0; n < 2; ++n) acc[a][b][m][n] = (f32x4){0.f, 0.f, 0.f, 0.f};
    i32x8 At[4], B0[2], B1[2];
    const char* cA = (const char*)g.A + (size_t)cur.pm * tstep + (size_t)cur.ko * 2; const char* cB = (const char*)g.Bt + (size_t)cur.pn * tstep + (size_t)cur.ko * 2 + (g.pnsplit > 0 && cur.pn >= g.pnsplit ? g.bt2off : 0ll);
    S.a_ready(cur);
    if constexpr (SP2) {
        PG8_STAGE(PG8_SB(0, 0), cB, voffB); PG8_STAGE(PG8_SB(0, 1), cB + hstep, voffB); PG8_STAGE(PG8_SA(0, 0), cA, voffA); PG8_STAGE(PG8_SA(0, 1), cA + hstep, voffA);
        if (wr == 1) PG8_BAR;
        PG8_WAIT_V(2); PG8_BAR;
        PG8_STAGE(PG8_SB(1, 0), cB + kstep, voffB); PG8_STAGE(PG8_SA(1, 0), cA + kstep, voffA); PG8_STAGE(PG8_SB(1, 1), cB + hstep + kstep, voffB);
        PG8_WAIT_V(6); PG8_BAR;
    } else {
        PG8_STAGE(PG8_SB(0, 0), cB, voffB); PG8_STAGE(PG8_SA(0, 0), cA, voffA); PG8_STAGE(PG8_SB(0, 1), cB + hstep, voffB); PG8_STAGE(PG8_SA(0, 1), cA + hstep, voffA);
        if (wr == 1) PG8_BAR;
        PG8_WAIT_V(4); PG8_BAR;
        PG8_STAGE(PG8_SB(1, 0), cB + kstep, voffB); PG8_STAGE(PG8_SA(1, 0), cA + kstep, voffA); PG8_STAGE(PG8_SB(1, 1), cB + hstep + kstep, voffB);
        PG8_WAIT_V(6); PG8_BAR;
    }
    const long long dA = g.nt1 > 0 ? (long long)((const char*)g.A2 - (const char*)g.A) - (long long)g.nt1 * (long long)kstep : 0ll, dB = g.nt1 > 0 ? (long long)((const char*)g.Bt2 - (const char*)g.Bt) - (long long)g.nt1 * (long long)kstep : 0ll;
    for (;;) {
        const bool has_next = S.next(ui + 1, nxt);
        const char* nA = has_next ? (const char*)g.A + (size_t)nxt.pm * tstep + (size_t)nxt.ko * 2 : cA; const char* nB = has_next ? (const char*)g.Bt + (size_t)nxt.pn * tstep + (size_t)nxt.ko * 2 + (g.pnsplit > 0 && nxt.pn >= g.pnsplit ? g.bt2off : 0ll) : cB;
#pragma unroll 1
        for (int t = 0; t < nt; t += 2) {
            const bool last = (t == nt - 2);
            const long long o1 = (g.nt1 > 0 && t + 1 >= g.nt1) ? 1ll : 0ll, o2 = (g.nt1 > 0 && t + 2 >= g.nt1) ? 1ll : 0ll;
            const char* a1 = cA + (size_t)(t + 1) * kstep + o1 * dA;
            const char* a2 = last ? nA : cA + (size_t)(t + 2) * kstep + o2 * dA; const char* b2 = last ? nB : cB + (size_t)(t + 2) * kstep + o2 * dB;
            if constexpr (epi_has_mid<Epi>::value) { if (g.nt1 > 0 && t == g.nt1) { const int t2_ = mk_lane(); E.mid(acc, cur, wr, wc, t2_ & 15, t2_ >> 4); } }
            const char* a3 = a2 + kstep; const char* b3 = b2 + kstep;
            if (last && has_next) S.a_ready(nxt);
            if constexpr (SP2) {
            PG8_LDB(B0, 0, 0); PG8_LDB(B1, 0, 1); PG8_SCHED; PG8_LDA(At, 0, 0); PG8_STAGE(PG8_SA(1, 1), a1 + hstep, voffA);
            PG8_WAIT_V(8); PG8_WAIT_L(0); PG8_BAR; PG8_MM(0, 0, At, B0); PG8_MM(0, 1, At, B1); PG8_BAR; PG8_SCHED;
            PG8_LDA(At, 0, 1); PG8_STAGE(PG8_SB(0, 0), b2, voffB); PG8_STAGE(PG8_SB(0, 1), b2 + hstep, voffB); PG8_STAGE(PG8_SA(0, 0), a2, voffA);
            PG8_WAIT_V(8); PG8_WAIT_L(0); PG8_BAR; PG8_MM(1, 0, At, B0); PG8_MM(1, 1, At, B1); PG8_BAR; PG8_SCHED;
            PG8_LDB(B0, 1, 0); PG8_LDB(B1, 1, 1); PG8_SCHED; PG8_LDA(At, 1, 0); PG8_STAGE(PG8_SA(0, 1), a2 + hstep, voffA);
            PG8_WAIT_V(8); PG8_WAIT_L(0); PG8_BAR; PG8_MM(0, 0, At, B0); PG8_MM(0, 1, At, B1); PG8_BAR; PG8_SCHED;
            PG8_LDA(At, 1, 1); PG8_STAGE(PG8_SB(1, 0), b3, voffB); PG8_STAGE(PG8_SB(1, 1), b3 + hstep, voffB); PG8_STAGE(PG8_SA(1, 0), a3, voffA);
            PG8_WAIT_V(8); PG8_WAIT_L(0); PG8_BAR; PG8_MM(1, 0, At, B0); PG8_MM(1, 1, At, B1); PG8_BAR; PG8_SCHED;
            } else {
            PG8_LDB(B0, 0, 0); PG8_SCHED; PG8_LDA(At, 0, 0); PG8_STAGE(PG8_SA(1, 1), a1 + hstep, voffA);
            PG8_WAIT_L(8); PG8_BAR; PG8_WAIT_L(0); PG8_MM(0, 0, At, B0); PG8_BAR; PG8_SCHED;
            PG8_LDB(B1, 0, 1); PG8_STAGE(PG8_SB(0, 0), b2, voffB);
            PG8_BAR; PG8_WAIT_L(0); PG8_MM(0, 1, At, B1); PG8_BAR;
            PG8_LDA(At, 0, 1); PG8_STAGE(PG8_SA(0, 0), a2, voffA);
            PG8_BAR; PG8_WAIT_L(0); PG8_MM(1, 0, At, B0); PG8_BAR; PG8_SCHED;
            PG8_STAGE(PG8_SB(0, 1), b2 + hstep, voffB);
            PG8_WAIT_V(6); PG8_BAR; PG8_MM(1, 1, At, B1); PG8_BAR;
            PG8_LDB(B0, 1, 0); PG8_SCHED; PG8_LDA(At, 1, 0); PG8_STAGE(PG8_SA(0, 1), a2 + hstep, voffA);
            PG8_WAIT_L(8); PG8_BAR; PG8_WAIT_L(0); PG8_MM(0, 0, At, B0); PG8_BAR; PG8_SCHED;
            PG8_LDB(B1, 1, 1); PG8_STAGE(PG8_SB(1, 0), b3, voffB);
            PG8_BAR; PG8_WAIT_L(0); PG8_MM(0, 1, At, B1); PG8_BAR;
            PG8_LDA(At, 1, 1); PG8_STAGE(PG8_SA(1, 0), a3, voffA);
            PG8_BAR; PG8_WAIT_L(0); PG8_MM(1, 0, At, B0); PG8_BAR; PG8_SCHED;
            PG8_STAGE(PG8_SB(1, 1), b3 + hstep, voffB);
            PG8_WAIT_V(6); PG8_BAR; PG8_MM(1, 1, At, B1); PG8_BAR;
            }
        }
        if constexpr (ALIGN_EPI) { if (wr == 0) PG8_BAR; }
        if constexpr (!Epi::AFTER_DRAIN) { int fr_ = fr, fq_ = fq; if constexpr (F8 || epi_has_mid<Epi>::value) { int t2_ = (int)__builtin_amdgcn_mbcnt_hi(~0u, __builtin_amdgcn_mbcnt_lo(~0u, 0u)); asm volatile("" : "+v"(t2_)); fr_ = t2_ & 15; fq_ = t2_ >> 4; }   E(acc, cur, wr, wc, fr_, fq_); S.done(cur); }
        if (!has_next) break;
#pragma unroll
        for (int a = 0; a < 2; ++a)
#pragma unroll
            for (int b = 0; b < 2; ++b)
#pragma unroll
                for (int m = 0; m < 4; ++m)
#pragma unroll
                    for (int n = 0; n < 2; ++n) acc[a][b][m][n] = (f32x4){0.f, 0.f, 0.f, 0.f};
        cur = nxt; cA = nA; cB = nB; ++ui;
        if constexpr (ALIGN_EPI) { if (wr == 1) PG8_BAR; }
    }
    PG8_WAIT_V(0);
    if constexpr (!ALIGN_EPI) { if (wr == 0) PG8_BAR; }
    PG8_BAR;
    if constexpr (Epi::AFTER_DRAIN) { E.fused(acc, cur, wr, wc, fr, fq, lds, wid, lane); S.done(cur); }
#undef PG8_SA
#undef PG8_SB
#undef PG8_STAGE
#undef PG8_LDA
#undef PG8_LDB
#undef PG8_MMA
#undef PG8_MMA8
#undef PG8_MM
#undef PG8_WAIT_V
#undef PG8_WAIT_L
#undef PG8_BAR
#undef PG8_SCHED
}
}
#include <hip/hip_bf16.h>
#include <cmath>
namespace attn_body {
using bf16=__hip_bfloat16;
using bf16x8=__attribute__((ext_vector_type(8)))short;
using s16x4=__attribute__((ext_vector_type(4)))short;
using f32x16=__attribute__((ext_vector_type(16)))float;
using u32x4=__attribute__((ext_vector_type(4)))unsigned;
constexpr int BATCH=2,NHEAD=8,SEQ=8192,D=64,DM=NHEAD*D;
constexpr int NW=8,QBLK=32,QB=QBLK*NW,KVBLK=64,NQB=SEQ/QB;
constexpr int ATTN_PITCH=DM, ATTN_UNIT_ROWS=QB;
__device__ __forceinline__ int crow(int r,int hi){return (r&3)+8*(r>>2)+4*hi;}
#define SBAR() __builtin_amdgcn_sched_barrier(0)
typedef const __attribute__((address_space(4))) unsigned long long* cmask_ptr;
__device__ __forceinline__ float msel(unsigned long long m,float if_set,float if_clear){float r;asm("v_cndmask_b32_e64 %0, %1, %2, %3":"=v"(r):"v"(if_clear),"v"(if_set),"s"(m));return r;}
typedef unsigned long long u64x8 __attribute__((ext_vector_type(8)));
__device__ __forceinline__ void mload16(u64x8&a,u64x8&b,unsigned long long base,int t){
  const __attribute__((address_space(4))) u64x8* p=(const __attribute__((address_space(4))) u64x8*)(base+(unsigned long long)t*256ull);
  a=p[0];b=p[1];
}
__device__ __forceinline__ void mkc16(f32x16&c,const u64x8&a,const u64x8&b,float negmh,float ninf){
  #pragma unroll
  for(int r=0;r<8;++r){c[r]=msel(a[r],negmh,ninf);c[8+r]=msel(b[r],negmh,ninf);}
}

constexpr int NSLOT=3, SLOTB=8192;
constexpr int LDS_K=0, LDS_V=NSLOT*SLOTB, LDS_WS=2*NSLOT*SLOTB, LDS_OST=LDS_WS+NW*64*4, LDS_BYTES=LDS_OST+NW*4096;
constexpr float C2=0.125f*1.4426950408889634f;
__device__ __forceinline__ void glds16(const void*gsrc,unsigned lds_dst){unsigned keep;
  asm volatile("s_mov_b32 %0, m0\n\ts_mov_b32 m0, %2\n\ts_nop 0\n\tglobal_load_lds_dwordx4 %1, off\n\ts_mov_b32 m0, %0":"=&s"(keep):"v"(gsrc),"s"(lds_dst):"memory");}
__device__ __forceinline__ float max3f(float a,float b,float c){float r;asm("v_max3_f32 %0, %1, %2, %3":"=v"(r):"v"(a),"v"(b),"v"(c));return r;}
__device__ __forceinline__ float max2f(float a,float b){float r;asm("v_max_f32_e32 %0, %1, %2":"=v"(r):"v"(a),"v"(b));return r;}
__device__ __forceinline__ float fadd_s(float a,float b){float r;asm("v_add_f32_e32 %0, %1, %2":"=v"(r):"v"(a),"v"(b));return r;}
__device__ __forceinline__ float fsub_s(float a,float b){float r;asm("v_sub_f32_e32 %0, %1, %2":"=v"(r):"v"(a),"v"(b));return r;}
typedef float f32x2_t __attribute__((ext_vector_type(2))); typedef __bf16 bf16x2_t __attribute__((ext_vector_type(2)));
__device__ __forceinline__ unsigned cvtpk_s(float lo,float hi){f32x2_t v={lo,hi};bf16x2_t b=__builtin_convertvector(v,bf16x2_t);return __builtin_bit_cast(unsigned,b);}
#define WAIT_BAR(N) do{ asm volatile("s_waitcnt vmcnt(" #N ") lgkmcnt(0)\n\ts_barrier":::"memory"); __builtin_amdgcn_s_waitcnt(0xC07F); }while(0)

__device__ __forceinline__ void qkt(f32x16&p0,f32x16&p1,const char*Kslot,const bf16x8*qr,int r32,int hi){
  const char*kb=Kslot+hi*1024+r32*16;
  #pragma unroll
  for(int d0=0;d0<4;++d0){
    const bf16x8 b0=*reinterpret_cast<const bf16x8*>(kb+d0*2048);
    const bf16x8 b1=*reinterpret_cast<const bf16x8*>(kb+d0*2048+512);
    p0=__builtin_amdgcn_mfma_f32_32x32x16_bf16(b0,qr[d0],p0,0,0,0);p1=__builtin_amdgcn_mfma_f32_32x32x16_bf16(b1,qr[d0],p1,0,0,0);}
}
typedef __attribute__((address_space(3))) const char* lds_cptr;
typedef short v4i16_t __attribute__((ext_vector_type(4)));
__device__ __forceinline__ void kload8(bf16x8*kf,lds_cptr kp){
  kf[0]=*(const __attribute__((address_space(3))) bf16x8*)(kp);      kf[1]=*(const __attribute__((address_space(3))) bf16x8*)(kp+512);
  kf[2]=*(const __attribute__((address_space(3))) bf16x8*)(kp+2048); kf[3]=*(const __attribute__((address_space(3))) bf16x8*)(kp+2560);
  kf[4]=*(const __attribute__((address_space(3))) bf16x8*)(kp+4096); kf[5]=*(const __attribute__((address_space(3))) bf16x8*)(kp+4608);
  kf[6]=*(const __attribute__((address_space(3))) bf16x8*)(kp+6144); kf[7]=*(const __attribute__((address_space(3))) bf16x8*)(kp+6656);
}
__device__ __forceinline__ void kload2(bf16x8*kf,lds_cptr kp,int j){ kf[2*j]=*(const __attribute__((address_space(3))) bf16x8*)(kp+j*2048); kf[2*j+1]=*(const __attribute__((address_space(3))) bf16x8*)(kp+j*2048+512); }
__device__ __forceinline__ s16x4 vtr(lds_cptr p){ return __builtin_bit_cast(s16x4,__builtin_amdgcn_ds_read_tr16_b64_v4i16((__attribute__((address_space(3))) v4i16_t*)p)); }
__device__ __forceinline__ float rowmax(const f32x16&p0,const f32x16&p1){
  float a=max3f(p0[0],p0[1],p1[0]),b=max3f(p0[2],p0[3],p1[1]);a=max3f(a,p1[2],p1[3]);
  #pragma unroll
  for(int r=4;r<16;r+=4){a=max3f(a,p0[r],p0[r+1]);b=max3f(b,p0[r+2],p0[r+3]);a=max3f(a,p1[r],p1[r+1]);b=max3f(b,p1[r+2],p1[r+3]);}
  const float m=max2f(a,b);
  auto rr=__builtin_amdgcn_permlane32_swap(__float_as_uint(m),__float_as_uint(m),false,false);
  return max2f(__uint_as_float(rr[0]),__uint_as_float(rr[1]));
}
__device__ __forceinline__ void pv(f32x16*o,int vb,bf16x8 pa0,bf16x8 pa1,bf16x8 pa2,bf16x8 pa3){
  #pragma unroll
  for(int d0=0;d0<2;++d0){s16x4 lo[4],hi[4];
    #pragma unroll
    for(int ks=0;ks<4;++ks){
      asm volatile("ds_read_b64_tr_b16 %0,%1 offset:%c2":"=&v"(lo[ks]):"v"(vb),"i"(d0*4096+ks*1024):"memory");
      asm volatile("ds_read_b64_tr_b16 %0,%1 offset:%c2":"=&v"(hi[ks]):"v"(vb),"i"(d0*4096+ks*1024+512):"memory");}
    asm volatile("s_waitcnt lgkmcnt(0)":::"memory");SBAR();
    #define PK(k) (bf16x8){lo[k][0],lo[k][1],lo[k][2],lo[k][3],hi[k][0],hi[k][1],hi[k][2],hi[k][3]}
    o[d0]=__builtin_amdgcn_mfma_f32_32x32x16_bf16(pa0,PK(0),o[d0],0,0,0);
    o[d0]=__builtin_amdgcn_mfma_f32_32x32x16_bf16(pa1,PK(1),o[d0],0,0,0);
    o[d0]=__builtin_amdgcn_mfma_f32_32x32x16_bf16(pa2,PK(2),o[d0],0,0,0);
    o[d0]=__builtin_amdgcn_mfma_f32_32x32x16_bf16(pa3,PK(3),o[d0],0,0,0);
    #undef PK
  }
}

#ifndef ATTN_STORE16
#define ATTN_STORE16(p,v) (*(u32x4*)(p)=(v))
#endif
template<int THRL> __device__ __forceinline__ void attn_unit(int b,int h,int qb,const bf16*Q,const bf16*__restrict__ K,const bf16*__restrict__ V,bf16*O,const unsigned long long*MASK,char*shm,const int wv){
  int wv_=wv; asm volatile("":"+s"(wv_)); int tid_=wv_*64+mk_lane(); asm volatile("":"+v"(tid_)); const int tid=tid_,lane=tid&63,r32=lane&31,hi=lane>>5; const int wid=wv_;
  const long rowbase=(long)b*SEQ; const int q0=qb*QB;
  const bf16*Qw=Q+(rowbase+q0+wid*QBLK)*DM+h*D;
  const bf16*Kh=K+rowbase*DM+h*D,*Vh=V+rowbase*DM+h*D;
  const unsigned lds0=(unsigned)(uintptr_t)shm;
  float*wsf=(float*)(shm+LDS_WS)+wid*64;
  const bf16*ksrc=Kh+(long)lane*DM+wid*8;
  const bf16*vsrc=Vh+(long)(16*(wid&3)+(lane>>2))*DM+(wid>>2)*32+(lane&3)*8;
  const unsigned kdst=lds0+LDS_K+wid*1024, vdst=lds0+LDS_V+wid*1024;
  #define DMA_K(t,slot) glds16(ksrc+(long)(t)*KVBLK*DM,(unsigned)__builtin_amdgcn_readfirstlane(kdst+(slot)))
  #define DMA_V(t,slot) glds16(vsrc+(long)(t)*KVBLK*DM,(unsigned)__builtin_amdgcn_readfirstlane(vdst+(slot)))
  const int vb0=(int)(lds0+LDS_V)+((lane>>4)&1)*32+(lane&3)*8+(4*hi+((lane&15)>>2))*64;
  const char*Kbase=shm+LDS_K; bf16x8 kf[8];
  const lds_cptr shm3=(lds_cptr)shm; const lds_cptr kp0=shm3+LDS_K+hi*1024+r32*16; const lds_cptr vp0=shm3+LDS_V+((lane>>4)&1)*32+(lane&3)*8+(4*hi+((lane&15)>>2))*64;
  const int NT=(q0+QB)/KVBLK;
  DMA_K(0,0);DMA_V(0,0);DMA_K(1,SLOTB);
  bf16x8 qr[4];
  #pragma unroll
  for(int d0=0;d0<4;++d0)qr[d0]=*reinterpret_cast<const bf16x8*>(&Qw[(long)r32*DM+d0*16+hi*8]);
  float mhat=0.f,l_reg=0.f,negmh=0.f;f32x16 o[2];o[0]=f32x16{};o[1]=f32x16{};float NINF=-INFINITY;asm volatile("":"+v"(NINF));
  unsigned long long mbase=(unsigned long long)(uintptr_t)(MASK+((size_t)((b*256+qb*8+wid)*128))*32);asm volatile("":"+s"(mbase));
  bool resc=false;
  #define RESC() do{ if(resc){ asm volatile("s_waitcnt lgkmcnt(0)":::"memory"); \
      _Pragma("unroll") for(int d_=0;d_<2;++d_) _Pragma("unroll") for(int r=0;r<16;++r)o[d_][r]*=wsf[crow(r,hi)]; } }while(0)
  f32x16 pA0,pA1,pB0,pB1;
  int sl_prev=0,sl_cur=0,sl_next=SLOTB;
  #define ROT() do{sl_prev=sl_cur;sl_cur=sl_next;sl_next=(sl_next==(NSLOT-1)*SLOTB)?0:sl_next+SLOTB;}while(0)
  DMA_K(2,2*SLOTB);
  WAIT_BAR(3);
  u64x8 mA0,mA1,mB0,mB1;
  mload16(mA0,mA1,mbase,0);mload16(mB0,mB1,mbase+128ull,0);
  mkc16(pA0,mA0,mA1,negmh,NINF);mkc16(pA1,mB0,mB1,negmh,NINF);SBAR();
  mload16(mA0,mA1,mbase,1);mload16(mB0,mB1,mbase+128ull,1);SBAR();
  qkt(pA0,pA1,Kbase,qr,r32,hi);asm volatile("s_nop 15\n\ts_nop 7":"+v"(pA0),"+v"(pA1));
  { const float rm=rowmax(pA0,pA1);
    if(__any(rm>(float)THRL)){ const float dl=__builtin_fmaxf(rm,0.f); mhat+=dl; negmh=-mhat;
      _Pragma("unroll") for(int r=0;r<16;++r){pA0[r]-=dl;pA1[r]-=dl;} } }
  _Pragma("unroll") for(int r=0;r<16;++r){pA0[r]=__builtin_amdgcn_exp2f(pA0[r]);pA1[r]=__builtin_amdgcn_exp2f(pA1[r]);}
  WAIT_BAR(0);
  DMA_K(3,0);DMA_V(1,SLOTB);
  ROT();
  kload8(kf,kp0+sl_cur);
  WAIT_BAR(2);
  s16x4 vlo[8],vhi[8]; u32x4 pw0,pw1,pw2,pw3;
  #define PKW(P,B) cvtpk_s(P[B],P[B+1])
  #define PAF(k) __builtin_bit_cast(bf16x8,pw##k)
  #define VFR(i) (bf16x8){vlo[i][0],vlo[i][1],vlo[i][2],vlo[i][3],vhi[i][0],vhi[i][1],vhi[i][2],vhi[i][3]}
  #define PIN(x) asm volatile("":"+v"(x))
  #define MX3(a,b,c) __builtin_fmaxf(__builtin_fmaxf((a),(b)),(c))
  #define GAPA(MF,A0,A1,A2,A3,W0,W1,PW) do{ MF; sacc+=A0; sacc+=A1; sacc+=A2; sacc+=A3; PIN(sacc); W0; W1; PIN(PW); SBAR(); }while(0)
  #define EX(v) __builtin_amdgcn_exp2f(v)
  #define GAPB(MF,X,B) do{ MF; X[B]=EX(X[B]); X[B+1]=EX(X[B+1]); X[B+2]=EX(X[B+2]); X[B+3]=EX(X[B+3]); PIN(X); SBAR(); }while(0)
  #define VRD(i) do{ vlo[i]=vtr(vp_+(((i)>>2)*4096+((i)&3)*1024)); vhi[i]=vtr(vp_+(((i)>>2)*4096+((i)&3)*1024+512)); }while(0)
  #define KRD(G,j) do{ if(G){ kload2(kf,kp0+sl_next,j); SBAR(); } }while(0)
  #define STEP(C0,C1,P0,P1,t,GK,GV,GL) do{ SBAR(); \
    mkc16(C0,mA0,mA1,negmh,NINF); SBAR(); \
    const lds_cptr vp_=vp0+sl_prev; \
    VRD(0); SBAR(); float sacc=(P0[0]+P0[1]); \
    GAPA(C0=__builtin_amdgcn_mfma_f32_32x32x16_bf16(kf[0],qr[0],C0,0,0,0), P0[2],P0[3],P0[4],P0[5],     pw0[0]=PKW(P0,0), pw0[1]=PKW(P0,2), pw0); \
    mkc16(C1,mB0,mB1,negmh,NINF); SBAR(); { const int tn_=((t)+1<NT)?(t)+1:(t); mload16(mA0,mA1,mbase,tn_); mload16(mB0,mB1,mbase+128ull,tn_); } SBAR();     \
    VRD(4); SBAR(); GAPA(C1=__builtin_amdgcn_mfma_f32_32x32x16_bf16(kf[1],qr[0],C1,0,0,0), P0[6],P0[7],P0[8],P0[9],     pw0[2]=PKW(P0,4), pw0[3]=PKW(P0,6), pw0); \
    VRD(1); SBAR(); GAPA(C0=__builtin_amdgcn_mfma_f32_32x32x16_bf16(kf[2],qr[1],C0,0,0,0),   P0[10],P0[11],P0[12],P0[13], pw1[0]=PKW(P0,8), pw1[1]=PKW(P0,10), pw1); \
    VRD(5); SBAR(); GAPA(C1=__builtin_amdgcn_mfma_f32_32x32x16_bf16(kf[3],qr[1],C1,0,0,0),   P0[14],P0[15],P1[0],P1[1],   pw1[2]=PKW(P0,12),pw1[3]=PKW(P0,14), pw1); \
    VRD(2); SBAR(); GAPA(C0=__builtin_amdgcn_mfma_f32_32x32x16_bf16(kf[4],qr[2],C0,0,0,0),   P1[2],P1[3],P1[4],P1[5],     pw2[0]=PKW(P1,0), pw2[1]=PKW(P1,2), pw2); \
    VRD(6); SBAR(); GAPA(C1=__builtin_amdgcn_mfma_f32_32x32x16_bf16(kf[5],qr[2],C1,0,0,0),   P1[6],P1[7],P1[8],P1[9],     pw2[2]=PKW(P1,4), pw2[3]=PKW(P1,6), pw2); \
    VRD(3); SBAR(); GAPA(C0=__builtin_amdgcn_mfma_f32_32x32x16_bf16(kf[6],qr[3],C0,0,0,0),   P1[10],P1[11],P1[12],P1[13], pw3[0]=PKW(P1,8), pw3[1]=PKW(P1,10), pw3); \
    VRD(7); SBAR(); GAPA(C1=__builtin_amdgcn_mfma_f32_32x32x16_bf16(kf[7],qr[3],C1,0,0,0),   P1[14],P1[15],0.f,0.f,       pw3[2]=PKW(P1,12),pw3[3]=PKW(P1,14), pw3); \
    l_reg+=sacc; \
    if(GK){DMA_K((t)+3,sl_cur);} if(GV){DMA_V((t)+1,sl_next);} \
    { float a=MX3(C0[0],C0[1],C1[0]),b=MX3(C0[2],C0[3],C1[1]); a=MX3(a,C1[2],C1[3]); \
      _Pragma("unroll") for(int r=4;r<16;r+=4){a=MX3(a,C0[r],C0[r+1]);b=MX3(b,C0[r+2],C0[r+3]);a=MX3(a,C1[r],C1[r+1]);b=MX3(b,C1[r+2],C1[r+3]);} \
      float rm=__builtin_fmaxf(a,b); { auto rr=__builtin_amdgcn_permlane32_swap(__float_as_uint(rm),__float_as_uint(rm),false,false); rm=__builtin_fmaxf(__uint_as_float(rr[0]),__uint_as_float(rr[1])); } \
      resc=false; \
      if(__builtin_expect(__any(rm>(float)THRL),0)){ const float dl=__builtin_fmaxf(rm,0.f); mhat+=dl; \
        _Pragma("unroll") for(int r=0;r<16;++r){C0[r]-=dl;C1[r]-=dl;} \
        negmh=-mhat; \
        const float f=__builtin_amdgcn_exp2f(-dl); l_reg*=f; if(hi==0)wsf[r32]=f; resc=true; } } \
    SBAR(); \
    GAPB(o[0]=__builtin_amdgcn_mfma_f32_32x32x16_bf16(PAF(0),VFR(0),o[0],0,0,0), C0,0); \
    GAPB(o[1]=__builtin_amdgcn_mfma_f32_32x32x16_bf16(PAF(0),VFR(4),o[1],0,0,0), C0,4); \
    KRD(GL,0); GAPB(o[0]=__builtin_amdgcn_mfma_f32_32x32x16_bf16(PAF(1),VFR(1),o[0],0,0,0), C0,8); \
    KRD(GL,1); GAPB(o[1]=__builtin_amdgcn_mfma_f32_32x32x16_bf16(PAF(1),VFR(5),o[1],0,0,0), C0,12); \
    KRD(GL,2); GAPB(o[0]=__builtin_amdgcn_mfma_f32_32x32x16_bf16(PAF(2),VFR(2),o[0],0,0,0), C1,0); \
    KRD(GL,3); GAPB(o[1]=__builtin_amdgcn_mfma_f32_32x32x16_bf16(PAF(2),VFR(6),o[1],0,0,0), C1,4); \
    GAPB(o[0]=__builtin_amdgcn_mfma_f32_32x32x16_bf16(PAF(3),VFR(3),o[0],0,0,0), C1,8); \
    GAPB(o[1]=__builtin_amdgcn_mfma_f32_32x32x16_bf16(PAF(3),VFR(7),o[1],0,0,0), C1,12); \
    }while(0)
  int t=1;
  for(;t+5<NT;t+=2){
    STEP(pB0,pB1,pA0,pA1,t,true,true,true);     WAIT_BAR(2); RESC(); ROT();
    STEP(pA0,pA1,pB0,pB1,t+1,true,true,true);   WAIT_BAR(2); RESC(); ROT();
  }
  #define ENDW(tt) do{ if((tt)+3<NT){WAIT_BAR(2);} else if((tt)+2<NT){WAIT_BAR(1);} else {WAIT_BAR(0);} }while(0)
  for(;t+1<NT;t+=2){
    STEP(pB0,pB1,pA0,pA1,t,(t+3<NT),(t+1<NT),(t+1<NT));       ENDW(t);   RESC(); ROT();
    STEP(pA0,pA1,pB0,pB1,t+1,(t+4<NT),(t+2<NT),(t+2<NT));     ENDW(t+1); RESC(); ROT();
  }
  STEP(pB0,pB1,pA0,pA1,NT-1,false,false,false); RESC();
  { float sacc=pB0[0]+pB0[1]; _Pragma("unroll") for(int r=2;r<16;++r)sacc+=pB0[r]; _Pragma("unroll") for(int r=0;r<16;++r)sacc+=pB1[r]; l_reg+=sacc;
    pw0=(u32x4){PKW(pB0,0),PKW(pB0,2),PKW(pB0,4),PKW(pB0,6)};pw1=(u32x4){PKW(pB0,8),PKW(pB0,10),PKW(pB0,12),PKW(pB0,14)};pw2=(u32x4){PKW(pB1,0),PKW(pB1,2),PKW(pB1,4),PKW(pB1,6)};pw3=(u32x4){PKW(pB1,8),PKW(pB1,10),PKW(pB1,12),PKW(pB1,14)};
    SBAR(); pv(o,vb0+sl_cur,PAF(0),PAF(1),PAF(2),PAF(3)); }
  #undef PKW
  #undef PAF
  #undef VFR
  #undef PIN
  #undef MX3
  #undef GAPA
  #undef GAPB
  #undef EX
  #undef VRD
  #undef KRD
  #undef STEP
  #undef ENDW
  {auto rr=__builtin_amdgcn_permlane32_swap(__float_as_uint(l_reg),__float_as_uint(l_reg),false,false);l_reg=__uint_as_float(rr[0])+__uint_as_float(rr[1]);}
  if(hi==0)wsf[32+r32]=l_reg;asm volatile("s_waitcnt lgkmcnt(0)":::"memory");
  float rli[16];
  #pragma unroll
  for(int r=0;r<16;++r)rli[r]=__builtin_amdgcn_rcpf(wsf[32+crow(r,hi)]);
  bf16*Ow=O+(rowbase+q0+wid*QBLK)*DM+h*D;
  { bf16*stg=(bf16*)(shm+LDS_OST)+wid*2048;
    #pragma unroll
    for(int r=0;r<16;++r){const int orow=crow(r,hi);
      #pragma unroll
      for(int d0=0;d0<2;++d0)stg[orow*64+d0*32+r32]=__float2bfloat16(o[d0][r]*rli[r]);}
    asm volatile("s_waitcnt lgkmcnt(0)":::"memory");
    #pragma unroll
    for(int i=0;i<4;++i){const int row=i*8+(lane>>3),ch=lane&7; const u32x4 v=*(const u32x4*)(stg+row*64+ch*8); ATTN_STORE16(Ow+(long)row*DM+ch*8,v);} }
  asm volatile("s_waitcnt lgkmcnt(0)\n\ts_barrier":::"memory");
  #undef DMA_K
  #undef DMA_V
  #undef RESC
  #undef ROT
}
constexpr int ATTN_LDS_BYTES=LDS_BYTES;
struct AttnTensors { const bf16* Q; const bf16* K; const bf16* V; bf16* O; const unsigned long long* MASK; };
struct AttnUnit { int bh; int qb; };
struct StaticOrder {
  int vcu,G;
  __device__ __forceinline__ explicit StaticOrder(int grid,int block):vcu((grid%8==0)?(block%8)*(grid/8)+block/8:block),G(grid){}
  __device__ __forceinline__ bool next(int i,AttnUnit&u)const{ const int idx=vcu+i*G; if(idx>=512)return false; const int j=idx&255,s=j&15; u.bh=j>>4; u.qb=(idx<256)?s:31-s; return true; }
  __device__ __forceinline__ void a_ready(const AttnUnit&)const{}
  __device__ __forceinline__ void done(const AttnUnit&)const{}
};
template<class Sched,int THRL=8> __device__ __forceinline__ void attn_phase(char*lds,const AttnTensors&T,const Sched&S,const int wv){
  AttnUnit u;
  for(int i=0;S.next(i,u);++i){ S.a_ready(u); attn_unit<THRL>(u.bh/NHEAD,u.bh%NHEAD,u.qb,T.Q,T.K,T.V,T.O,T.MASK,lds,wv); S.done(u); }
}
#undef SBAR
#undef WAIT_BAR
}
constexpr int NWAVES = 8;
#ifndef MK_PER_PHASE
#define MK_PER_PHASE 0
#endif
constexpr int NPH = 18;

constexpr int BATCH = 2, T = 8192, D = 1024, M = BATCH * T;
constexpr int INW = 4392, INP = 4608;
constexpr int FF = 2816, FFE = 3584, NE = 8;
constexpr int TOPK = 256;
constexpr int MROWS = 34816;
constexpr float EPS = 1e-6f;

constexpr size_t MiB = 1u << 20;
constexpr size_t WS_CTL = 0, CTL_ZERO_BYTES = 1 * MiB;
constexpr size_t WS_TAB16 = 1 * MiB, WS_TAB8 = 1 * MiB + 512 * 1024;
constexpr size_t WS_GAINS = 1 * MiB + 768 * 1024;
constexpr size_t WS_SSQP = 2 * MiB;
constexpr size_t WS_ROUTE = 3 * MiB, WS_POS = 3 * MiB + 256 * 1024;
constexpr size_t WS_GCNT = 3 * MiB + 512 * 1024;
constexpr size_t WS_META = 4 * MiB;
constexpr size_t WS_WIN = 6 * MiB, WS_PA = 24 * MiB, WS_WEFF = 26 * MiB, WS_WOUT = 28 * MiB, WS_W13 = 32 * MiB, WS_W2 = 43 * MiB;
constexpr size_t WS_XB = 52 * MiB;
constexpr size_t WS_U = 84 * MiB, WS_SG = 100 * MiB;
constexpr size_t WS_HB = 84 * MiB;
constexpr size_t WS_Q = 228 * MiB, WS_K = 244 * MiB, WS_V = 260 * MiB, WS_QI = 276 * MiB  , WS_KI = 285 * MiB, WS_WI = 286 * MiB, WS_DIFF = 287 * MiB;
constexpr size_t WS_MASK = 303 * MiB;
constexpr size_t WS_T1 = 335 * MiB, WS_MB = 367 * MiB;
constexpr size_t WS_X8 = WS_T1;
constexpr size_t WS_AO = 399 * MiB;
constexpr size_t WS_SLAB = 84 * MiB;
constexpr size_t DO_W2E = 0, DO_W13E = 28 * MiB;
constexpr int W13E_SPLIT = 5;
constexpr size_t WS_W13E = 84 * MiB, WS_W2E = 140 * MiB, WS_AP = 174 * MiB, WS_Y = 208 * MiB, WS_HE = 280 * MiB, WS_END = 480 * MiB;
static_assert(WS_XB + (size_t)M * D * 2 <= WS_W13E && WS_SLAB + (size_t)32 * 7 * 65536 * 4 <= WS_W2E && WS_W13E + (size_t)NE * 2 * FFE * D <= WS_W2E && WS_W2E + (size_t)NE * D * FFE <= WS_AP && WS_AP + (size_t)MROWS * D <= WS_Y && WS_Y + (size_t)MROWS * D * 2 <= WS_HE && WS_HE + (size_t)MROWS * FFE <= WS_END, "MoE map");
static_assert(WS_SG + (size_t)M * 2048 * 2 <= WS_Q && WS_MB + (size_t)M * D * 2 <= WS_END && WS_W2 + (size_t)D * FF * 2 <= WS_XB && WS_HB + (size_t)M * FF * 2 <= WS_Q, "layer map");
constexpr int CW_BAR = 4096;
constexpr int CW_CNT = 16384;
constexpr int CW_CUR = 16384 + 64 * 8;
constexpr int CW_WQ = 16384 + 64 * 16;

constexpr int RING_OFF = 0, RING_BYTES = 131072;
constexpr int LDSCTL_OFF = 151808, MISC_OFF = LDSCTL_OFF + 320;
constexpr int SEL_OFF = 152576;
constexpr int LDS_BYTES = 163840;
static_assert(MISC_OFF + 128 <= SEL_OFF && SEL_OFF + 4096 <= LDS_BYTES, "LDS map");

#define GAS __attribute__((address_space(1)))
#define LAS __attribute__((address_space(3)))
typedef unsigned short bf16;
typedef unsigned v4u __attribute__((ext_vector_type(4)));
typedef float f32x4 __attribute__((ext_vector_type(4)));
typedef short bf16x8 __attribute__((ext_vector_type(8)));
typedef GAS unsigned gu32;
typedef GAS unsigned long long gu64;
#define RLX_AGENT __ATOMIC_RELAXED, __HIP_MEMORY_SCOPE_AGENT
#define LDS_WAIT() asm volatile("s_waitcnt lgkmcnt(0)" ::: "memory")
#define VM_WAIT() asm volatile("s_waitcnt vmcnt(0)" ::: "memory")
__device__ __forceinline__ unsigned long long rt() { return __builtin_amdgcn_s_memrealtime(); }
__device__ __forceinline__ unsigned f2bf(float f) { unsigned u = __builtin_bit_cast(unsigned, f); return (u + 0x7fffu + ((u >> 16) & 1u)) >> 16; }
__device__ __forceinline__ unsigned pk2(float lo, float hi) { return pg8::cvt_pk_bf16(lo, hi); }

#define XB_TMO      128
#define XB_XCNT(j)  (256  + 64 * (j))
#define XB_XSUB(j)  (1280 + 64 * (j))
#define XB_XGEN(j)  (2304 + 64 * (j))
#define XB_TOP      3328
#define XB_TOPGEN   3392
#define XCD_BAR_WORDS 3456
#define XB_SPIN_CAP (1u << 18)

__device__ __forceinline__ unsigned xb_ld(unsigned* p)              { return __hip_atomic_load(p, __ATOMIC_RELAXED, __HIP_MEMORY_SCOPE_AGENT); }
__device__ __forceinline__ unsigned xb_add(unsigned* p, unsigned v) { return __hip_atomic_fetch_add(p, v, __ATOMIC_RELAXED, __HIP_MEMORY_SCOPE_AGENT); }
__device__ __forceinline__ unsigned xb_xcc_id() { return (unsigned)__builtin_amdgcn_s_getreg((3 << 11) | 20) & 0xFu; }
#define XB_SPIN(cond, bar) do { unsigned _sp = 0; while (cond) { __builtin_amdgcn_s_sleep(1); \
    if ((++_sp & 255u) == 0u) { if (xb_ld(&(bar)[XB_TMO])) break; if (_sp > XB_SPIN_CAP) { atomicAdd(&(bar)[XB_TMO], 1u); break; } } } } while (0)

struct XcdBarrier {
    unsigned* bar; unsigned x; int wv;
    volatile LAS unsigned* st;
};

__device__ __forceinline__ XcdBarrier xcd_barrier_post(unsigned* bar, volatile LAS unsigned* st, int wv) {
    XcdBarrier b; b.bar = bar; b.x = xb_xcc_id(); b.st = st; b.wv = wv;
    if (wv == 0 && mk_lane() == 0) (void)xb_add(&bar[XB_XCNT(b.x)], 1u);
    return b;
}
__device__ __forceinline__ void xcd_barrier_complete(unsigned* bar, unsigned x, unsigned& nloc, unsigned& nx) {
    const unsigned G = gridDim.x * gridDim.y * gridDim.z;
    unsigned sum, cnt, mine, sp = 0u;
    for (;;) {
        sum = 0u; cnt = 0u; mine = 0u;
#pragma unroll
        for (unsigned j = 0; j < 16; ++j) { const unsigned c = xb_ld(&bar[XB_XCNT(j)]); sum += c; cnt += (c > 0u) ? 1u : 0u; mine = (j == x) ? c : mine; }
        if (sum == G) break;
        __builtin_amdgcn_s_sleep(1);
        if ((++sp & 255u) == 0u) { if (xb_ld(&bar[XB_TMO])) break; if (sp > XB_SPIN_CAP) { atomicAdd(&bar[XB_TMO], 1u); break; } }
    }
    nloc = mine > 0u ? mine : 1u; nx = cnt > 0u ? cnt : 1u;
}

__device__ __forceinline__ void xcd_barrier(const XcdBarrier& b) {
    asm volatile("s_waitcnt vmcnt(0)" ::: "memory");
    __syncthreads();
    if (b.wv == 0 && mk_lane() == 0) {
        unsigned* bar = b.bar;
        __builtin_amdgcn_s_waitcnt(0);
        unsigned nloc = b.st[0], nx = b.st[1];
        if (nloc == 0u) { xcd_barrier_complete(bar, b.x, nloc, nx); b.st[0] = nloc; b.st[1] = nx; }
        const unsigned old = xb_add(&bar[XB_XSUB(b.x)], 1u);
        const unsigned gen = old / nloc;
        if (old + 1u == (gen + 1u) * nloc) {
            __builtin_amdgcn_fence(__ATOMIC_RELEASE, "agent");
            asm volatile("s_waitcnt vmcnt(0)" ::: "memory");
            const unsigned og = xb_add(&bar[XB_TOP], 1u);
            const unsigned tg = og / nx;
            if (og + 1u == (tg + 1u) * nx) xb_add(&bar[XB_TOPGEN], 1u);
            else XB_SPIN(xb_ld(&bar[XB_TOPGEN]) == tg, bar);
            __builtin_amdgcn_fence(__ATOMIC_ACQUIRE, "agent");
            xb_add(&bar[XB_XGEN(b.x)], 1u);
            asm volatile("s_waitcnt vmcnt(0)" ::: "memory");
        } else {
            XB_SPIN(xb_ld(&bar[XB_XGEN(b.x)]) == gen, bar);
            __builtin_amdgcn_fence(__ATOMIC_ACQUIRE, "agent");
            asm volatile("s_waitcnt vmcnt(0)" ::: "memory");
        }
    }
    __syncthreads();
}

namespace pg8 {
struct EpiInProj {
    static constexpr bool PERM = true, AFTER_DRAIN = false;
    unsigned char* ws; const float* gains; float c2;
    __device__ __forceinline__ void operator()(const f32x4 (&acc)[2][2][4][2], const Unit& u, int wr, int wc, int fr, int fq) const {
        const int row0 = u.pm * BM + wr * 64 + fr, pn = u.pn; const float* ssqp = (const float*)(ws + WS_SSQP);
        float rsv[8];
#pragma unroll
        for (int k = 0; k < 8; ++k) rsv[k] = 0.f;
        rstd8(ssqp, row0, fr, fq, rsv, 1.f);
        if (pn < 4) {
            const bool isq = pn < 2; const int head = 4 * (pn & 1) + wc; const float* g = gains + (isq ? 0 : 64); const f32x2* t16 = (const f32x2*)(ws + WS_TAB16);
            const int db0 = fq == 0 ? 0 : 8 * fq + 8, db1 = fq == 0 ? 8 : 8 * fq + 32;
            const f32x4 g00 = *(const f32x4*)(g + db0), g01 = *(const f32x4*)(g + db0 + 4), g10 = *(const f32x4*)(g + db1), g11 = *(const f32x4*)(g + db1 + 4);
            bf16_t* dst = (bf16_t*)(ws + (isq ? WS_Q : WS_K)) + head * 64; const float sc = isq ? c2 : 1.f;
#pragma unroll
            for (int ai = 0; ai < 2; ++ai)
#pragma unroll
                for (int m = 0; m < 4; ++m) { const int row = row0 + ai * HALF + m * 16; const float rs = rsv[ai * 4 + m];
                    f32x4 a0 = acc[ai][0][m][0] * rs, a1 = acc[ai][0][m][1] * rs, b0 = acc[ai][1][m][0] * rs, b1 = acc[ai][1][m][1] * rs;
                    float ss = ((a0[0] * a0[0] + a0[1] * a0[1]) + (a0[2] * a0[2] + a0[3] * a0[3])) + ((a1[0] * a1[0] + a1[1] * a1[1]) + (a1[2] * a1[2] + a1[3] * a1[3]))
                             + ((b0[0] * b0[0] + b0[1] * b0[1]) + (b0[2] * b0[2] + b0[3] * b0[3])) + ((b1[0] * b1[0] + b1[1] * b1[1]) + (b1[2] * b1[2] + b1[3] * b1[3]));
                    ss += __shfl_xor(ss, 16); ss += __shfl_xor(ss, 32);
                    const float rn = __builtin_amdgcn_rsqf(ss * (1.f / 64.f) + 1e-6f);
                    a0 = a0 * rn * g00; a1 = a1 * rn * g01; b0 = b0 * rn * g10; b1 = b1 * rn * g11;
                    if (fq == 0) { const f32x2* cs = t16 + (size_t)(row & 8191) * 8;
#pragma unroll
                        for (int j = 0; j < 4; ++j) { const f32x2 c0 = cs[j], c1 = cs[4 + j]; const float x1 = a0[j], x2 = b0[j], y1 = a1[j], y2 = b1[j];
                            a0[j] = x1 * c0.x - x2 * c0.y; b0[j] = x2 * c0.x + x1 * c0.y; a1[j] = y1 * c1.x - y2 * c1.y; b1[j] = y2 * c1.x + y1 * c1.y; } }
                    *(u32x4*)(dst + (size_t)row * 512 + db0) = pack8(a0 * sc, a1 * sc); *(u32x4*)(dst + (size_t)row * 512 + db1) = pack8(b0 * sc, b1 * sc); }
        } else if (pn == 6 || pn == 7) {
            const int col8 = wc * 32 + 8 * fq; const f32x2* t8 = (const f32x2*)(ws + WS_TAB8); bf16_t* QI = (bf16_t*)(ws + WS_QI); bf16_t* KI = (bf16_t*)(ws + WS_KI); float* WI = (float*)(ws + WS_WI);
#pragma unroll
            for (int ai = 0; ai < 2; ++ai)
#pragma unroll
                for (int m = 0; m < 4; ++m) { const int row = row0 + ai * HALF + m * 16; const float rs = rsv[ai * 4 + m]; const f32x2* cs = t8 + (size_t)(row & 8191) * 4;
#pragma unroll
                    for (int bj = 0; bj < 2; ++bj) { f32x4 a0 = acc[ai][bj][m][0] * rs, a1 = acc[ai][bj][m][1] * rs;
                        if (pn == 6 || (bj == 0 && wc == 0)) {
                            if (fq == 0) {
#pragma unroll
                                for (int j = 0; j < 4; ++j) { const f32x2 c = cs[j]; const float x1 = a0[j], x2 = a1[j]; a0[j] = x1 * c.x - x2 * c.y; a1[j] = x2 * c.x + x1 * c.y; } }
                            if (pn == 6) *(u32x4*)(QI + (size_t)row * 288 + bj * HALF + col8) = pack8(a0, a1); else *(u32x4*)(KI + (size_t)row * 32 + 8 * fq) = pack8(a0, a1); }
                        else if (bj == 0 && wc == 1 && fq == 0) { *(f32x4*)(WI + (size_t)row * 8) = a0 * 0.03125f; *(f32x4*)(WI + (size_t)row * 8 + 4) = a1 * 0.03125f; } } }
        } else {
            const bool sg = pn >= 10; const int ld = sg ? 2048 : 512, colt = (pn < 6 ? pn - 4 : pn < 10 ? pn - 8 : pn - 10) * BM;
            bf16_t* dst = (bf16_t*)(ws + (pn < 6 ? WS_V : pn < 10 ? WS_U : WS_SG));
            const int col0 = colt + wc * 32 + 8 * fq;
#pragma unroll
            for (int ai = 0; ai < 2; ++ai)
#pragma unroll
                for (int m = 0; m < 4; ++m) { const int row = row0 + ai * HALF + m * 16; const float rs = rsv[ai * 4 + m];
#pragma unroll
                    for (int bj = 0; bj < 2; ++bj) { f32x4 a0 = acc[ai][bj][m][0] * rs, a1 = acc[ai][bj][m][1] * rs;
                        if (sg) {
#pragma unroll
                            for (int i = 0; i < 4; ++i) { a0[i] = fsigmoid(a0[i]); a1[i] = fsigmoid(a1[i]); } }
                        *(u32x4*)(dst + (size_t)row * ld + col0 + bj * HALF) = pack8(a0, a1); } }
        }
    }
};
}
struct Frame {
    LAS unsigned char* lds;
    volatile LAS unsigned* MISC;
    gu32* ctl;
    int tid, lane, wave;
    int vcu, G;
    unsigned char* ws;
    float* out;
};
__device__ __forceinline__ float wave_sum(float v) {
#pragma unroll
    for (int o = 1; o < 64; o <<= 1) v += __shfl_xor(v, o);
    return v;
}
__device__ __forceinline__ float bfl(unsigned w) { return __uint_as_float(w << 16); }
__device__ __forceinline__ float bfh(unsigned w) { return __uint_as_float(w & 0xffff0000u); }
__device__ __forceinline__ void unpk8(const v4u w, float (&v)[8]) { v[0] = bfl(w.x); v[1] = bfh(w.x); v[2] = bfl(w.y); v[3] = bfh(w.y); v[4] = bfl(w.z); v[5] = bfh(w.z); v[6] = bfl(w.w); v[7] = bfh(w.w); }
__device__ __forceinline__ v4u pk8(const float (&v)[8]) { v4u o; o.x = pk2(v[0], v[1]); o.y = pk2(v[2], v[3]); o.z = pk2(v[4], v[5]); o.w = pk2(v[6], v[7]); return o; }

struct RowMap { int mode, a;
    __device__ __forceinline__ int operator()(int n) const {
        if (mode == 0) return a + n;
        if (mode == 2) return 256 * (n >> 7) + (n & 127) + a;
        if (n >= 1832) return n + 216;
        if (n >= 1024) return n;
        const int h = (n & 511) >> 6, d = n & 63, wc = h & 3, base = (n & ~511) + 256 * (h >> 2);
        return base + (d < 8 ? 32 * wc + d : d < 16 ? 128 + 32 * wc + d - 8 : d < 40 ? 32 * wc + d - 8 : 128 + 32 * wc + d - 32); } };
constexpr float MOE_SX = 8.f, MOE_SW1 = 64.f, MOE_SH = 8.f, MOE_SW2 = 128.f;
struct TrS { const float* W; bf16* WT; const float* gain; float scale; int K, N, k0, n0, f8; RowMap mp; };
__device__ __forceinline__ void tr32_load(const TrS& t, f32x4 (&v)[8], float (&gv)[8], int lane) {
    const int nq = t.n0 + 4 * (lane & 7), kr = lane >> 3; const bool okn = nq < t.N;
    const float* gp = t.gain ? t.gain + t.k0 : t.W; const float gsc = t.f8 ? t.scale : 1.f;
#pragma unroll
    for (int i = 0; i < 8; ++i) { const float gl = gp[8 * i + kr]; gv[i] = (t.gain ? gl : 1.f) * gsc; }
#pragma unroll
    for (int i = 0; i < 8; ++i) v[i] = okn ? __builtin_nontemporal_load((const GAS f32x4*)(t.W + (size_t)(t.k0 + 8 * i + kr) * t.N + nq)) : (f32x4){0.f, 0.f, 0.f, 0.f};
}
__device__ __forceinline__ void tr32_store(const TrS& t, const f32x4 (&v)[8], const float (&gv)[8], LAS float* scr, int lane) {
    const int kr = lane >> 3;
#pragma unroll
    for (int i = 0; i < 8; ++i) { const int kk = 8 * i + kr; const float g = gv[i]; LAS float* d = scr + kk * 33 + 4 * (lane & 7);
        d[0] = v[i].x * g; d[1] = v[i].y * g; d[2] = v[i].z * g; d[3] = v[i].w * g; }
    LDS_WAIT(); asm volatile("" ::: "memory");
    const int c = lane & 7;
#pragma unroll
    for (int j = 0; j < 4; ++j) { const int n = (lane >> 3) + 8 * j;
        if (t.n0 + n < t.N) { const LAS float* s = scr + (8 * c) * 33 + n;
            if (t.f8) { pg8::u32x2 o; o.x = pg8::pk4_fp8((f32x4){s[0 * 33], s[1 * 33], s[2 * 33], s[3 * 33]}); o.y = pg8::pk4_fp8((f32x4){s[4 * 33], s[5 * 33], s[6 * 33], s[7 * 33]});
                *(GAS pg8::u32x2*)((unsigned char*)t.WT + (size_t)t.mp(t.n0 + n) * t.K + t.k0 + 8 * c) = o; }
            else { v4u o; o.x = pk2(s[0 * 33], s[1 * 33]); o.y = pk2(s[2 * 33], s[3 * 33]); o.z = pk2(s[4 * 33], s[5 * 33]); o.w = pk2(s[6 * 33], s[7 * 33]);
                *(GAS v4u*)(t.WT + (size_t)t.mp(t.n0 + n) * t.K + t.k0 + 8 * c) = o; } } }
    LDS_WAIT(); asm volatile("" ::: "memory");
}
struct TrItem { const float* W; unsigned char* WT; const float* gain; float scale; int K, N, k0, n0; RowMap mp; };
__device__ __forceinline__ void tr64_load(const TrItem& t, f32x4 (&v)[16], float (&gv)[16], int lane) {
    const int nq = t.n0 + 4 * (lane & 15), kr = lane >> 4;
    const float* gp = t.gain ? t.gain + t.k0 : t.W;
#pragma unroll
    for (int i = 0; i < 16; ++i) { const float gl = gp[4 * i + kr]; gv[i] = (t.gain ? gl : 1.f) * t.scale; }
#pragma unroll
    for (int i = 0; i < 16; ++i) v[i] = __builtin_nontemporal_load((const GAS f32x4*)(t.W + (size_t)(t.k0 + 4 * i + kr) * t.N + nq));
}
__device__ __forceinline__ void tr64_store(const TrItem& t, const f32x4 (&v)[16], const float (&gv)[16], LAS float* scr, int lane) {
    const int kr = lane >> 4;
#pragma unroll
    for (int i = 0; i < 16; ++i) { const int kk = 4 * i + kr; const float g = gv[i]; LAS float* d = scr + kk * 65 + 4 * (lane & 15);
        d[0] = v[i].x * g; d[1] = v[i].y * g; d[2] = v[i].z * g; d[3] = v[i].w * g; }
    LDS_WAIT(); asm volatile("" ::: "memory");
    const int c = lane & 7;
#pragma unroll
    for (int j = 0; j < 8; ++j) { const int n = (lane >> 3) + 8 * j; const LAS float* s = scr + (8 * c) * 65 + n;
        pg8::u32x2 o; o.x = pg8::pk4_fp8((f32x4){s[0 * 65], s[1 * 65], s[2 * 65], s[3 * 65]}); o.y = pg8::pk4_fp8((f32x4){s[4 * 65], s[5 * 65], s[6 * 65], s[7 * 65]});
        __builtin_nontemporal_store(o, (GAS pg8::u32x2*)(t.WT + (size_t)t.mp(t.n0 + n) * t.K + t.k0 + 8 * c)); }
    LDS_WAIT(); asm volatile("" ::: "memory");
}
__device__ __forceinline__ float inv16(int i) { return i == 0 ? 1.0f : i == 1 ? 0.1939227432012558f : i == 2 ? 0.03760603070259094f : i == 3 ? 0.007292664609849453f : i == 4 ? 0.0014142135623842478f : i == 5 ? 0.00027424818836152554f : i == 6 ? 5.3182957344688475e-05f : 1.0313385246263351e-05f; }
__device__ __forceinline__ float2 cs_of(float ang) {
    const double a = (double)ang, k = __builtin_rint(a * 0.15915494309189535), r = a - k * 6.283185307179586;
    const float rr = (float)(r * 0.15915494309189535);
    return make_float2(__builtin_amdgcn_cosf(rr), __builtin_amdgcn_sinf(rr));
}

__device__ __forceinline__ void p0_prologue(Frame& F, const float* const* in) {
    LAS float* scr = (LAS float*)(F.lds + RING_OFF + F.wave * 16384);
    int lane_ = F.lane; asm volatile("" : "+v"(lane_)); const int gw = F.vcu * NWAVES + F.wave, NGW = F.G * NWAVES, lane = lane_;
    const float* x = in[0];
    constexpr int I_WIN = 16 * 138, I_PA = 8 * 32, I_WO = 16 * 32, I_W1 = 16 * 88, I_W2 = 44 * 32;
    constexpr int I_L = I_WIN + I_PA + I_WO, NIT = 2 * I_L + 2 * I_W1 + I_W2;
    auto item = [&](int it) -> TrS { TrS t; int r = it; t.scale = 1.f; t.f8 = 0; t.gain = nullptr; t.mp = RowMap{0, 0};
        if (r < 2 * I_L) { const int L = r / I_L; r -= L * I_L;
            if (r < I_WIN) { t.W = in[2] + (size_t)L * D * INW; t.K = D; t.N = INW; t.WT = (bf16*)(F.ws + WS_WIN) + (size_t)L * INP * D; t.gain = in[1] + L * D; t.mp = RowMap{1, 0}; }
            else if (r < I_WIN + I_PA) { r -= I_WIN; t.W = in[7] + (size_t)L * 512 * D; t.K = 512; t.N = D; t.WT = (bf16*)(F.ws + WS_PA) + (size_t)L * D * 512; }
            else { r -= I_WIN + I_PA; t.W = in[9] + (size_t)L * D * D; t.K = D; t.N = D; t.WT = (bf16*)(F.ws + WS_WOUT) + (size_t)L * D * D; } }
        else { r -= 2 * I_L; t.f8 = 1;
            if (r < 2 * I_W1) { const bool third = r >= I_W1; if (third) r -= I_W1; t.W = third ? in[12] : in[11]; t.K = D; t.N = FF; t.WT = (bf16*)(F.ws + WS_W13); t.gain = in[10]; t.mp = RowMap{2, third ? 128 : 0}; t.scale = MOE_SW1; }
            else { r -= 2 * I_W1; t.W = in[13]; t.K = FF; t.N = D; t.WT = (bf16*)(F.ws + WS_W2); t.scale = MOE_SW2; } }
        const int nblk = (t.N + 31) / 32; t.k0 = 64 * (r / nblk); t.n0 = 32 * (r % nblk); return t; };
    if (gw < NIT) { int it = gw; TrS a = item(it), b = a; f32x4 v[8], vn[8]; float gv[8], gn[8]; tr32_load(a, v, gv, lane);
        for (;;) {
            { const int nx = it + NGW; const bool more = nx < NIT; if (more) { b = item(nx); tr32_load(b, vn, gn, lane); } tr32_store(a, v, gv, scr, lane); if (!more) break; it = nx; }
            { const int nx = it + NGW; const bool more = nx < NIT; if (more) { a = item(nx); tr32_load(a, v, gv, lane); } tr32_store(b, vn, gn, scr, lane); if (!more) break; it = nx; } } }
    for (int it = gw; it < 2 * 216; it += NGW) { const int L = it / 216, rr = 1832 + it % 216; GAS v4u* o = (GAS v4u*)((bf16*)(F.ws + WS_WIN) + ((size_t)L * INP + rr) * D) + lane; o[0] = (v4u){0u, 0u, 0u, 0u}; o[64] = (v4u){0u, 0u, 0u, 0u}; }
    for (int it = gw; it < 2 * 4 * 16 * 8; it += NGW) {
        const int cc = it & 7, nb = (it >> 3) & 15, g = (it >> 7) & 3, L = it >> 9; const int n = nb * 64 + lane, c0 = cc * 16;
        const float* wp = in[5] + ((size_t)(L * 4 + g) * 128 + c0) * 128; const float* ps = in[6] + L * 512 + g * 128; const float* pb = in[8] + ((size_t)L * 512 + g * 128) * D + n;
        float acc[16];
#pragma unroll
        for (int c = 0; c < 16; ++c) acc[c] = 0.f;
        { const GAS f32x4* wsrc = (const GAS f32x4*)wp + lane; const GAS f32x4* psv = (const GAS f32x4*)ps;
#pragma unroll
          for (int i = 0; i < 8; ++i) { const int idx = i * 64 + lane; *(LAS f32x4*)(scr + 4 * idx) = wsrc[64 * i] * psv[idx & 31]; } }
        LDS_WAIT(); asm volatile("" ::: "memory");
        for (int d0 = 0; d0 < 128; d0 += 32) {
            float v[32];
#pragma unroll
            for (int dd = 0; dd < 32; ++dd) v[dd] = pb[(size_t)(d0 + dd) * D];
#pragma unroll
            for (int c = 0; c < 16; ++c) {
#pragma unroll
                for (int q4 = 0; q4 < 8; ++q4) { const f32x4 a4 = *(const LAS f32x4*)(scr + c * 128 + d0 + 4 * q4);
                    acc[c] += (a4.x * v[4 * q4] + a4.y * v[4 * q4 + 1]) + (a4.z * v[4 * q4 + 2] + a4.w * v[4 * q4 + 3]); } } }
        LDS_WAIT(); asm volatile("" ::: "memory");
        GAS v4u* o = (GAS v4u*)((bf16*)(F.ws + WS_WEFF) + ((size_t)L * D + n) * 512 + g * 128 + c0);
        v4u o0, o1; o0.x = pk2(acc[0], acc[1]); o0.y = pk2(acc[2], acc[3]); o0.z = pk2(acc[4], acc[5]); o0.w = pk2(acc[6], acc[7]); o1.x = pk2(acc[8], acc[9]); o1.y = pk2(acc[10], acc[11]); o1.z = pk2(acc[12], acc[13]); o1.w = pk2(acc[14], acc[15]);
        o[0] = o0; o[1] = o1;
    }
    if (gw == 0) { for (int i = lane; i < 256; i += 64) { const int L = i >> 7, j = i & 127; ((float*)(F.ws + WS_GAINS))[i] = j < 64 ? in[3][L * 64 + j] : in[4][L * 64 + j - 64]; } }
    { float2* t16 = (float2*)(F.ws + WS_TAB16); float2* t8 = (float2*)(F.ws + WS_TAB8);
      for (int i = gw * 64 + lane; i < T * 12; i += NGW * 64) { const int t = i / 12, j = i % 12;
          if (j < 8) t16[t * 8 + j] = cs_of((float)t * inv16(j)); else t8[t * 4 + (j - 8)] = cs_of((float)t * inv16(2 * (j - 8))); } }
    for (int m = gw; m < M; m += 4 * NGW) {
        f32x4 va[4][4]; int mr[4];
#pragma unroll
        for (int k = 0; k < 4; ++k) { mr[k] = m + k * NGW < M ? m + k * NGW : m; const GAS f32x4* xa = (const GAS f32x4*)(x + (size_t)mr[k] * D) + lane;
#pragma unroll
            for (int j = 0; j < 4; ++j) va[k][j] = xa[64 * j]; }
#pragma unroll
        for (int k = 0; k < 4; ++k) { float sa = 0.f;
#pragma unroll
            for (int j = 0; j < 4; ++j) sa += (va[k][j].x * va[k][j].x + va[k][j].y * va[k][j].y) + (va[k][j].z * va[k][j].z + va[k][j].w * va[k][j].w);
            sa = wave_sum(sa);
            GAS unsigned long long* oa = (GAS unsigned long long*)((bf16*)(F.ws + WS_XB) + (size_t)mr[k] * D) + lane;
#pragma unroll
            for (int j = 0; j < 4; ++j) oa[64 * j] = (unsigned long long)pk2(va[k][j].x, va[k][j].y) | ((unsigned long long)pk2(va[k][j].z, va[k][j].w) << 32);
            if (lane < 16) ((float*)(F.ws + WS_SSQP))[(size_t)mr[k] * 16 + lane] = lane == 0 ? sa : 0.f; }
    }
}

__device__ __forceinline__ void diff_rows(Frame& F) {
    int lane_ = F.lane; asm volatile("" : "+v"(lane_)); const int gw = F.vcu * NWAVES + F.wave, NGW = F.G * NWAVES, l = lane_;
    const bf16* U = (const bf16*)(F.ws + WS_U) + 8 * l; const int w = 2 << (l >> 4);
    for (int blk = gw; blk < M / 8; blk += NGW) {
        const int r0 = blk * 8, t0 = r0 & (T - 1);
        v4u pi[16], pc[8], po[8];
#pragma unroll
        for (int j = 1; j <= 16; ++j) { const bool ok = j <= w && t0 >= j; pi[j - 1] = *(const GAS v4u*)(U + (size_t)(ok ? r0 - j : r0) * 512); if (!ok) pi[j - 1] = (v4u){0u, 0u, 0u, 0u}; }
#pragma unroll
        for (int i = 0; i < 8; ++i) { pc[i] = *(const GAS v4u*)(U + (size_t)(r0 + i) * 512); const bool ok = t0 + i >= w; po[i] = *(const GAS v4u*)(U + (size_t)(ok ? r0 + i - w : r0) * 512); if (!ok) po[i] = (v4u){0u, 0u, 0u, 0u}; }
        float S[8];
#pragma unroll
        for (int c = 0; c < 8; ++c) S[c] = 0.f;
#pragma unroll
        for (int j = 0; j < 16; ++j) { float a[8]; unpk8(pi[j], a);
#pragma unroll
            for (int c = 0; c < 8; ++c) S[c] += a[c]; }
#pragma unroll
        for (int i = 0; i < 8; ++i) { float cu[8], ol[8], o[8]; unpk8(pc[i], cu); unpk8(po[i], ol); const int t = t0 + i; const float inv = 1.f / (float)((t + 1) < w ? (t + 1) : w);
#pragma unroll
            for (int c = 0; c < 8; ++c) { S[c] += cu[c] - ol[c]; o[c] = S[c] * inv - cu[c]; }
            *(GAS v4u*)((bf16*)(F.ws + WS_DIFF) + (size_t)(r0 + i) * 512 + 8 * l) = pk8(o); }
    }
}

namespace topk {
typedef float f32x16 __attribute__((ext_vector_type(16)));
constexpr int HROW = 1025;
constexpr int ST_OFF = 32 * HROW * 4;
constexpr int BQ_OFF = ST_OFF + 512, BQ_PITCH = 624;
static_assert(BQ_OFF + 32 * BQ_PITCH <= LDSCTL_OFF && BQ_OFF % 16 == 0, "top-k LDS map");
constexpr int CAND = 1024;
__device__ __forceinline__ unsigned okey(float s) { const unsigned u = __float_as_uint(s); return u ^ ((unsigned)((int)u >> 31) | 0x80000000u); }
__device__ __forceinline__ int crow(int r, int hi) { return (r & 3) + 8 * (r >> 2) + 4 * hi; }
__device__ __forceinline__ unsigned wave_suffix_incl(unsigned c) {
    unsigned v = c;
    v += (unsigned)__builtin_amdgcn_update_dpp(0, (int)v, 0x111, 0xf, 0xf, false);
    v += (unsigned)__builtin_amdgcn_update_dpp(0, (int)v, 0x112, 0xf, 0xf, false);
    v += (unsigned)__builtin_amdgcn_update_dpp(0, (int)v, 0x114, 0xf, 0xf, false);
    v += (unsigned)__builtin_amdgcn_update_dpp(0, (int)v, 0x118, 0xf, 0xf, false);
    v += (unsigned)__builtin_amdgcn_update_dpp(0, (int)v, 0x142, 0xa, 0xf, false);
    v += (unsigned)__builtin_amdgcn_update_dpp(0, (int)v, 0x143, 0xc, 0xf, false);
    const unsigned total = (unsigned)__builtin_amdgcn_readlane((int)v, 63);
    return total - v + c;
}
template <int NB, bool PACKED> __device__ __forceinline__ void scan_row(const LAS unsigned* hrow, unsigned k, int lane, LAS unsigned* pref, LAS unsigned* krem, LAS unsigned* nbin, int shift, unsigned add) {
    constexpr int WPL = PACKED ? NB / 128 : NB / 64;
    unsigned wv[WPL], c = 0;
#pragma unroll
    for (int i = 0; i < WPL; ++i) { wv[i] = hrow[lane * WPL + i]; c += PACKED ? (wv[i] & 0xffffu) + (wv[i] >> 16) : wv[i]; }
    unsigned incl = c;
    incl = wave_suffix_incl(c);
    const unsigned above = incl - c;
    if (above < k && k <= incl) {
        unsigned cum = above, bin = 0, kr = 1, nb = 1; bool found = false;
#pragma unroll
        for (int i = WPL - 1; i >= 0; --i) {
            if (PACKED) {
                unsigned h = wv[i] >> 16; if (!found && cum + h >= k) { found = true; bin = (unsigned)(lane * WPL + i) * 2u + 1u; kr = k - cum; nb = h; } cum += h;
                h = wv[i] & 0xffffu;       if (!found && cum + h >= k) { found = true; bin = (unsigned)(lane * WPL + i) * 2u;      kr = k - cum; nb = h; } cum += h;
            } else { const unsigned h = wv[i]; if (!found && cum + h >= k) { found = true; bin = (unsigned)(lane * WPL + i); kr = k - cum; nb = h; } cum += h; } }
        *pref = ((*pref << shift) | bin) + add; *krem = kr; *nbin = nb;
    }
}
#define TOPK_VALID(r) (!DIAG || (((r) & 3) + 8 * ((r) >> 2)) <= lim2_)
#define TOPK_LIM() const int lim2_ = qabs - tile * 64 - 32 * p - 4 * hi
template <bool DIAG, bool ALL> __device__ __forceinline__ void hist_gen(const float (&sv)[16], int p, int tile, int qabs, int hi, LAS unsigned* hrow, unsigned pref, int sh, int bsh, unsigned bmask) { TOPK_LIM();
#pragma unroll
    for (int r = 0; r < 16; ++r) { const unsigned key = okey(sv[r]);
        if (TOPK_VALID(r) && (ALL || (key >> sh) == pref)) {
            if (ALL) { unsigned ad, inc;
                asm("v_bfe_u32 %0, %2, 22, 10\n\tv_bfe_u32 %1, %2, 21, 1\n\tv_lshl_add_u32 %0, %0, 2, %3\n\tv_mad_u32_u24 %1, %1, %4, 1" : "=&v"(ad), "=&v"(inc) : "v"(key), "v"((unsigned)(uintptr_t)hrow), "s"(0xffffu));
                __hip_atomic_fetch_add((LAS unsigned*)(uintptr_t)ad, inc, __ATOMIC_RELAXED, __HIP_MEMORY_SCOPE_WORKGROUP); }
            else { const unsigned bin = (key >> bsh) & bmask; __hip_atomic_fetch_add(hrow + (bin >> 1), 1u << (16 * (bin & 1u)), __ATOMIC_RELAXED, __HIP_MEMORY_SCOPE_WORKGROUP); } } }
}
template <bool DIAG> __device__ __forceinline__ void cand_half(const float (&sv)[16], int p, int tile, int qabs, int hi, LAS unsigned* lrow, LAS unsigned* lc, unsigned pref, int sh) { TOPK_LIM();
    unsigned m = 0u;
#pragma unroll
    for (int r = 0; r < 16; ++r) { if (TOPK_VALID(r) && (okey(sv[r]) >> sh) == pref) m |= 1u << r; }
    if (m) { unsigned at = __hip_atomic_fetch_add(lc, (unsigned)__popc(m), __ATOMIC_RELAXED, __HIP_MEMORY_SCOPE_WORKGROUP);
#pragma unroll
        for (int r = 0; r < 16; ++r) if (m & (1u << r)) { if (at < (unsigned)CAND) lrow[at] = okey(sv[r]); ++at; } }
}
#define TOPK_CMP8(OP) asm volatile(OP " %0, %8, %16\n\t" OP " %1, %9, %16\n\t" OP " %2, %10, %16\n\t" OP " %3, %11, %16\n\t" OP " %4, %12, %16\n\t" OP " %5, %13, %16\n\t" OP " %6, %14, %16\n\t" OP " %7, %15, %16" \
        : "=s"(c[0]), "=s"(c[1]), "=s"(c[2]), "=s"(c[3]), "=s"(c[4]), "=s"(c[5]), "=s"(c[6]), "=s"(c[7]) : "v"(x[0]), "v"(x[1]), "v"(x[2]), "v"(x[3]), "v"(x[4]), "v"(x[5]), "v"(x[6]), "v"(x[7]), "v"(thr))
template <bool DIAG, int FAST> __device__ __forceinline__ void mask_half(const float (&sv)[16], int p, int tile, int qabs, int hi, unsigned thr, unsigned& mlo, unsigned& mhi) { TOPK_LIM();
#pragma unroll
    for (int r0 = 0; r0 < 16; r0 += 8) {
        unsigned x[8]; unsigned long long c[8];
#pragma unroll
        for (int i = 0; i < 8; ++i) { const int r = r0 + i; x[i] = FAST == 1 ? __float_as_uint(sv[r]) : okey(sv[r]);
            if (DIAG) { if (!TOPK_VALID(r)) x[i] = FAST == 1 ? 0x80000000u : 0u; } }
        if (FAST == 1) TOPK_CMP8("v_cmp_ge_i32_e64"); else if (FAST == 2) TOPK_CMP8("v_cmp_gt_u32_e64"); else TOPK_CMP8("v_cmp_ge_u32_e64");
#pragma unroll
        for (int i = 0; i < 8; ++i) { const unsigned lo = (unsigned)c[i], hi2 = (unsigned)(c[i] >> 32);
            if (p == 0) { asm volatile("v_writelane_b32 %0, %1, %2" : "+v"(mlo) : "s"(lo), "i"(r0 + i)); asm volatile("v_writelane_b32 %0, %1, %2" : "+v"(mhi) : "s"(hi2), "i"(r0 + i)); }
            else { asm volatile("v_writelane_b32 %0, %1, %2" : "+v"(mlo) : "s"(lo), "i"(16 + r0 + i)); asm volatile("v_writelane_b32 %0, %1, %2" : "+v"(mhi) : "s"(hi2), "i"(16 + r0 + i)); } }
    }
}
#undef TOPK_CMP8
__device__ __forceinline__ void mask_store(int p, int lane, unsigned long long* mt, unsigned& mlo, unsigned& mhi) { if (p == 1) { if (lane < 32) mt[lane] = ((unsigned long long)mhi << 32) | mlo; mlo = 0u; mhi = 0u; } }
__device__ __forceinline__ unsigned select_row(const LAS unsigned* list, unsigned n, unsigned krem, unsigned pref, int sh, int lane, LAS unsigned* bins) {
    while (sh > 0) {
        const int db = sh < 7 ? sh : 7, nsh = sh - db; const unsigned dm = (1u << db) - 1u;
        bins[2 * lane] = 0u; bins[2 * lane + 1] = 0u;
        asm volatile("s_waitcnt lgkmcnt(0)" ::: "memory");
#pragma unroll
        for (int j = 0; j < 16; ++j) if ((unsigned)(lane + 64 * j) < n) { const unsigned kj = list[lane + 64 * j]; if ((kj >> sh) == pref) __hip_atomic_fetch_add(bins + ((kj >> nsh) & dm), 1u, __ATOMIC_RELAXED, __HIP_MEMORY_SCOPE_WORKGROUP); }
        asm volatile("s_waitcnt lgkmcnt(0)" ::: "memory");
        const unsigned b0 = bins[2 * lane], b1 = bins[2 * lane + 1], c = b0 + b1;
        unsigned incl = c;
        incl = wave_suffix_incl(c);
        const unsigned above = incl - c; const bool mine = above < krem && krem <= incl;
        const unsigned dig = (above + b1 >= krem) ? (unsigned)(2 * lane + 1) : (unsigned)(2 * lane), kr = (above + b1 >= krem) ? krem - above : krem - above - b1;
        const unsigned long long mb = __ballot(mine); const int src = mb ? (int)__builtin_ctzll(mb) : 0;
        pref = (pref << db) | (unsigned)__builtin_amdgcn_readlane((int)dig, src); krem = (unsigned)__builtin_amdgcn_readlane((int)kr, src); sh = nsh;
    }
    return pref;
}
template <bool DIAG> __device__ __forceinline__ void cand_pos_half(const float (&sv)[16], int p, int tile, int qabs, int hi, LAS unsigned* lrow, LAS unsigned* lc, unsigned last) { TOPK_LIM();
    unsigned m = 0u;
#pragma unroll
    for (int r = 0; r < 16; ++r) { if (TOPK_VALID(r) && (last - okey(sv[r])) < 0x200000u) m |= 1u << r; }
    unsigned at = 0u; if (m) at = __hip_atomic_fetch_add(lc, (unsigned)__popc(m), __ATOMIC_RELAXED, __HIP_MEMORY_SCOPE_WORKGROUP);
    const unsigned pb = 8191u - (unsigned)(tile * 64 + 32 * p + 4 * hi);
    while (__any(m != 0u)) {
        const unsigned r = (unsigned)__builtin_ctz(m | 0x10000u);
#define TOPK_SEL(o, b, x, y) float o; { float e0_ = (x), e1_ = (y); asm volatile("" : "+v"(e0_), "+v"(e1_)); o = (r & (b)) ? e1_ : e0_; }
        TOPK_SEL(a0, 1u, sv[0], sv[1]) TOPK_SEL(a1, 1u, sv[2], sv[3]) TOPK_SEL(a2, 1u, sv[4], sv[5]) TOPK_SEL(a3, 1u, sv[6], sv[7]) TOPK_SEL(a4, 1u, sv[8], sv[9]) TOPK_SEL(a5, 1u, sv[10], sv[11]) TOPK_SEL(a6, 1u, sv[12], sv[13]) TOPK_SEL(a7, 1u, sv[14], sv[15])
        TOPK_SEL(b0, 2u, a0, a1) TOPK_SEL(b1, 2u, a2, a3) TOPK_SEL(b2, 2u, a4, a5) TOPK_SEL(b3, 2u, a6, a7)
        TOPK_SEL(c0, 4u, b0, b1) TOPK_SEL(c1, 4u, b2, b3)
        TOPK_SEL(d0, 8u, c0, c1)
#undef TOPK_SEL
        const unsigned key = okey(d0);
        if (m != 0u) { if (at < (unsigned)CAND) lrow[at] = (((key & 0x1fffffu) >> 2) << 13) | (pb - ((r & 3u) + 8u * ((r >> 2) & 3u))); ++at; }
        m &= m - 1u;
    }
}
__device__ __forceinline__ unsigned select_packed(const LAS unsigned* list, unsigned n, unsigned krem, int lane, LAS unsigned* bins) {
    unsigned pref = 0u; int sh = 32;
    while (sh > 0) {
        const int db = sh == 32 ? 5 : (sh < 7 ? sh : 7), nsh = sh - db; const unsigned dm = (1u << db) - 1u;
        bins[2 * lane] = 0u; bins[2 * lane + 1] = 0u;
        asm volatile("s_waitcnt lgkmcnt(0)" ::: "memory");
#pragma unroll
        for (int j = 0; j < 16; ++j) if ((unsigned)(lane + 64 * j) < n) { const unsigned kj = list[lane + 64 * j]; if (sh == 32 || (kj >> sh) == pref) __hip_atomic_fetch_add(bins + ((kj >> nsh) & dm), 1u, __ATOMIC_RELAXED, __HIP_MEMORY_SCOPE_WORKGROUP); }
        asm volatile("s_waitcnt lgkmcnt(0)" ::: "memory");
        const unsigned b0 = bins[2 * lane], b1 = bins[2 * lane + 1], c = b0 + b1;
        unsigned incl = c;
        incl = wave_suffix_incl(c);
        const unsigned above = incl - c; const bool mine = above < krem && krem <= incl; const bool odd = above + b1 >= krem;
        const unsigned dig = odd ? (unsigned)(2 * lane + 1) : (unsigned)(2 * lane), kr = odd ? krem - above : krem - above - b1, nb = odd ? b1 : b0;
        const unsigned long long mb = __ballot(mine); const int src = mb ? (int)__builtin_ctzll(mb) : 0;
        pref = (pref << db) | (unsigned)__builtin_amdgcn_readlane((int)dig, src); krem = (unsigned)__builtin_amdgcn_readlane((int)kr, src); sh = nsh;
        if ((unsigned)__builtin_amdgcn_readlane((int)nb, src) == krem) break;
    }
    return sh > 0 ? pref << sh : pref;
}
}
#undef TOPK_VALID
#undef TOPK_LIM
__device__ __forceinline__ void topk_phase(Frame& F, int L) {
    using namespace topk;
    int tid_ = F.tid; asm volatile("" : "+v"(tid_)); const int tid = tid_, lane = tid & 63, r32 = lane & 31, hi = lane >> 5, wid = F.wave;
    LAS unsigned* hist = (LAS unsigned*)(F.lds + RING_OFF);
    LAS unsigned* pref = (LAS unsigned*)(F.lds + RING_OFF + ST_OFF); LAS unsigned* krem = pref + 32; LAS unsigned* nbin = pref + 64; LAS unsigned* lcnt = pref + 96;
    const bf16* QI = (const bf16*)(F.ws + WS_QI); const bf16* KI = (const bf16*)(F.ws + WS_KI); const float* WI = (const float*)(F.ws + WS_WI);
    unsigned long long* MASK = (unsigned long long*)(F.ws + WS_MASK + (size_t)L * 16 * MiB);
    for (int ui = F.vcu; ui < 512; ui += F.G) {
        const int jj = ui & 255, b = jj >> 7, j32 = ui < 256 ? (jj & 127) : 255 - (jj & 127);
        const int q0 = j32 * 32, ntile = (j32 >> 1) + 1, qabs = q0 + r32; const size_t brow = (size_t)b * T;
        for (int i = tid; i < 32 * 34; i += NWAVES * 64) { const int rw = i / 34, ch = i % 34;
            *(LAS v4u*)(F.lds + RING_OFF + BQ_OFF + rw * BQ_PITCH + (ch < 32 ? ch * 16 : 576 + (ch - 32) * 16)) = ch < 32 ? *(const v4u*)(QI + (brow + q0 + rw) * 288 + ch * 8) : *(const v4u*)(WI + (brow + q0 + rw) * 8 + (ch - 32) * 4); }
        __syncthreads();
        for (int i = tid; i < 32 * 16; i += NWAVES * 64) { const int rw = i >> 4, dp = i & 15; const LAS unsigned char* rb = F.lds + RING_OFF + BQ_OFF + rw * BQ_PITCH;
            float s0 = 0.f, s1 = 0.f;
#pragma unroll
            for (int h = 0; h < 8; ++h) { const unsigned qq = *(const LAS unsigned*)(rb + 64 * h + 4 * dp); const float wv_ = *(const LAS float*)(rb + 576 + 4 * h); s0 += bfl(qq) * wv_; s1 += bfh(qq) * wv_; }
            *(LAS unsigned*)(rb + 512 + 4 * dp) = pk2(s0, s1); }
        const LAS unsigned char* bqp = F.lds + RING_OFF + BQ_OFF + r32 * BQ_PITCH + hi * 16;
#define TOPK_BQ(h, ks) (*(const LAS pg8::bf16x8*)(bqp + 64 * (h) + 32 * (ks)))
        if (tid < 32) { pref[tid] = 0u; krem[tid] = (unsigned)((q0 + tid + 1) < TOPK ? (q0 + tid + 1) : TOPK); nbin[tid] = 0xffffffffu; lcnt[tid] = 0u; }
        LAS unsigned* hrow = hist + r32 * HROW; LAS unsigned* lrow = hist + r32 * CAND;
#define TOPK_MF(A, B, C) __builtin_amdgcn_mfma_f32_32x32x16_bf16(A, B, C, 0, 0, 0)
#define TOPK_KP(tl) (KI + (brow + (size_t)(tl) * 64 + r32) * 32 + hi * 8)
        const unsigned bqa = (unsigned)(uintptr_t)bqp, wqa = bqa - (unsigned)hi * 16u + 576u;
#define TOPK_LDB(B0, B1, h) do { asm volatile("ds_read_b128 %0, %2 offset:%3\n\tds_read_b128 %1, %2 offset:%4" : "=&v"(B0), "=&v"(B1) : "v"(bqa), "i"(64 * (h)), "i"(64 * (h) + 32)); } while (0)
#define TOPK_LDW(W, h) do { asm volatile("ds_read_b32 %0, %1 offset:%2" : "=&v"(W) : "v"(wqa), "i"(4 * (h))); } while (0)
#define TOPK_LWAIT(B0, B1) asm volatile("s_waitcnt lgkmcnt(0)" : "+v"(B0), "+v"(B1))
#define TOPK_SCORES() \
        float sA[16], sB[16]; { pg8::bf16x8 bl0, bl1, bb0[2], bb1[2]; float wv[2]; TOPK_LDB(bl0, bl1, 8); TOPK_LDB(bb0[0], bb1[0], 0); TOPK_LDB(bb0[1], bb1[1], 1); TOPK_LDW(wv[0], 0); TOPK_LDW(wv[1], 1); \
            TOPK_LWAIT(bl0, bl1); TOPK_LWAIT(bb0[0], bb1[0]); \
            f32x16 l0 = TOPK_MF(a00, bl0, f32x16{}), l1 = TOPK_MF(a10, bl0, f32x16{}); l0 = TOPK_MF(a01, bl1, l0); l1 = TOPK_MF(a11, bl1, l1); \
            f32x16 dA = TOPK_MF(a00, bb0[0], f32x16{}), dB = TOPK_MF(a10, bb0[0], f32x16{}); dA = TOPK_MF(a01, bb1[0], dA); dB = TOPK_MF(a11, bb1[0], dB); \
            asm volatile("s_nop 15" : "+v"(l0), "+v"(l1), "+v"(dA), "+v"(dB));     \
            _Pragma("unroll") for (int r = 0; r < 16; ++r) { sA[r] = l0[r]; sB[r] = l1[r]; } \
            _Pragma("unroll") for (int h = 0; h < 8; ++h) { f32x16 dn = f32x16{}; \
                if (h < 7) { TOPK_LWAIT(bb0[(h + 1) & 1], bb1[(h + 1) & 1]); dn = TOPK_MF(a00, bb0[(h + 1) & 1], f32x16{}); asm volatile("" : "+v"(dn)); }     \
                _Pragma("unroll") for (int r = 0; r < 8; ++r) asm volatile("v_fma_f32 %0, |%1|, %2, %0" : "+v"(sA[r]) : "v"(dA[r]), "v"(wv[h & 1])); \
                if (h < 7) { dn = TOPK_MF(a01, bb1[(h + 1) & 1], dn); asm volatile("" : "+v"(dn)); } \
                _Pragma("unroll") for (int r = 8; r < 16; ++r) asm volatile("v_fma_f32 %0, |%1|, %2, %0" : "+v"(sA[r]) : "v"(dA[r]), "v"(wv[h & 1])); \
                asm volatile("" : "+v"(a00), "+v"(a01));     \
                dA = dn; \
                if (h < 7) { dn = TOPK_MF(a10, bb0[(h + 1) & 1], f32x16{}); asm volatile("" : "+v"(dn)); } \
                _Pragma("unroll") for (int r = 0; r < 8; ++r) asm volatile("v_fma_f32 %0, |%1|, %2, %0" : "+v"(sB[r]) : "v"(dB[r]), "v"(wv[h & 1])); \
                if (h < 7) { dn = TOPK_MF(a11, bb1[(h + 1) & 1], dn); asm volatile("" : "+v"(dn)); \
                    if (h < 6) TOPK_LDB(bb0[h & 1], bb1[h & 1], (h + 2) & 7); }     \
                _Pragma("unroll") for (int r = 8; r < 16; ++r) asm volatile("v_fma_f32 %0, |%1|, %2, %0" : "+v"(sB[r]) : "v"(dB[r]), "v"(wv[h & 1])); \
                asm volatile("" : "+v"(a10), "+v"(a11)); \
                dB = dn; if (h < 6) TOPK_LDW(wv[h & 1], (h + 2) & 7); } }
#define TOPK_LOOP(BODY_N, BODY_D) do { int tile = wid; if (tile < ntile) { const bf16* kp_ = TOPK_KP(tile); \
            pg8::bf16x8 a00 = *(const pg8::bf16x8*)kp_, a01 = *(const pg8::bf16x8*)(kp_ + 16), a10 = *(const pg8::bf16x8*)(kp_ + 1024), a11 = *(const pg8::bf16x8*)(kp_ + 1024 + 16); \
            for (;;) { const bool more = tile + NWAVES < ntile; \
                TOPK_SCORES(); \
                if (more) { const bf16* kn_ = TOPK_KP(tile + NWAVES); a00 = *(const pg8::bf16x8*)kn_; a01 = *(const pg8::bf16x8*)(kn_ + 16); a10 = *(const pg8::bf16x8*)(kn_ + 1024); a11 = *(const pg8::bf16x8*)(kn_ + 1024 + 16); }     \
                if (tile == ntile - 1) { { const float (&sv)[16] = sA; const int p = 0; BODY_D; } { const float (&sv)[16] = sB; const int p = 1; BODY_D; } } \
                else { { const float (&sv)[16] = sA; const int p = 0; BODY_N; } { const float (&sv)[16] = sB; const int p = 1; BODY_N; } } \
                if (!more) break; tile += NWAVES; } } } while (0)
#define TOPK_ZERO() do { for (int i = tid; i < 32 * HROW; i += NWAVES * 64) hist[i] = 0u; } while (0)
#define TOPK_SCAN(NB, PACKED, SHIFT, ADD) do { for (int rr = 0; rr < 4; ++rr) { const int row = wid * 4 + rr; scan_row<NB, PACKED>(hist + row * HROW, krem[row], lane, pref + row, krem + row, nbin + row, SHIFT, ADD); } } while (0)
        int sh = 21;
        bool fused = false;
        unsigned long long* mq = MASK + ((size_t)(b * 256 + j32) * 128) * 32; const int nt_att = 4 * (j32 >> 3) + 4;
#define TOPK_MSTORE() mask_store(p, lane, mq + (size_t)tile * 32, mlo, mhi)
        {
        TOPK_ZERO(); __syncthreads();
        TOPK_LOOP((hist_gen<false, true>(sv, p, tile, qabs, hi, hrow, 0u, 0, 21, 2047u)), (hist_gen<true, true>(sv, p, tile, qabs, hi, hrow, 0u, 0, 21, 2047u)));
        __syncthreads();
        TOPK_SCAN(2048, true, 11, 0u);
        __syncthreads();
        bool big = __any(nbin[r32] > (unsigned)CAND);
        fused = !big;
        if (big) {
            TOPK_ZERO(); __syncthreads();
            { const unsigned pf = pref[r32]; TOPK_LOOP((hist_gen<false, false>(sv, p, tile, qabs, hi, hrow, pf, 21, 10, 2047u)), (hist_gen<true, false>(sv, p, tile, qabs, hi, hrow, pf, 21, 10, 2047u))); }
            __syncthreads();
            TOPK_SCAN(2048, true, 11, 0u);
            __syncthreads();
            sh = 10; big = __any(nbin[r32] > (unsigned)CAND);
            if (big) {
                TOPK_ZERO(); __syncthreads();
                { const unsigned pf = pref[r32]; TOPK_LOOP((hist_gen<false, false>(sv, p, tile, qabs, hi, hrow, pf, 10, 0, 1023u)), (hist_gen<true, false>(sv, p, tile, qabs, hi, hrow, pf, 10, 0, 1023u))); }
                __syncthreads();
                TOPK_SCAN(1024, true, 10, 0u);
                __syncthreads();
                sh = 0;
            }
        }
        }
        if (fused) {
            { const unsigned tb = (pref[r32] << 21) | 0x1fffffu; LAS unsigned* lc = lcnt + r32; unsigned mlo = 0u, mhi = 0u;
              TOPK_LOOP((cand_pos_half<false>(sv, p, tile, qabs, hi, lrow, lc, tb), mask_half<false, 2>(sv, p, tile, qabs, hi, tb, mlo, mhi), TOPK_MSTORE()),
                        (cand_pos_half<true>(sv, p, tile, qabs, hi, lrow, lc, tb), mask_half<true, 2>(sv, p, tile, qabs, hi, tb, mlo, mhi), TOPK_MSTORE())); }
            __syncthreads();
            for (int rr = 0; rr < 4; ++rr) { const int row = wid * 4 + rr; const unsigned n = lcnt[row] < (unsigned)CAND ? lcnt[row] : (unsigned)CAND; const LAS unsigned* lst = hist + row * CAND;
                const unsigned thr = select_packed(lst, n, krem[row], lane, (LAS unsigned*)(F.lds + SEL_OFF) + wid * 128);
                for (int j = 0; j < 16; ++j) { const unsigned idx = (unsigned)(lane + 64 * j); if (idx < n) { const unsigned e = lst[idx];
                    if (e >= thr) { const unsigned pos = 8191u - (e & 8191u), c = pos & 31u, wd = (pos >> 6) * 32u + ((pos >> 5) & 1u) * 16u + (c & 3u) + 4u * (c >> 3);
                        __hip_atomic_fetch_or((unsigned*)mq + 2u * wd + ((c >> 2) & 1u), 1u << row, __ATOMIC_RELAXED, __HIP_MEMORY_SCOPE_WORKGROUP); } } } }
        } else {
        if (sh > 0) {
            { const unsigned pf = pref[r32]; LAS unsigned* lc = lcnt + r32; TOPK_LOOP(cand_half<false>(sv, p, tile, qabs, hi, lrow, lc, pf, sh), cand_half<true>(sv, p, tile, qabs, hi, lrow, lc, pf, sh)); }
            __syncthreads();
            for (int rr = 0; rr < 4; ++rr) { const int row = wid * 4 + rr; const unsigned n = lcnt[row] < (unsigned)CAND ? lcnt[row] : (unsigned)CAND;
                const unsigned thr = select_row(hist + row * CAND, n, krem[row], pref[row], sh, lane, (LAS unsigned*)(F.lds + SEL_OFF) + wid * 128);
                if (lane == 0) pref[row] = thr; }
            __syncthreads();
        }
        { const unsigned thr = pref[r32];
          unsigned mlo = 0u, mhi = 0u;
          if (!__any(thr < 0x80000000u)) { const unsigned tb = thr & 0x7fffffffu;
              TOPK_LOOP((mask_half<false, true>(sv, p, tile, qabs, hi, tb, mlo, mhi), TOPK_MSTORE()), (mask_half<true, true>(sv, p, tile, qabs, hi, tb, mlo, mhi), TOPK_MSTORE())); }
          else { TOPK_LOOP((mask_half<false, false>(sv, p, tile, qabs, hi, thr, mlo, mhi), TOPK_MSTORE()), (mask_half<true, false>(sv, p, tile, qabs, hi, thr, mlo, mhi), TOPK_MSTORE())); }
          }
        }
        for (int tile = ntile + wid; tile < nt_att; tile += NWAVES) if (lane < 32) mq[(size_t)tile * 32 + lane] = 0ull;
        __syncthreads();
#undef TOPK_MSTORE
#undef TOPK_SCAN
#undef TOPK_LOOP
#undef TOPK_SCORES
#undef TOPK_KP
#undef TOPK_LDB
#undef TOPK_LDW
#undef TOPK_LWAIT
#undef TOPK_MF
#undef TOPK_BQ
#undef TOPK_ZERO
    }
}

__device__ __forceinline__ void route_phase(Frame& F, const float* gain, const float* wr) {
    const int lane = F.lane;
    volatile LAS unsigned* lcnt = F.MISC + 16;
    f32x4 wga[4][4], wgb[4][4];
#pragma unroll
    for (int j = 0; j < 4; ++j) { const int c0 = 8 * lane + 512 * (j >> 1) + 4 * (j & 1); const f32x4 g4 = *(const f32x4*)(gain + c0);
#pragma unroll
        for (int i = 0; i < 4; ++i) { wga[j][i] = *(const f32x4*)(wr + (size_t)(c0 + i) * 8) * g4[i]; wgb[j][i] = *(const f32x4*)(wr + (size_t)(c0 + i) * 8 + 4) * g4[i]; } }
    for (int grp = blockIdx.x; grp < M / 64; grp += F.G) {
#pragma unroll 2
    for (int ti = 0; ti < 8; ++ti) { const int m = grp * 64 + F.wave * 8 + ti;
        const GAS v4u* xr = (const GAS v4u*)((const bf16*)(F.ws + WS_XB) + (size_t)m * D) + lane; f32x4 v[4]; float s = 0.f;
#pragma unroll
        for (int jj = 0; jj < 2; ++jj) { const v4u w = xr[64 * jj]; v[2 * jj] = (f32x4){bfl(w.x), bfh(w.x), bfl(w.y), bfh(w.y)}; v[2 * jj + 1] = (f32x4){bfl(w.z), bfh(w.z), bfl(w.w), bfh(w.w)}; }
#pragma unroll
        for (int j = 0; j < 4; ++j) s += (v[j].x * v[j].x + v[j].y * v[j].y) + (v[j].z * v[j].z + v[j].w * v[j].w);
        const float rstd = __builtin_amdgcn_rsqf(wave_sum(s) * (1.f / D) + EPS);
        float lg[8];
#pragma unroll
        for (int e = 0; e < 8; ++e) lg[e] = 0.f;
#pragma unroll
        for (int j = 0; j < 4; ++j) {
#pragma unroll
            for (int i = 0; i < 4; ++i) { const float h = v[j][i]; const f32x4 wa = wga[j][i], wb = wgb[j][i];
                lg[0] += h * wa.x; lg[1] += h * wa.y; lg[2] += h * wa.z; lg[3] += h * wa.w; lg[4] += h * wb.x; lg[5] += h * wb.y; lg[6] += h * wb.z; lg[7] += h * wb.w; } }
#pragma unroll
        for (int e = 0; e < 8; ++e) lg[e] = lg[e];
        {
            float a4[4], a2[2], a1;
            { const bool up = (lane & 32) != 0;
#pragma unroll
              for (int i = 0; i < 4; ++i) { const float keep = up ? lg[4 + i] : lg[i], send = up ? lg[i] : lg[4 + i]; a4[i] = keep + __shfl_xor(send, 32); } }
            { const bool up = (lane & 16) != 0;
#pragma unroll
              for (int i = 0; i < 2; ++i) { const float keep = up ? a4[2 + i] : a4[i], send = up ? a4[i] : a4[2 + i]; a2[i] = keep + __shfl_xor(send, 16); } }
            { const bool up = (lane & 8) != 0; const float keep = up ? a2[1] : a2[0], send = up ? a2[0] : a2[1]; a1 = keep + __shfl_xor(send, 8); }
            a1 += __shfl_xor(a1, 4); a1 += __shfl_xor(a1, 2); a1 += __shfl_xor(a1, 1);
#pragma unroll
            for (int e = 0; e < 8; ++e) lg[e] = __int_as_float(__builtin_amdgcn_readlane(__float_as_int(a1), 32 * (e >> 2) + 16 * ((e >> 1) & 1) + 8 * (e & 1))) * rstd;
        }
        int e0 = 0; float l0 = lg[0];
#pragma unroll
        for (int e = 1; e < 8; ++e) if (lg[e] > l0) { l0 = lg[e]; e0 = e; }
        int e1 = -1; float l1 = -INFINITY;
#pragma unroll
        for (int e = 0; e < 8; ++e) if (e != e0 && lg[e] > l1) { l1 = lg[e]; e1 = e; }
        const float g1 = 1.f / (1.f + __expf(l0 - l1)), g0 = 1.f - g1;
        if (lane == 0) { *(GAS f32x4*)((float*)(F.ws + WS_ROUTE) + (size_t)m * 4) = (f32x4){__uint_as_float((unsigned)e0 | ((unsigned)e1 << 8)), g0, g1, rstd};
            __hip_atomic_fetch_add((LAS unsigned*)lcnt + e0, 1u, __ATOMIC_RELAXED, __HIP_MEMORY_SCOPE_WORKGROUP); __hip_atomic_fetch_add((LAS unsigned*)lcnt + e1, 1u, __ATOMIC_RELAXED, __HIP_MEMORY_SCOPE_WORKGROUP); }
    }
    __syncthreads();
    if (F.tid < 8) { const unsigned c = lcnt[F.tid]; ((int*)(F.ws + WS_GCNT))[grp * 8 + F.tid] = (int)c; __hip_atomic_fetch_add(F.ctl + CW_CNT + 64 * F.tid, c, RLX_AGENT); lcnt[F.tid] = 0u; }
    __syncthreads();
    }
}
constexpr int MOE_I_UP = 16 * 56, MOE_I_DN = 56 * 16, MOE_NIT = NE * (2 * MOE_I_UP + MOE_I_DN), MOE_EARLY = NE * MOE_I_DN + W13E_SPLIT * 2 * MOE_I_UP;
constexpr int MOE_K_INPROJ = 3, MOE_K_UP = 1;
__device__ __forceinline__ TrItem moe_item(Frame& F, int it, const float* gain, const float* w1, const float* w3, const float* w2) {
    TrItem t; int r;
    if (it < NE * MOE_I_DN) { const int e = it / MOE_I_DN; r = it - e * MOE_I_DN; t.W = w2 + (size_t)e * FFE * D; t.WT = (unsigned char*)F.out + DO_W2E + (size_t)e * D * FFE; t.gain = nullptr; t.scale = MOE_SW2; t.K = FFE; t.N = D; t.mp = RowMap{0, 0}; }
    else { const int i2 = it - NE * MOE_I_DN, e = i2 / (2 * MOE_I_UP); r = i2 - e * 2 * MOE_I_UP; const bool third = r >= MOE_I_UP; if (third) r -= MOE_I_UP;
        t.W = (third ? w3 : w1) + (size_t)e * D * FFE; t.WT = (e < W13E_SPLIT ? (unsigned char*)F.out + DO_W13E : F.ws + WS_W13E) + (size_t)e * 2 * FFE * D; t.gain = gain; t.scale = MOE_SW1; t.K = D; t.N = FFE; t.mp = RowMap{2, third ? 128 : 0}; }
    const int nblk = t.N / 64; t.k0 = 64 * (r / nblk); t.n0 = 64 * (r % nblk); return t;
}
__device__ __forceinline__ void moe_weights_range(Frame& F, const float* gain, const float* w1, const float* w3, const float* w2, int first, int stride, int count, int limit) {
    LAS float* scr = (LAS float*)(F.lds + RING_OFF + F.wave * 16896);
    const int lane = F.lane;
    int it = first; if (count <= 0 || it >= limit) return;
    TrItem cur = moe_item(F, it, gain, w1, w3, w2); f32x4 v[16]; float gv[16]; tr64_load(cur, v, gv, lane);
    for (int k = 1;; ++k) { const int nx = it + stride; const bool more = k < count && nx < limit;
        TrItem nxt = cur; f32x4 vn[16]; float gn[16];
        if (more) { nxt = moe_item(F, nx, gain, w1, w3, w2); tr64_load(nxt, vn, gn, lane); }
        tr64_store(cur, v, gv, scr, lane);
        if (!more) break;
        it = nx; cur = nxt;
#pragma unroll
        for (int i = 0; i < 16; ++i) { v[i] = vn[i]; gv[i] = gn[i]; } }
}
__device__ __forceinline__ int moe_tail_idle(int G, int nwg) { const int rem = nwg % G; return rem > 0 ? G - rem : 0; }
__device__ __forceinline__ int moe_tail_base(int G, int t) {
    const int n0 = moe_tail_idle(G, (M / 256) * (INP / 256)) * 8 * MOE_K_INPROJ, n2 = moe_tail_idle(G, (M / 256) * (2 * FF / 256)) * 8 * MOE_K_UP;
    const int b = t == 0 ? 0 : t == 1 ? n0 : t == 2 ? 2 * n0 : 2 * n0 + n2; return b < MOE_EARLY ? b : MOE_EARLY; }
__device__ __forceinline__ void moe_tail_work(Frame& F, const float* const* in, int t, int nwg, int kper) {
    const int rem = nwg % F.G, idle = moe_tail_idle(F.G, nwg); if (idle == 0 || (int)blockIdx.x < rem) return;
    asm volatile("s_waitcnt vmcnt(0)" ::: "memory"); __syncthreads();
    const int base = moe_tail_base(F.G, t), lim = moe_tail_base(F.G, t + 1);
    moe_weights_range(F, in[10] + D, in[15], in[16], in[17], base + ((int)blockIdx.x - rem) * 8 + F.wave, idle * 8, kper, lim);
}
struct MoeSeg { int t1, t2, t3, t4, t5, t6, t7, nrt; };
__device__ __forceinline__ MoeSeg moe_segments(Frame& F) {
    unsigned c[8];
#pragma unroll
    for (int e = 0; e < 8; ++e) c[e] = (unsigned)__builtin_amdgcn_readfirstlane((int)__hip_atomic_load(F.ctl + CW_CNT + 64 * e, RLX_AGENT));
    MoeSeg s; int a = 0;
    a += (c[0] + 255) >> 8; s.t1 = a; a += (c[1] + 255) >> 8; s.t2 = a; a += (c[2] + 255) >> 8; s.t3 = a; a += (c[3] + 255) >> 8; s.t4 = a;
    a += (c[4] + 255) >> 8; s.t5 = a; a += (c[5] + 255) >> 8; s.t6 = a; a += (c[6] + 255) >> 8; s.t7 = a; a += (c[7] + 255) >> 8; s.nrt = a;
    return s;
}
__device__ __forceinline__ void gather_phase(Frame& F) {
    const MoeSeg sg = moe_segments(F);
    LAS int* earr = (LAS int*)(F.lds + RING_OFF);
    LAS int* parr = earr + 128;
    LAS int* tot = parr + 128;
    LAS int* base = tot + 8;
    const float* ROUTE = (const float*)(F.ws + WS_ROUTE); int* POS = (int*)(F.ws + WS_POS); float* META = (float*)(F.ws + WS_META); unsigned char* AP = F.ws + WS_AP;
    for (int e = blockIdx.x; e < 8; e += F.G) {
        const int cnt = (int)__hip_atomic_load(F.ctl + CW_CNT + 64 * e, RLX_AGENT);
        const int toff = e == 0 ? 0 : e == 1 ? sg.t1 : e == 2 ? sg.t2 : e == 3 ? sg.t3 : e == 4 ? sg.t4 : e == 5 ? sg.t5 : e == 6 ? sg.t6 : sg.t7;
        const int r0 = toff * 256 + cnt, r1 = toff * 256 + ((cnt + 255) & ~255);
        for (int r = r0 + F.wave; r < r1; r += NWAVES) { GAS unsigned long long* o8 = (GAS unsigned long long*)(AP + (size_t)r * D) + F.lane;
#pragma unroll
            for (int j = 0; j < 2; ++j) o8[64 * j] = 0ull;
            if (F.lane == 0) *(f32x4*)(META + (size_t)r * 4) = (f32x4){0.f, 0.f, 0.f, 0.f}; } }
    for (int grp = blockIdx.x; grp < M / 64; grp += F.G) {
        const int p = F.tid, tok = grp * 64 + (p >> 1), slot = p & 1; int e = 0;
        if (p < 128) { const unsigned ee = __float_as_uint(ROUTE[(size_t)tok * 4]); e = slot == 0 ? (int)(ee & 0xffu) : (int)((ee >> 8) & 0xffu); earr[p] = e; }
        __syncthreads();
        if (p < 8) { tot[p] = 0; base[p] = 0; }
        __syncthreads();
        for (int i = p; i < grp * 8; i += NWAVES * 64) __hip_atomic_fetch_add(base + (i & 7), ((const int*)(F.ws + WS_GCNT))[i], __ATOMIC_RELAXED, __HIP_MEMORY_SCOPE_WORKGROUP);
        __syncthreads();
        if (p < 128) { int rank = 0; for (int j = 0; j < p; ++j) rank += (earr[j] == e);
            const int toff = e == 0 ? 0 : e == 1 ? sg.t1 : e == 2 ? sg.t2 : e == 3 ? sg.t3 : e == 4 ? sg.t4 : e == 5 ? sg.t5 : e == 6 ? sg.t6 : sg.t7;
            const int pos = toff * 256 + base[e] + rank; parr[p] = pos; POS[(size_t)tok * 2 + slot] = pos;
            const f32x4 rt4 = *(const f32x4*)(ROUTE + (size_t)tok * 4); *(f32x4*)(META + (size_t)pos * 4) = (f32x4){rt4.w * (1.f / (MOE_SX * MOE_SW1)), (slot == 0 ? rt4.y : rt4.z) * MOE_SH, 0.f, 0.f}; }
        __syncthreads();
        { const int c4 = p & 255, tsub = p >> 8;
#pragma unroll 1
          for (int it = 0; it < 32; it += 8) { unsigned long long v[8];
#pragma unroll
              for (int k = 0; k < 8; ++k) v[k] = *((const GAS unsigned long long*)((const bf16*)(F.ws + WS_XB) + (size_t)(grp * 64 + 2 * (it + k) + tsub) * D) + c4);
#pragma unroll
              for (int k = 0; k < 8; ++k) { const int tl = 2 * (it + k) + tsub; const unsigned a = (unsigned)v[k], b = (unsigned)(v[k] >> 32); const unsigned w = pg8::pk4_fp8((f32x4){bfl(a), bfh(a), bfl(b), bfh(b)} * MOE_SX);
                  *((GAS unsigned*)(AP + (size_t)parr[2 * tl] * D) + c4) = w; *((GAS unsigned*)(AP + (size_t)parr[2 * tl + 1] * D) + c4) = w; } } }
        __syncthreads();
    }
}
__device__ __forceinline__ f32x4 moe_row4(Frame& F, int pos, int col) {
    if (pos < 128 * 256) { const unsigned long long a = *((const GAS unsigned long long*)((const bf16*)(F.ws + WS_Y) + (size_t)pos * D + col));
        return (f32x4){bfl((unsigned)a), bfh((unsigned)a), bfl((unsigned)(a >> 32)), bfh((unsigned)(a >> 32))}; }
    const float* sl = (const float*)(F.ws + WS_SLAB) + ((size_t)(((pos >> 8) - 128) * 4 + (col >> 8)) * 7) * 65536 + (size_t)(pos & 255) * 256 + (col & 255);
    f32x4 v = *(const GAS f32x4*)sl;
#pragma unroll
    for (int k = 1; k < 7; ++k) v += *(const GAS f32x4*)(sl + (size_t)k * 65536);
    return v;
}
__device__ __forceinline__ void fin_phase(Frame& F) {
    const int gw = F.vcu * NWAVES + F.wave, NGW = F.G * NWAVES, lane = F.lane;
    const int* POS = (const int*)(F.ws + WS_POS);
    for (int m = gw; m < M; m += NGW) {
        const int2 pa = *(const int2*)(POS + (size_t)m * 2);
        GAS f32x4* xa = (GAS f32x4*)(F.out + (size_t)m * D) + lane;
        f32x4 va[4];
#pragma unroll
        for (int j = 0; j < 4; ++j) { const unsigned long long w = *((const GAS unsigned long long*)((const bf16*)(F.ws + WS_XB) + (size_t)m * D + 256 * j) + lane); va[j] = (f32x4){bfl((unsigned)w), bfh((unsigned)w), bfl((unsigned)(w >> 32)), bfh((unsigned)(w >> 32))}; }
        if (pa.x < 128 * 256 && pa.y < 128 * 256) {
            unsigned long long ya[4], yb[4];
#pragma unroll
            for (int j = 0; j < 4; ++j) { ya[j] = *((const GAS unsigned long long*)((const bf16*)(F.ws + WS_Y) + (size_t)pa.x * D + 256 * j) + lane); yb[j] = *((const GAS unsigned long long*)((const bf16*)(F.ws + WS_Y) + (size_t)pa.y * D + 256 * j) + lane); }
#pragma unroll
            for (int j = 0; j < 4; ++j) { const unsigned long long a = ya[j], b = yb[j];
                va[j].x += bfl((unsigned)a) + bfl((unsigned)b); va[j].y += bfh((unsigned)a) + bfh((unsigned)b); va[j].z += bfl((unsigned)(a >> 32)) + bfl((unsigned)(b >> 32)); va[j].w += bfh((unsigned)(a >> 32)) + bfh((unsigned)(b >> 32)); }
        } else {
#pragma unroll
            for (int j = 0; j < 4; ++j) { const int col = 4 * lane + 256 * j; va[j] = va[j] + (moe_row4(F, pa.x, col) + moe_row4(F, pa.y, col)); }
        }
#pragma unroll
        for (int j = 0; j < 4; ++j) xa[64 * j] = va[j];
    }
}

#ifndef GSP2
#define GSP2 true
#endif
struct Args { const float* in[18]; float* out; unsigned char* ws; int ph_lo, ph_hi; };
__global__ void __launch_bounds__(NWAVES * 64, 2) mk_fwd(Args args) {
    extern __shared__ __attribute__((aligned(16))) unsigned char lds[];
    Frame F;
    F.lds = (LAS unsigned char*)lds;
    F.MISC = (volatile LAS unsigned*)(F.lds + MISC_OFF);
    const int wave0 = __builtin_amdgcn_readfirstlane((int)threadIdx.x >> 6);
    F.wave = wave0; F.lane = mk_lane(); F.tid = wave0 * 64 + F.lane;
    F.G = gridDim.x; { const int bx = blockIdx.x; F.vcu = (F.G % 8 == 0) ? (bx % 8) * (F.G / 8) + bx / 8 : bx; }
    F.ws = args.ws; F.out = args.out; F.ctl = (gu32*)(args.ws + WS_CTL);
    for (int u = F.tid; u < (LDS_BYTES - LDSCTL_OFF) / 4; u += NWAVES * 64) ((LAS unsigned*)(F.lds + LDSCTL_OFF))[u] = 0u;
    __syncthreads();
    XcdBarrier bar; bar.bar = (unsigned*)(F.ctl + CW_BAR); bar.x = 0; bar.st = nullptr; bar.wv = wave0;
    if (!MK_PER_PHASE) bar = xcd_barrier_post((unsigned*)(F.ctl + CW_BAR), F.MISC + 8, wave0);
    const int lo = args.ph_lo, hi = args.ph_hi;
#define IN(k) (!MK_PER_PHASE || (lo <= (k) && (k) < hi))
#define FRESH() do { int l_ = mk_lane(), w_ = wave0; unsigned char* ws_ = args.ws; asm volatile("" : "+v"(l_)); asm volatile("" : "+s"(w_)); asm volatile("" : "+s"(ws_)); F.lane = l_; F.tid = w_ * 64 + l_; F.wave = w_; F.ws = ws_; } while (0)
#define SEAM(k) do { if (!MK_PER_PHASE && IN(k) && IN((k) + 1)) xcd_barrier(bar); } while (0)
    const float* const* in = args.in;
    bf16* XB = (bf16*)(F.ws + WS_XB); float* SSQP = (float*)(F.ws + WS_SSQP);

    if (IN(0)) { FRESH(); p0_prologue(F, in); } SEAM(0);

    for (int L = 0; L < 2; ++L) {
        const int pb = 1 + 7 * L;
        if (IN(pb)) { FRESH(); pg8::Gemm g{XB, (const bf16*)(F.ws + WS_WIN) + (size_t)L * INP * D, M, INP, D, D}; pg8::StaticOrder S; S.init(M, INP, F.G, (int)blockIdx.x);
            pg8::EpiInProj E{F.ws, (const float*)(F.ws + WS_GAINS) + L * 128, attn_body::C2};
            pg8::gemm_phase<pg8::EpiInProj, pg8::StaticOrder, true, GSP2>(F.lds + RING_OFF, g, S, E, F.wave);
            FRESH(); moe_tail_work(F, in, L, (M / 256) * (INP / 256), MOE_K_INPROJ); }
        SEAM(pb);
        if (IN(pb + 1)) { FRESH(); diff_rows(F); topk_phase(F, L); }
        SEAM(pb + 1);
        if (IN(pb + 2)) { FRESH();
            const attn_body::AttnTensors AT{(const attn_body::bf16*)(F.ws + WS_Q), (const attn_body::bf16*)(F.ws + WS_K), (const attn_body::bf16*)(F.ws + WS_V), (attn_body::bf16*)(F.ws + WS_AO), (const unsigned long long*)(F.ws + WS_MASK + (size_t)L * 16 * MiB)};
            const attn_body::StaticOrder S((int)F.G, (int)blockIdx.x);
            attn_body::attn_phase<attn_body::StaticOrder>((char*)lds + RING_OFF, AT, S, F.wave); }
        SEAM(pb + 2);
        if (IN(pb + 3)) { FRESH();
            pg8::Gemm g{(const bf16*)(F.ws + WS_AO), (const bf16*)(F.ws + WS_PA) + (size_t)L * D * 512, M, D, 1024, 512, 0, 0ll, (const bf16*)(F.ws + WS_DIFF), (const bf16*)(F.ws + WS_WEFF) + (size_t)L * D * 512, 8};
            pg8::StaticOrder S; S.init(M, D, F.G, (int)blockIdx.x);
            pg8::EpiGate2 E{(const bf16*)(F.ws + WS_SG), 2048, (bf16*)(F.ws + WS_MB)};
            pg8::gemm_phase<pg8::EpiGate2, pg8::StaticOrder, true, GSP2>(F.lds + RING_OFF, g, S, E, F.wave); }
        SEAM(pb + 3);
        if (IN(pb + 4)) { FRESH(); pg8::Gemm g{(const bf16*)(F.ws + WS_MB), (const bf16*)(F.ws + WS_WOUT) + (size_t)L * D * D, M, D, D, D}; pg8::StaticOrder S; S.init(M, D, F.G, (int)blockIdx.x);
            if (L == 0) { pg8::EpiResid<true> E{XB, F.ws + WS_X8, SSQP, 1.f, MOE_SX};
                pg8::gemm_phase<pg8::EpiResid<true>, pg8::StaticOrder, true, GSP2>(F.lds + RING_OFF, g, S, E, F.wave); }
            else { pg8::EpiResid<false> E{XB, nullptr, SSQP, 1.f, 1.f};
                pg8::gemm_phase<pg8::EpiResid<false>, pg8::StaticOrder, true, GSP2>(F.lds + RING_OFF, g, S, E, F.wave); } }
        SEAM(pb + 4);
        if (L == 0) {
            if (IN(6)) { FRESH(); pg8::Gemm g{(const bf16*)(F.ws + WS_X8), (const bf16*)(F.ws + WS_W13), M, 2 * FF, D / 2, D / 2}; pg8::StaticOrder S; S.init(M, 2 * FF, F.G, (int)blockIdx.x);
                pg8::EpiSwiGLU<false> E{(bf16*)(F.ws + WS_HB), FF, 2 * FF / 256, SSQP, nullptr, 1.f / (MOE_SX * MOE_SW1), MOE_SH};
                pg8::gemm_phase<pg8::EpiSwiGLU<false>, pg8::StaticOrder, true, GSP2, true>(F.lds + RING_OFF, g, S, E, F.wave);
                FRESH(); moe_tail_work(F, in, 2, (M / 256) * (2 * FF / 256), MOE_K_UP); }
            SEAM(6);
            if (IN(7)) { FRESH(); pg8::Gemm g{(const bf16*)(F.ws + WS_HB), (const bf16*)(F.ws + WS_W2), M, D, FF / 2, FF / 2}; pg8::StaticOrder S; S.init(M, D, F.G, (int)blockIdx.x);
                pg8::EpiResid<false> E{XB, nullptr, SSQP, 1.f / (MOE_SH * MOE_SW2), 1.f};
                pg8::gemm_phase<pg8::EpiResid<false>, pg8::StaticOrder, true, GSP2, true>(F.lds + RING_OFF, g, S, E, F.wave); }
            SEAM(7);
        }
    }
    if (IN(13)) { FRESH(); moe_weights_range(F, in[10] + D, in[15], in[16], in[17], moe_tail_base(F.G, 3) + F.vcu * NWAVES + F.wave, F.G * NWAVES, 1 << 30, MOE_NIT); route_phase(F, in[10] + D, in[14]); }
    SEAM(13);
    if (IN(14)) { FRESH(); gather_phase(F); }
    SEAM(14);
    if (IN(15)) { FRESH(); const MoeSeg sg = moe_segments(F);
        pg8::Gemm g{(const bf16*)(F.ws + WS_AP), (const bf16*)((unsigned char*)F.out + DO_W13E), MROWS, NE * 2 * FFE, D / 2, D / 2, W13E_SPLIT * (2 * FFE / 256), (long long)((F.ws + WS_W13E) - ((unsigned char*)F.out + DO_W13E))};
        pg8::GroupedOrder S{2 * FFE / 256, F.G, (int)blockIdx.x, sg.nrt, sg.t1, sg.t2, sg.t3, sg.t4, sg.t5, sg.t6, sg.t7, 0, sg.nrt * (2 * FFE / 256), 1, 0};
        pg8::EpiSwiGLU<true> E{(bf16*)(F.ws + WS_HE), FFE, 2 * FFE / 256, nullptr, (const float*)(F.ws + WS_META)};
        pg8::gemm_phase<pg8::EpiSwiGLU<true>, pg8::GroupedOrder, true, GSP2, true>(F.lds + RING_OFF, g, S, E, F.wave); }
    SEAM(15);
    if (IN(16)) { FRESH(); const MoeSeg sg = moe_segments(F);
        { pg8::Gemm g{(const bf16*)(F.ws + WS_HE), (const bf16*)((unsigned char*)F.out + DO_W2E), MROWS, NE * D, FFE / 2, FFE / 2};
          pg8::GroupedOrder S{D / 256, F.G, (int)blockIdx.x, sg.nrt, sg.t1, sg.t2, sg.t3, sg.t4, sg.t5, sg.t6, sg.t7, 0, 128 * (D / 256), 1, 0};
          pg8::EpiPlain E{(bf16*)(F.ws + WS_Y), D, D / 256, 1.f / (MOE_SH * MOE_SW2)};
          pg8::gemm_phase<pg8::EpiPlain, pg8::GroupedOrder, true, GSP2, true>(F.lds + RING_OFF, g, S, E, F.wave); }
        { pg8::Gemm g{(const bf16*)(F.ws + WS_HE), (const bf16*)((unsigned char*)F.out + DO_W2E), MROWS, NE * D, FFE / 14, FFE / 2};
          pg8::GroupedOrder S{D / 256, F.G, (int)blockIdx.x, sg.nrt, sg.t1, sg.t2, sg.t3, sg.t4, sg.t5, sg.t6, sg.t7, 128 * (D / 256), sg.nrt * (D / 256), 7, FFE / 14};
          pg8::EpiSlab E{(float*)(F.ws + WS_SLAB), D / 256, 128, 7, FFE / 14, 1.f / (MOE_SH * MOE_SW2)};
          pg8::gemm_phase<pg8::EpiSlab, pg8::GroupedOrder, true, GSP2, true>(F.lds + RING_OFF, g, S, E, F.wave); }
        }
    SEAM(16);
    if (IN(17)) { FRESH(); fin_phase(F); }
#undef IN
#undef SEAM
}

extern "C" void kernel_launch(void* const* d_in, const int* in_sizes, int n_in, void* d_out, int out_size, void* d_ws, size_t ws_size, hipStream_t stream) {
    static int grid = 0;
    if (grid == 0) {
        if (n_in != 18 || in_sizes[0] != M * D || out_size != M * D || ws_size < WS_END) { fprintf(stderr, "kernel_launch: unexpected shapes or workspace (n_in %d, ws %zu < %zu); nothing launched\n", n_in, ws_size, (size_t)WS_END); grid = -1; return; }
        int dev = 0, cus = 0, per_cu = 0;
        if (hipGetDevice(&dev) != hipSuccess || hipDeviceGetAttribute(&cus, hipDeviceAttributeMultiprocessorCount, dev) != hipSuccess) { grid = -1; return; }
        if (hipFuncSetAttribute((const void*)mk_fwd, hipFuncAttributeMaxDynamicSharedMemorySize, LDS_BYTES) != hipSuccess) { fprintf(stderr, "kernel_launch: hipFuncSetAttribute failed\n"); grid = -1; return; }
        if (hipOccupancyMaxActiveBlocksPerMultiprocessor(&per_cu, (const void*)mk_fwd, NWAVES * 64, LDS_BYTES) != hipSuccess || per_cu < 1) fprintf(stderr, "kernel_launch: occupancy query reports %d\n", per_cu);
        (void)hipGetLastError();
        grid = cus;
    }
    if (grid < 0) return;
    if (hipMemsetAsync((char*)d_ws + WS_CTL, 0, CTL_ZERO_BYTES, stream) != hipSuccess) return;
    Args a{};
    for (int i = 0; i < 18; ++i) a.in[i] = (const float*)d_in[i];
    a.out = (float*)d_out; a.ws = (unsigned char*)d_ws;
#if MK_PER_PHASE
    for (int ph = 0; ph < NPH; ++ph) { a.ph_lo = ph; a.ph_hi = ph + 1; hipLaunchKernelGGL(mk_fwd, dim3(grid), dim3(NWAVES * 64), LDS_BYTES, stream, a); }
#else
    a.ph_lo = 0; a.ph_hi = NPH; hipLaunchKernelGGL(mk_fwd, dim3(grid), dim3(NWAVES * 64), LDS_BYTES, stream, a);
#endif
}
```
